# Optimizing an MI355X kernel written in HIP

```python
import math
import jax, jax.numpy as jnp
from jax import lax
import numpy as np

D_MODEL = 1024
BATCH = 16
SEQ = 2048
DEPTH = 1

N_HEADS_ATTN = 8
HEAD_DIM = 64
V_DIM = 2 * HEAD_DIM
ATTN_WIDTH = N_HEADS_ATTN * V_DIM
QK_WIDTH = N_HEADS_ATTN * 2 * HEAD_DIM
Q_BLOCK = 128
REL_BUCKETS = 32
REL_MAX_DIST = 128
LRU_WIDTH = D_MODEL
LRU_BLOCKS = 8
LRU_BLOCK = LRU_WIDTH // LRU_BLOCKS
CONV_WIDTH = 4
LRU_C = 8.0
N_EXPERTS = 16
EC_CAPACITY_FACTOR = 2
D_FF_EXPERT = 2 * D_MODEL
EPS = 1e-6

OFF_Q = 0
OFF_K = OFF_Q + QK_WIDTH
OFF_V = OFF_K + QK_WIDTH
OFF_LRU_X = OFF_V + ATTN_WIDTH
OFF_LRU_Y = OFF_LRU_X + LRU_WIDTH
OFF_GATE_A = OFF_LRU_Y + LRU_WIDTH
OFF_GATE_R = OFF_GATE_A + D_MODEL
D_IN = OFF_GATE_R + D_MODEL

kernel_name = "hybrid_diffattn_rglru_ecmoe_encoder"


def _rmsnorm(x, g):
    xf = x.astype(jnp.float32)
    y = xf * lax.rsqrt(jnp.mean(xf * xf, axis=-1, keepdims=True) + EPS)
    return (y * g.astype(jnp.float32)).astype(x.dtype)


def _lambda_init(layer_idx):
    return 0.8 - 0.6 * math.exp(-0.3 * layer_idx)


def _rel_bucket(rel):
    half = REL_BUCKETS // 2
    max_exact = half // 2
    ret = jnp.where(rel > 0, half, 0)
    n = jnp.abs(rel)
    nf = jnp.maximum(n, max_exact).astype(jnp.float32)
    large = max_exact + (jnp.log(nf / max_exact) / math.log(REL_MAX_DIST / max_exact)
                         * (half - max_exact)).astype(jnp.int32)
    large = jnp.minimum(large, half - 1)
    return ret + jnp.where(n < max_exact, n, large)


def _diff_attention(q, k, v, lam, rel_bias):
    B, S = q.shape[0], q.shape[1]
    nq = S // Q_BLOCK
    qb = q.reshape(B, nq, Q_BLOCK, N_HEADS_ATTN, 2, HEAD_DIM).transpose(1, 0, 3, 4, 2, 5)
    kt = k.transpose(0, 2, 3, 1, 4)
    vt = v.transpose(0, 2, 1, 3)
    k_pos = jnp.arange(S, dtype=jnp.int32)
    scale = HEAD_DIM ** -0.5

    def block(args):
        q_blk, start = args
        q_pos = start + jnp.arange(Q_BLOCK, dtype=jnp.int32)
        bias = rel_bias[_rel_bucket(k_pos[None, :] - q_pos[:, None])]
        bias = bias.transpose(2, 0, 1).astype(jnp.float32)
        logits = jnp.einsum("bhmqd,bhmkd->bhmqk", q_blk, kt).astype(jnp.float32) * scale
        p = jax.nn.softmax(logits + bias[None, :, None], axis=-1)
        w = (p[:, :, 0] - lam * p[:, :, 1]).astype(v.dtype)
        return jnp.einsum("bhqk,bhkv->bhqv", w, vt)

    starts = jnp.arange(nq, dtype=jnp.int32) * Q_BLOCK
    o = lax.map(block, (qb, starts))
    return o.transpose(1, 0, 3, 2, 4).reshape(B, S, N_HEADS_ATTN, V_DIM)


def _scan_combine(c1, c2):
    a1, b1 = c1
    a2, b2 = c2
    return a1 * a2, a2 * b1 + b2


def _rg_lru(xf, w_r, b_r, w_i, b_i, lam_param, reverse):
    B, S, W = xf.shape
    xb = xf.reshape(B, S, LRU_BLOCKS, LRU_BLOCK)
    r = jax.nn.sigmoid(jnp.einsum("bsnc,ncd->bsnd", xb, w_r.astype(jnp.float32)).reshape(B, S, W)
                       + b_r.astype(jnp.float32))
    i = jax.nn.sigmoid(jnp.einsum("bsnc,ncd->bsnd", xb, w_i.astype(jnp.float32)).reshape(B, S, W)
                       + b_i.astype(jnp.float32))
    log_a = -LRU_C * r * jax.nn.softplus(-lam_param.astype(jnp.float32))
    a = jnp.exp(log_a)
    mult = jnp.sqrt(jnp.maximum(-jnp.expm1(2.0 * log_a), 0.0))
    _, h = lax.associative_scan(_scan_combine, (a, mult * i * xf), axis=1, reverse=reverse)
    return h


def _ec_moe(xn, w_router, w_gate, w_up, w_down):
    B, S, D = xn.shape
    cap = EC_CAPACITY_FACTOR * S // N_EXPERTS
    aff = jax.nn.softmax(jnp.einsum("bsd,de->bse", xn.astype(jnp.float32),
                                    w_router.astype(jnp.float32)), axis=-1)
    vals, idx = lax.top_k(aff.transpose(0, 2, 1), cap)
    xg = jax.vmap(lambda xs, ix: xs[ix])(xn, idx)
    hg = jax.nn.silu(jnp.einsum("becd,edf->becf", xg, w_gate)) * jnp.einsum("becd,edf->becf", xg, w_up)
    ye = jnp.einsum("becf,efd->becd", hg, w_down) * vals[..., None].astype(xn.dtype)
    return jax.vmap(lambda ix, yb: jnp.zeros((S, D), yb.dtype).at[ix.reshape(-1)].add(yb.reshape(-1, D)))(idx, ye)


def setup_inputs(seed: int = 0) -> dict:
    key = jax.random.key(seed)
    ks = jax.random.split(key, 32)
    f32 = jnp.float32
    nrm = lambda k, shape, s: jax.random.normal(k, shape, f32) * s
    u = jax.random.uniform(ks[20], (DEPTH, 2, LRU_WIDTH), f32, 0.9, 0.999)
    return {
        "x": jax.random.normal(ks[0], (BATCH, SEQ, D_MODEL), f32),
        "g_mix": 1.0 + nrm(ks[1], (DEPTH, D_MODEL), 0.05),
        "w_in": nrm(ks[2], (DEPTH, D_MODEL, D_IN), D_MODEL ** -0.5),
        "g_q": 1.0 + nrm(ks[3], (DEPTH, HEAD_DIM), 0.05),
        "g_k": 1.0 + nrm(ks[4], (DEPTH, HEAD_DIM), 0.05),
        "lam_q1": nrm(ks[5], (DEPTH, HEAD_DIM), 0.1),
        "lam_k1": nrm(ks[6], (DEPTH, HEAD_DIM), 0.1),
        "lam_q2": nrm(ks[7], (DEPTH, HEAD_DIM), 0.1),
        "lam_k2": nrm(ks[8], (DEPTH, HEAD_DIM), 0.1),
        "g_subln": 1.0 + nrm(ks[9], (DEPTH, V_DIM), 0.05),
        "rel_bias": nrm(ks[10], (REL_BUCKETS, N_HEADS_ATTN), 0.5),
        "conv_w": nrm(ks[11], (DEPTH, CONV_WIDTH, LRU_WIDTH), CONV_WIDTH ** -0.5),
        "conv_b": nrm(ks[12], (DEPTH, LRU_WIDTH), 0.01),
        "gate_r_w": nrm(ks[13], (DEPTH, 2, LRU_BLOCKS, LRU_BLOCK, LRU_BLOCK), LRU_BLOCK ** -0.5),
        "gate_r_b": nrm(ks[14], (DEPTH, 2, LRU_WIDTH), 0.01),
        "gate_i_w": nrm(ks[15], (DEPTH, 2, LRU_BLOCKS, LRU_BLOCK, LRU_BLOCK), LRU_BLOCK ** -0.5),
        "gate_i_b": nrm(ks[16], (DEPTH, 2, LRU_WIDTH), 0.01),
        "lru_lambda": jnp.log(u) - jnp.log1p(-u),
        "w_proj_attn": nrm(ks[17], (DEPTH, ATTN_WIDTH, D_MODEL), ATTN_WIDTH ** -0.5),
        "w_proj_lru": nrm(ks[18], (DEPTH, LRU_WIDTH, D_MODEL), LRU_WIDTH ** -0.5),
        "w_out": nrm(ks[19], (DEPTH, D_MODEL, D_MODEL), D_MODEL ** -0.5),
        "g_ffn": 1.0 + nrm(ks[21], (DEPTH, D_MODEL), 0.05),
        "w_router": nrm(ks[22], (DEPTH, D_MODEL, N_EXPERTS), D_MODEL ** -0.5),
        "w_gate_e": nrm(ks[23], (DEPTH, N_EXPERTS, D_MODEL, D_FF_EXPERT), D_MODEL ** -0.5),
        "w_up_e": nrm(ks[24], (DEPTH, N_EXPERTS, D_MODEL, D_FF_EXPERT), D_MODEL ** -0.5),
        "w_down_e": nrm(ks[25], (DEPTH, N_EXPERTS, D_FF_EXPERT, D_MODEL), D_FF_EXPERT ** -0.5),
    }


def reference(x, g_mix, w_in, g_q, g_k, lam_q1, lam_k1, lam_q2, lam_k2, g_subln, rel_bias,
              conv_w, conv_b, gate_r_w, gate_r_b, gate_i_w, gate_i_b, lru_lambda,
              w_proj_attn, w_proj_lru, w_out, g_ffn, w_router, w_gate_e, w_up_e, w_down_e):
    B, S, D = x.shape
    h = x
    for layer in range(DEPTH):
        lam_init = _lambda_init(layer)
        xn = _rmsnorm(h, g_mix[layer])
        proj = jnp.einsum("bsd,dn->bsn", xn, w_in[layer])
        q = proj[..., OFF_Q:OFF_K].reshape(B, S, N_HEADS_ATTN, 2, HEAD_DIM)
        k = proj[..., OFF_K:OFF_V].reshape(B, S, N_HEADS_ATTN, 2, HEAD_DIM)
        v = proj[..., OFF_V:OFF_LRU_X].reshape(B, S, N_HEADS_ATTN, V_DIM)
        x_lru = proj[..., OFF_LRU_X:OFF_LRU_Y]
        y_lru = proj[..., OFF_LRU_Y:OFF_GATE_A]
        gate_a = proj[..., OFF_GATE_A:OFF_GATE_R]
        gate_r = proj[..., OFF_GATE_R:D_IN]

        q = _rmsnorm(q, g_q[layer])
        k = _rmsnorm(k, g_k[layer])
        lam = (jnp.exp(jnp.sum(lam_q1[layer].astype(jnp.float32) * lam_k1[layer].astype(jnp.float32)))
               - jnp.exp(jnp.sum(lam_q2[layer].astype(jnp.float32) * lam_k2[layer].astype(jnp.float32)))
               + lam_init)
        o = _diff_attention(q, k, v, lam, rel_bias)
        o = _rmsnorm(o, g_subln[layer]) * (1.0 - lam_init)
        branch_a = jnp.einsum("bsa,ad->bsd", o.reshape(B, S, ATTN_WIDTH), w_proj_attn[layer])

        xc = lax.conv_general_dilated(
            x_lru, conv_w[layer][:, None, :], window_strides=(1,),
            padding=[(CONV_WIDTH // 2, CONV_WIDTH - 1 - CONV_WIDTH // 2)],
            dimension_numbers=("NWC", "WIO", "NWC"), feature_group_count=LRU_WIDTH) + conv_b[layer]
        xcf = xc.astype(jnp.float32)
        h_fwd = _rg_lru(xcf, gate_r_w[layer, 0], gate_r_b[layer, 0], gate_i_w[layer, 0],
                        gate_i_b[layer, 0], lru_lambda[layer, 0], reverse=False)
        h_bwd = _rg_lru(xcf, gate_r_w[layer, 1], gate_r_b[layer, 1], gate_i_w[layer, 1],
                        gate_i_b[layer, 1], lru_lambda[layer, 1], reverse=True)
        lru_out = ((h_fwd + h_bwd) * jax.nn.gelu(y_lru.astype(jnp.float32))).astype(x.dtype)
        branch_r = jnp.einsum("bsw,wd->bsd", lru_out, w_proj_lru[layer])

        mixed = jax.nn.sigmoid(gate_a) * branch_a + jax.nn.sigmoid(gate_r) * branch_r
        h = h + jnp.einsum("bsd,de->bse", mixed, w_out[layer])

        hn = _rmsnorm(h, g_ffn[layer])
        h = h + _ec_moe(hn, w_router[layer], w_gate_e[layer], w_up_e[layer], w_down_e[layer])
    return h
```

```cpp
#include <hip/hip_runtime.h>
#include <cstdio>
#include <cstdint>

#define GAS __attribute__((address_space(1)))
#define LAS __attribute__((address_space(3)))
typedef unsigned short bf16_t;
typedef short bf16x8 __attribute__((ext_vector_type(8)));
typedef short s16x4 __attribute__((ext_vector_type(4)));
typedef float f32x2 __attribute__((ext_vector_type(2)));
typedef float f32x4 __attribute__((ext_vector_type(4)));
typedef float f32x16 __attribute__((ext_vector_type(16)));
typedef unsigned u32x2 __attribute__((ext_vector_type(2)));
typedef unsigned u32x4 __attribute__((ext_vector_type(4)));
typedef unsigned long long u64;

#ifndef MK_ONE_LAUNCH
#define MK_ONE_LAUNCH 0
#endif

constexpr int BATCH = 16, SEQ = 2048, DM = 1024, MTOK = BATCH * SEQ, NH = 8, DIN = 7168, NE = 16, CAP = 256, FFE = 2048;
constexpr float EPS = 1e-6f;
constexpr float LOG2E = 1.4426950408889634f;
constexpr int NPHASE = 9;

constexpr size_t MiB = 1u << 20;
constexpr size_t WS_CTL = 0, CTL_ZERO_BYTES = 64 * 1024;
constexpr size_t WS_TAB = 1 * MiB;
constexpr size_t WS_WIN = 2 * MiB;
constexpr size_t WS_WCAT = 16 * MiB;
constexpr size_t WS_WOUT = 20 * MiB;
constexpr size_t WS_WLRU = 22 * MiB;
constexpr size_t WS_AFF = 23 * MiB;
constexpr size_t WS_SELI = 25 * MiB;
constexpr size_t WS_SELV = 25 * MiB + 256 * 1024;
constexpr size_t WS_RA = 26 * MiB;
constexpr size_t WS_Q = 90 * MiB, WS_K = 154 * MiB, WS_V = 218 * MiB;
constexpr size_t WS_WGU = 90 * MiB;
constexpr size_t WS_WDN = 218 * MiB;
constexpr size_t WS_XL = 282 * MiB;
constexpr size_t WS_GY = 346 * MiB;
constexpr size_t WS_LO = 410 * MiB;
constexpr size_t WS_HG = 282 * MiB;
constexpr size_t WS_END = 538 * MiB;
constexpr int CW_BAR = 1024;

constexpr int RING_BYTES = 131072;
constexpr int X_SCR_OFF = 131072;
constexpr int X_IDX_OFF = X_SCR_OFF + 8 * 2304;
constexpr int MISC_OFF = X_IDX_OFF + 2048;
constexpr int LDS_BYTES = 152576;

__device__ __forceinline__ unsigned cvt_pk_bf16(float lo, float hi) { unsigned r; asm volatile("v_cvt_pk_bf16_f32 %0, %1, %2" : "=v"(r) : "v"(lo), "v"(hi)); return r; }
__device__ __forceinline__ float bf_lo(unsigned w) { return __uint_as_float(w << 16); }
__device__ __forceinline__ float bf_hi(unsigned w) { return __uint_as_float(w & 0xffff0000u); }
__device__ __forceinline__ float bf1(bf16_t b) { return __uint_as_float(((unsigned)b) << 16); }
__device__ __forceinline__ bf16_t f2bf(float f) { return (bf16_t)(cvt_pk_bf16(f, 0.f) & 0xffffu); }
__device__ __forceinline__ float wave_sum(float v) {
#pragma unroll
    for (int o = 1; o < 64; o <<= 1) v += __shfl_xor(v, o);
    return v;
}
__device__ __forceinline__ float sigmoidf_(float x) { return __builtin_amdgcn_rcpf(1.0f + __builtin_amdgcn_exp2f(-x * LOG2E)); }
__device__ __forceinline__ float gelu_tanh(float y) { const float u = 0.7978845608028654f * (y + 0.044715f * y * y * y); return y * __builtin_amdgcn_rcpf(1.0f + __builtin_amdgcn_exp2f(-2.0f * LOG2E * u)); }
#define LDS_WAIT() asm volatile("s_waitcnt lgkmcnt(0)" ::: "memory")
#define VM_WAIT() asm volatile("s_waitcnt vmcnt(0)" ::: "memory")

#define XB_TMO      128
#define XB_XCNT(j)  (256  + 64 * (j))
#define XB_XSUB(j)  (1280 + 64 * (j))
#define XB_XGEN(j)  (2304 + 64 * (j))
#define XB_TOP      3328
#define XB_TOPGEN   3392
#define XCD_BAR_WORDS 3456
#define XB_SPIN_CAP (1u << 18)
__device__ __forceinline__ unsigned xb_ld(unsigned* p)              { return __hip_atomic_load(p, __ATOMIC_RELAXED, __HIP_MEMORY_SCOPE_AGENT); }
__device__ __forceinline__ unsigned xb_add(unsigned* p, unsigned v) { return __hip_atomic_fetch_add(p, v, __ATOMIC_RELAXED, __HIP_MEMORY_SCOPE_AGENT); }
__device__ __forceinline__ unsigned xb_xcc_id() { return (unsigned)__builtin_amdgcn_s_getreg((3 << 11) | 20) & 0xFu; }
#define XB_SPIN(cond, bar) do { unsigned _sp = 0; while (cond) { __builtin_amdgcn_s_sleep(1); \
    if ((++_sp & 255u) == 0u) { if (xb_ld(&(bar)[XB_TMO])) break; if (_sp > XB_SPIN_CAP) { atomicAdd(&(bar)[XB_TMO], 1u); break; } } } } while (0)
struct XcdBarrier { unsigned* bar; unsigned x; volatile LAS unsigned* st; };
__device__ __forceinline__ XcdBarrier xcd_barrier_post(unsigned* bar, volatile LAS unsigned* st) {
    XcdBarrier b; b.bar = bar; b.x = xb_xcc_id(); b.st = st;
    if (threadIdx.x == 0) (void)xb_add(&bar[XB_XCNT(b.x)], 1u);
    return b;
}
__device__ __forceinline__ void xcd_barrier_complete(unsigned* bar, unsigned x, unsigned& nloc, unsigned& nx) {
    const unsigned G = gridDim.x * gridDim.y * gridDim.z;
    unsigned sum, cnt, mine, sp = 0u;
    for (;;) {
        sum = 0u; cnt = 0u; mine = 0u;
#pragma unroll
        for (unsigned j = 0; j < 16; ++j) { const unsigned c = xb_ld(&bar[XB_XCNT(j)]); sum += c; cnt += (c > 0u) ? 1u : 0u; mine = (j == x) ? c : mine; }
        if (sum == G) break;
        __builtin_amdgcn_s_sleep(1);
        if ((++sp & 255u) == 0u) { if (xb_ld(&bar[XB_TMO])) break; if (sp > XB_SPIN_CAP) { atomicAdd(&bar[XB_TMO], 1u); break; } }
    }
    nloc = mine > 0u ? mine : 1u; nx = cnt > 0u ? cnt : 1u;
}
__device__ __forceinline__ void xcd_barrier(const XcdBarrier& b) {
    asm volatile("s_waitcnt vmcnt(0)" ::: "memory");
    __syncthreads();
    if (threadIdx.x == 0) {
        unsigned* bar = b.bar;
        __builtin_amdgcn_s_waitcnt(0);
        unsigned nloc = b.st[0], nx = b.st[1];
        if (nloc == 0u) { xcd_barrier_complete(bar, b.x, nloc, nx); b.st[0] = nloc; b.st[1] = nx; }
        const unsigned old = xb_add(&bar[XB_XSUB(b.x)], 1u);
        const unsigned gen = old / nloc;
        if (old + 1u == (gen + 1u) * nloc) {
            __builtin_amdgcn_fence(__ATOMIC_RELEASE, "agent");
            asm volatile("s_waitcnt vmcnt(0)" ::: "memory");
            const unsigned og = xb_add(&bar[XB_TOP], 1u);
            const unsigned tg = og / nx;
            if (og + 1u == (tg + 1u) * nx) xb_add(&bar[XB_TOPGEN], 1u);
            else XB_SPIN(xb_ld(&bar[XB_TOPGEN]) == tg, bar);
            __builtin_amdgcn_fence(__ATOMIC_ACQUIRE, "agent");
            xb_add(&bar[XB_XGEN(b.x)], 1u);
            asm volatile("s_waitcnt vmcnt(0)" ::: "memory");
        } else {
            XB_SPIN(xb_ld(&bar[XB_XGEN(b.x)]) == gen, bar);
            __builtin_amdgcn_fence(__ATOMIC_ACQUIRE, "agent");
            asm volatile("s_waitcnt vmcnt(0)" ::: "memory");
        }
    }
    __syncthreads();
}

namespace pg8 {
constexpr int BM = 256, BK = 64, HALF = 128, HTB = HALF * BK * 2, STAGE_BYTES = 8 * HTB, NXCD = 8, WGM = 8;
__host__ __device__ __forceinline__ int lds_byte(int r, int c) { const int st = (r >> 4) * 2 + (c >> 5), rr = r & 15, cc = c & 31, ob = rr * 64 + cc * 2; return st * 1024 + (ob ^ (((ob >> 9) & 1) << 5)); }
__host__ __device__ __forceinline__ void stage_rc(int b, int& R, int& C) { const int st = b / 1024, sb = b % 1024, swz = sb ^ (((sb >> 9) & 1) << 5); R = (st >> 1) * 16 + swz / 64; C = (st & 1) * 32 + (swz % 64) / 2; }
__host__ __device__ __forceinline__ int perm32(int rho) { const int n = rho >> 4, i = rho & 15; return 8 * (i >> 2) + 4 * n + (i & 3); }

struct Unit { int pm, pn, aux; const char* A; const char* B; };

__device__ __forceinline__ bool tile_of(int L, int nM, int nN, int& pm, int& pn) {
    const int nwg = nM * nN; if (L >= nwg) return false;
    int wgid = L; { const int q = nwg / NXCD, r = nwg % NXCD, xcd = wgid % NXCD, off = wgid / NXCD; wgid = (xcd < r ? xcd * (q + 1) : r * (q + 1) + (xcd - r) * q) + off; }
    const int nig = WGM * nN, gid = wgid / nig, fm = gid * WGM, gsz = (nM - fm) < WGM ? (nM - fm) : WGM;
    pm = fm + ((wgid % nig) % gsz); pn = (wgid % nig) / gsz; return true;
}

template <class Epi, class Sched, bool ALIGN_EPI, bool SP2>
__device__ __forceinline__ void gemm_phase(LAS unsigned char* lds, const int K, const Sched& S, const Epi& E) {
    const int tid = threadIdx.x, wid = __builtin_amdgcn_readfirstlane(tid >> 6), lane = tid & 63, wr = wid >> 2, wc = wid & 3, fr = lane & 15, fq = lane >> 4;
    const int nt = K / BK;
    unsigned voffA[2][2], voffB[2];
#pragma unroll
    for (int i = 0; i < 2; ++i) { int R, C; stage_rc(tid * 16 + i * 8192, R, C);
        voffB[i] = (unsigned)(Epi::browmap(R) * K + C) * 2u;
#pragma unroll
        for (int h = 0; h < 2; ++h) voffA[h][i] = S.aoff(R + HALF * h, C); }
    const size_t kstep = (size_t)(BK * 2);
    const size_t hstepB = (size_t)Epi::BHSTEP_ROWS * K * 2;
    const unsigned ldsw = (unsigned)wid * 1024u;
    const int aoff = lds_byte(wr * 64 + fr, fq * 8), boff = lds_byte(wc * 32 + fr, fq * 8);
#define PG8_SA(b, h) (((b) * 2 + (h)) * HTB)
#define PG8_SB(b, h) ((4 + (b) * 2 + (h)) * HTB)
#define PG8_STAGE_A(bufoff, gbase, h) do { _Pragma("unroll") for (int _i = 0; _i < 2; ++_i) \
        __builtin_amdgcn_global_load_lds((const unsigned*)((const char*)(gbase) + voffA[h][_i]), (LAS unsigned*)(lds + (bufoff) + ldsw + _i * 8192), 16, 0, 0); } while (0)
#define PG8_STAGE_B(bufoff, gbase) do { _Pragma("unroll") for (int _i = 0; _i < 2; ++_i) \
        __builtin_amdgcn_global_load_lds((const unsigned*)((const char*)(gbase) + voffB[_i]), (LAS unsigned*)(lds + (bufoff) + ldsw + _i * 8192), 16, 0, 0); } while (0)
#define PG8_LDA(dst, b, h) do { _Pragma("unroll") for (int m = 0; m < 4; ++m) _Pragma("unroll") for (int k = 0; k < 2; ++k) dst[m][k] = *(const LAS bf16x8*)(lds + PG8_SA(b, h) + aoff + m * 2048 + k * 1024); } while (0)
#define PG8_LDB(dst, b, h) do { _Pragma("unroll") for (int n = 0; n < 2; ++n) _Pragma("unroll") for (int k = 0; k < 2; ++k) dst[n][k] = *(const LAS bf16x8*)(lds + PG8_SB(b, h) + boff + n * 2048 + k * 1024); } while (0)
#define PG8_MMA(ai, bj, At, Bt) do { __builtin_amdgcn_s_setprio(1); _Pragma("unroll") for (int m = 0; m < 4; ++m) _Pragma("unroll") for (int n = 0; n < 2; ++n) _Pragma("unroll") for (int k = 0; k < 2; ++k) \
        acc[ai][bj][m][n] = __builtin_amdgcn_mfma_f32_16x16x32_bf16(Bt[n][k], At[m][k], acc[ai][bj][m][n], 0, 0, 0); __builtin_amdgcn_s_setprio(0); } while (0)
#define PG8_WAIT_V(n) asm volatile("s_waitcnt vmcnt(" #n ")" ::: "memory")
#define PG8_WAIT_L(n) asm volatile("s_waitcnt lgkmcnt(" #n ")" ::: "memory")
#define PG8_BAR __builtin_amdgcn_s_barrier()
#define PG8_SCHED __builtin_amdgcn_sched_barrier(0)
    Unit cur, nxt; int ui = 0;
    if (!S.next(0, cur)) return;
    f32x4 acc[2][2][4][2];
#pragma unroll
    for (int a = 0; a < 2; ++a)
#pragma unroll
        for (int b = 0; b < 2; ++b)
#pragma unroll
            for (int m = 0; m < 4; ++m)
#pragma unroll
                for (int n = 0; n < 2; ++n) acc[a][b][m][n] = (f32x4){0.f, 0.f, 0.f, 0.f};
    bf16x8 At[4][2], B0[2][2], B1[2][2];
    const char* cA = cur.A; const char* cB = cur.B;
    if constexpr (SP2) {
        PG8_STAGE_B(PG8_SB(0, 0), cB); PG8_STAGE_B(PG8_SB(0, 1), cB + hstepB); PG8_STAGE_A(PG8_SA(0, 0), cA, 0); PG8_STAGE_A(PG8_SA(0, 1), cA, 1);
        if (wr == 1) PG8_BAR;
        PG8_WAIT_V(2); PG8_BAR;
        PG8_STAGE_B(PG8_SB(1, 0), cB + kstep); PG8_STAGE_A(PG8_SA(1, 0), cA + kstep, 0); PG8_STAGE_B(PG8_SB(1, 1), cB + hstepB + kstep);
        PG8_WAIT_V(6); PG8_BAR;
    } else {
        PG8_STAGE_B(PG8_SB(0, 0), cB); PG8_STAGE_A(PG8_SA(0, 0), cA, 0); PG8_STAGE_B(PG8_SB(0, 1), cB + hstepB); PG8_STAGE_A(PG8_SA(0, 1), cA, 1);
        if (wr == 1) PG8_BAR;
        PG8_WAIT_V(4); PG8_BAR;
        PG8_STAGE_B(PG8_SB(1, 0), cB + kstep); PG8_STAGE_A(PG8_SA(1, 0), cA + kstep, 0); PG8_STAGE_B(PG8_SB(1, 1), cB + hstepB + kstep);
        PG8_WAIT_V(6); PG8_BAR;
    }
    for (;;) {
        const bool has_next = S.next(ui + 1, nxt);
        const char* nA = has_next ? nxt.A : cA; const char* nB = has_next ? nxt.B : cB;
        for (int t = 0; t < nt; t += 2) {
            const bool last = (t == nt - 2);
            const char* a1 = cA + (size_t)(t + 1) * kstep;
            const char* a2 = last ? nA : cA + (size_t)(t + 2) * kstep; const char* b2 = last ? nB : cB + (size_t)(t + 2) * kstep;
            const char* a3 = a2 + kstep; const char* b3 = b2 + kstep;
            if constexpr (SP2) {
            PG8_LDB(B0, 0, 0); PG8_LDB(B1, 0, 1); PG8_SCHED; PG8_LDA(At, 0, 0); PG8_STAGE_A(PG8_SA(1, 1), a1, 1);
            PG8_WAIT_V(8); PG8_WAIT_L(0); PG8_BAR; PG8_MMA(0, 0, At, B0); PG8_MMA(0, 1, At, B1); PG8_BAR; PG8_SCHED;
            PG8_LDA(At, 0, 1); PG8_STAGE_B(PG8_SB(0, 0), b2); PG8_STAGE_B(PG8_SB(0, 1), b2 + hstepB); PG8_STAGE_A(PG8_SA(0, 0), a2, 0);
            PG8_WAIT_V(8); PG8_WAIT_L(0); PG8_BAR; PG8_MMA(1, 0, At, B0); PG8_MMA(1, 1, At, B1); PG8_BAR; PG8_SCHED;
            PG8_LDB(B0, 1, 0); PG8_LDB(B1, 1, 1); PG8_SCHED; PG8_LDA(At, 1, 0); PG8_STAGE_A(PG8_SA(0, 1), a2, 1);
            PG8_WAIT_V(8); PG8_WAIT_L(0); PG8_BAR; PG8_MMA(0, 0, At, B0); PG8_MMA(0, 1, At, B1); PG8_BAR; PG8_SCHED;
            PG8_LDA(At, 1, 1); PG8_STAGE_B(PG8_SB(1, 0), b3); PG8_STAGE_B(PG8_SB(1, 1), b3 + hstepB); PG8_STAGE_A(PG8_SA(1, 0), a3, 0);
            PG8_WAIT_V(8); PG8_WAIT_L(0); PG8_BAR; PG8_MMA(1, 0, At, B0); PG8_MMA(1, 1, At, B1); PG8_BAR; PG8_SCHED;
            } else {
            PG8_LDB(B0, 0, 0); PG8_SCHED; PG8_LDA(At, 0, 0); PG8_STAGE_A(PG8_SA(1, 1), a1, 1);
            PG8_WAIT_L(8); PG8_BAR; PG8_WAIT_L(0); PG8_MMA(0, 0, At, B0); PG8_BAR; PG8_SCHED;
            PG8_LDB(B1, 0, 1); PG8_STAGE_B(PG8_SB(0, 0), b2);
            PG8_BAR; PG8_WAIT_L(0); PG8_MMA(0, 1, At, B1); PG8_BAR;
            PG8_LDA(At, 0, 1); PG8_STAGE_A(PG8_SA(0, 0), a2, 0);
            PG8_BAR; PG8_WAIT_L(0); PG8_MMA(1, 0, At, B0); PG8_BAR; PG8_SCHED;
            PG8_STAGE_B(PG8_SB(0, 1), b2 + hstepB);
            PG8_WAIT_V(6); PG8_BAR; PG8_MMA(1, 1, At, B1); PG8_BAR;
            PG8_LDB(B0, 1, 0); PG8_SCHED; PG8_LDA(At, 1, 0); PG8_STAGE_A(PG8_SA(0, 1), a2, 1);
            PG8_WAIT_L(8); PG8_BAR; PG8_WAIT_L(0); PG8_MMA(0, 0, At, B0); PG8_BAR; PG8_SCHED;
            PG8_LDB(B1, 1, 1); PG8_STAGE_B(PG8_SB(1, 0), b3);
            PG8_BAR; PG8_WAIT_L(0); PG8_MMA(0, 1, At, B1); PG8_BAR;
            PG8_LDA(At, 1, 1); PG8_STAGE_A(PG8_SA(1, 0), a3, 0);
            PG8_BAR; PG8_WAIT_L(0); PG8_MMA(1, 0, At, B0); PG8_BAR; PG8_SCHED;
            PG8_STAGE_B(PG8_SB(1, 1), b3 + hstepB);
            PG8_WAIT_V(6); PG8_BAR; PG8_MMA(1, 1, At, B1); PG8_BAR;
            }
        }
        if constexpr (ALIGN_EPI) { if (wr == 0) PG8_BAR; }
        E(acc, cur, wr, wc, fr, fq, wid, lane);
        if (!has_next) break;
#pragma unroll
        for (int a = 0; a < 2; ++a)
#pragma unroll
            for (int b = 0; b < 2; ++b)
#pragma unroll
                for (int m = 0; m < 4; ++m)
#pragma unroll
                    for (int n = 0; n < 2; ++n) acc[a][b][m][n] = (f32x4){0.f, 0.f, 0.f, 0.f};
        cur = nxt; cA = nA; cB = nB; ++ui;
        if constexpr (ALIGN_EPI) { if (wr == 1) PG8_BAR; }
    }
    PG8_WAIT_V(0);
    if constexpr (!ALIGN_EPI) { if (wr == 0) PG8_BAR; }
    PG8_BAR;
#undef PG8_SA
#undef PG8_SB
#undef PG8_STAGE_A
#undef PG8_STAGE_B
#undef PG8_LDA
#undef PG8_LDB
#undef PG8_MMA
#undef PG8_WAIT_V
#undef PG8_WAIT_L
#undef PG8_BAR
#undef PG8_SCHED
}

struct DenseOrder {
    const char* A; const char* Bt; int lda, K, nM, nN, G, c;
    __device__ __forceinline__ unsigned aoff(int row, int C) const { return (unsigned)(row * lda + C) * 2u; }
    __device__ __forceinline__ bool next(int i, Unit& u) const {
        int pm, pn; if (!tile_of(i * G + c, nM, nN, pm, pn)) return false;
        u.pm = pm; u.pn = pn; u.aux = 0; u.A = A + (size_t)pm * BM * lda * 2; u.B = Bt + (size_t)pn * BM * K * 2; return true;
    }
};
struct BranchOrder {
    const char* A0; long long dA; const char* Bt; int G, c;
    __device__ __forceinline__ unsigned aoff(int row, int C) const { return (unsigned)(row * DM + C) * 2u; }
    __device__ __forceinline__ bool next(int i, Unit& u) const {
        int pm, pn; const int br = i & 1; if (!tile_of((i >> 1) * G + c, MTOK / BM, DM / BM, pm, pn)) return false;
        u.pm = pm; u.pn = pn; u.aux = br; u.A = A0 + (long long)br * dA + (size_t)pm * BM * DM * 2; u.B = Bt + (size_t)(br * DM + pn * BM) * DM * 2; return true;
    }
};
struct MoeUpOrder {
    const char* hn; const char* wgu; const int* idx; int b, e, pair; bool valid;
    __device__ __forceinline__ unsigned aoff(int row, int C) const { const int tok = valid ? idx[pair * CAP + row] : 0; return (unsigned)((b * SEQ + tok) * DM + C) * 2u; }
    __device__ __forceinline__ bool next(int i, Unit& u) const {
        if (!valid || i >= 16) return false;
        u.pm = pair; u.pn = i; u.aux = 0; u.A = hn; u.B = wgu + (size_t)((e * 16 + i) * 256) * DM * 2; return true;
    }
};
struct MoeDownOrder {
    const char* hg; const char* wdn; int b, e, pair; bool valid;
    __device__ __forceinline__ unsigned aoff(int row, int C) const { return (unsigned)(row * FFE + C) * 2u; }
    __device__ __forceinline__ bool next(int i, Unit& u) const {
        if (!valid || i >= 4) return false;
        u.pm = pair; u.pn = i; u.aux = 0; u.A = hg + (size_t)pair * CAP * FFE * 2; u.B = wdn + (size_t)(e * DM + i * BM) * FFE * 2; return true;
    }
};

struct EpiProj {
    static constexpr int BHSTEP_ROWS = 32;
    __host__ __device__ static __forceinline__ int browmap(int R) { return 64 * (R >> 5) + perm32(R & 31); }
    bf16_t *q, *k, *v, *xl, *gy, *sa, *sr; const float *gq, *gk;
    __device__ __forceinline__ void operator()(const f32x4 (&acc)[2][2][4][2], const Unit& u, int wr, int wc, int fr, int fq, int wid, int lane) const {
        const int type = u.pn >> 2;
        const int row0 = u.pm * BM + wr * 64 + fr, col0 = (u.pn & 3) * 256 + 64 * wc + 8 * fq;
        bf16_t* dst = type == 0 ? q : type == 1 ? k : type == 2 ? v : type == 3 ? xl : type == 4 ? gy : type == 5 ? sa : sr;
        if (type < 2) {
            const float* g = type == 0 ? gq : gk;
            f32x4 gv[2][2];
#pragma unroll
            for (int bj = 0; bj < 2; ++bj)
#pragma unroll
                for (int n = 0; n < 2; ++n) gv[bj][n] = *(const f32x4*)(g + 32 * bj + 8 * fq + 4 * n);
#pragma unroll
            for (int ai = 0; ai < 2; ++ai)
#pragma unroll
                for (int m = 0; m < 4; ++m) {
                    float ss = 0.f;
#pragma unroll
                    for (int bj = 0; bj < 2; ++bj)
#pragma unroll
                        for (int n = 0; n < 2; ++n) { const f32x4 x = acc[ai][bj][m][n]; ss += (x[0] * x[0] + x[1] * x[1]) + (x[2] * x[2] + x[3] * x[3]); }
                    ss += __shfl_xor(ss, 16); ss += __shfl_xor(ss, 32);
                    const float rs = __builtin_amdgcn_rsqf(ss * (1.0f / 64.0f) + EPS);
                    bf16_t* rowp = dst + (size_t)(row0 + ai * HALF + m * 16) * DM + col0;
#pragma unroll
                    for (int bj = 0; bj < 2; ++bj) { const f32x4 v0 = acc[ai][bj][m][0] * rs * gv[bj][0], v1 = acc[ai][bj][m][1] * rs * gv[bj][1];
                        u32x4 w; w.x = cvt_pk_bf16(v0[0], v0[1]); w.y = cvt_pk_bf16(v0[2], v0[3]); w.z = cvt_pk_bf16(v1[0], v1[1]); w.w = cvt_pk_bf16(v1[2], v1[3]);
                        *(u32x4*)(rowp + 32 * bj) = w; }
                }
        } else {
#pragma unroll
            for (int ai = 0; ai < 2; ++ai)
#pragma unroll
                for (int m = 0; m < 4; ++m) { bf16_t* rowp = dst + (size_t)(row0 + ai * HALF + m * 16) * DM + col0;
#pragma unroll
                    for (int bj = 0; bj < 2; ++bj) { f32x4 v0 = acc[ai][bj][m][0], v1 = acc[ai][bj][m][1];
                        if (type == 4) {
#pragma unroll
                            for (int j = 0; j < 4; ++j) { v0[j] = gelu_tanh(v0[j]); v1[j] = gelu_tanh(v1[j]); }
                        } else if (type >= 5) {
#pragma unroll
                            for (int j = 0; j < 4; ++j) { v0[j] = sigmoidf_(v0[j]); v1[j] = sigmoidf_(v1[j]); }
                        }
                        u32x4 w; w.x = cvt_pk_bf16(v0[0], v0[1]); w.y = cvt_pk_bf16(v0[2], v0[3]); w.z = cvt_pk_bf16(v1[0], v1[1]); w.w = cvt_pk_bf16(v1[2], v1[3]);
                        *(u32x4*)(rowp + 32 * bj) = w; } }
        }
    }
};
struct PermMap { static constexpr int BHSTEP_ROWS = 128; __host__ __device__ static __forceinline__ int browmap(int R) { return (R & ~31) + perm32(R & 31); } };
struct PlainMap { static constexpr int BHSTEP_ROWS = 128; __host__ __device__ static __forceinline__ int browmap(int R) { return R; } };

struct EpiBranch : PermMap {
    const bf16_t *sa, *sr; bf16_t* mixed;
    __device__ __forceinline__ void operator()(const f32x4 (&acc)[2][2][4][2], const Unit& u, int wr, int wc, int fr, int fq, int wid, int lane) const {
        const int row0 = u.pm * BM + wr * 64 + fr, col0 = u.pn * BM + wc * 32 + 8 * fq;
        const bf16_t* gate = u.aux ? sr : sa;
#pragma unroll
        for (int ai = 0; ai < 2; ++ai)
#pragma unroll
            for (int m = 0; m < 4; ++m) { const size_t off = (size_t)(row0 + ai * HALF + m * 16) * DM + col0;
#pragma unroll
                for (int bj = 0; bj < 2; ++bj) { const f32x4 a0 = acc[ai][bj][m][0], a1 = acc[ai][bj][m][1];
                    const u32x4 g = *(const u32x4*)(gate + off + bj * HALF);
                    float r[8] = { a0[0] * bf_lo(g.x), a0[1] * bf_hi(g.x), a0[2] * bf_lo(g.y), a0[3] * bf_hi(g.y), a1[0] * bf_lo(g.z), a1[1] * bf_hi(g.z), a1[2] * bf_lo(g.w), a1[3] * bf_hi(g.w) };
                    if (u.aux) { const u32x4 p = *(const u32x4*)(mixed + off + bj * HALF);
                        r[0] += bf_lo(p.x); r[1] += bf_hi(p.x); r[2] += bf_lo(p.y); r[3] += bf_hi(p.y); r[4] += bf_lo(p.z); r[5] += bf_hi(p.z); r[6] += bf_lo(p.w); r[7] += bf_hi(p.w); }
                    u32x4 w; w.x = cvt_pk_bf16(r[0], r[1]); w.y = cvt_pk_bf16(r[2], r[3]); w.z = cvt_pk_bf16(r[4], r[5]); w.w = cvt_pk_bf16(r[6], r[7]);
                    *(u32x4*)(mixed + off + bj * HALF) = w; } }
        asm volatile("s_waitcnt vmcnt(0)" ::: "memory");
    }
};
struct EpiOut : PlainMap {
    const float* x; float* out;
    __device__ __forceinline__ void operator()(const f32x4 (&acc)[2][2][4][2], const Unit& u, int wr, int wc, int fr, int fq, int wid, int lane) const {
        const int row0 = u.pm * BM + wr * 64 + fr, col0 = u.pn * BM + wc * 32 + 4 * fq;
#pragma unroll
        for (int ai = 0; ai < 2; ++ai)
#pragma unroll
            for (int m = 0; m < 4; ++m) { const size_t off = (size_t)(row0 + ai * HALF + m * 16) * DM + col0;
#pragma unroll
                for (int bj = 0; bj < 2; ++bj)
#pragma unroll
                    for (int n = 0; n < 2; ++n) { const f32x4 xv = *(const f32x4*)(x + off + bj * HALF + n * 16); *(f32x4*)(out + off + bj * HALF + n * 16) = xv + acc[ai][bj][m][n]; } }
    }
};
struct EpiMoeUp : PermMap {
    bf16_t* hg;
    __device__ __forceinline__ void operator()(const f32x4 (&acc)[2][2][4][2], const Unit& u, int wr, int wc, int fr, int fq, int wid, int lane) const {
        const int row0 = wr * 64 + fr, col0 = u.pn * 128 + wc * 32 + 8 * fq;
        bf16_t* base = hg + (size_t)u.pm * CAP * FFE;
#pragma unroll
        for (int ai = 0; ai < 2; ++ai)
#pragma unroll
            for (int m = 0; m < 4; ++m) { float r[8];
#pragma unroll
                for (int n = 0; n < 2; ++n)
#pragma unroll
                    for (int j = 0; j < 4; ++j) { const float g = acc[ai][0][m][n][j], up = acc[ai][1][m][n][j]; r[4 * n + j] = g * sigmoidf_(g) * up; }
                u32x4 w; w.x = cvt_pk_bf16(r[0], r[1]); w.y = cvt_pk_bf16(r[2], r[3]); w.z = cvt_pk_bf16(r[4], r[5]); w.w = cvt_pk_bf16(r[6], r[7]);
                *(u32x4*)(base + (size_t)(row0 + ai * HALF + m * 16) * FFE + col0) = w; }
    }
};
struct EpiMoeDown : PlainMap {
    float* out; LAS float* scr; const LAS int* idxL; const LAS float* valL; int b;
    __device__ __forceinline__ void operator()(const f32x4 (&acc)[2][2][4][2], const Unit& u, int wr, int wc, int fr, int fq, int wid, int lane) const {
        LAS float* ws = scr + wid * 576;
        const int rl = lane >> 5, cl = lane & 31;
#pragma unroll
        for (int ai = 0; ai < 2; ++ai)
#pragma unroll
            for (int m = 0; m < 4; ++m) { const int rbase = ai * HALF + wr * 64 + m * 16; const float vs = valL[rbase + fr];
#pragma unroll
                for (int bj = 0; bj < 2; ++bj) {
#pragma unroll
                    for (int n = 0; n < 2; ++n) *(LAS f32x4*)(ws + fr * 36 + 16 * n + 4 * fq) = acc[ai][bj][m][n] * vs;
                    LDS_WAIT();
                    const int colg = u.pn * BM + bj * HALF + wc * 32 + cl;
#pragma unroll
                    for (int it = 0; it < 8; ++it) { const int r = 2 * it + rl; const float v = ws[r * 36 + cl]; const int tok = idxL[rbase + r];
                        unsafeAtomicAdd(out + (size_t)(b * SEQ + tok) * DM + colg, v); }
                    LDS_WAIT();
                } }
    }
};
}

namespace att {
constexpr int KVBLK = 64, LD = DM;
constexpr int SHM_V = KVBLK * 128 * 2, SHM_K = KVBLK * 128 * 2;
constexpr int TB_OFF = 2 * SHM_V + 2 * SHM_K;
constexpr int E_STRIDE = 132, E_BYTES = 128 * E_STRIDE * 4;
constexpr int LI_OFF = 2 * E_BYTES;
#define KSWZ(row, colB) ((row) * 256 + ((colB) ^ (((row) & 7) << 4)))
#define SBAR() __builtin_amdgcn_sched_barrier(0)
__device__ __forceinline__ int crow(int r, int hi) { return (r & 3) + 8 * (r >> 2) + 4 * hi; }
__device__ __forceinline__ int v_st(int k, int c) { const int kk = (k & ~0xC) | ((k & 4) << 1) | ((k & 8) >> 1); return ((kk >> 3) * 4 + (c >> 5)) * 512 + ((kk & 7) * 32 + (c & 31)) * 2; }
__device__ __forceinline__ int v_rd_base(int lane) { return ((lane & 3) << 3) | (((lane >> 2) & 3) << 6) | (((lane >> 4) & 1) << 5) | (((lane >> 5) & 1) << 8); }
constexpr int v_rd_off(int d0, int ks, int half) { return d0 * 512 + ks * 4096 + half * 2048; }
template <int OFF> __device__ __forceinline__ s16x4 tr_read(int vb) {
    s16x4 r; asm volatile("ds_read_b64_tr_b16 %0, %1 offset:%2" : "=&v"(r) : "v"(vb), "i"(OFF) : "memory"); return r;
}
template <int D0> __device__ __forceinline__ void pv_one(f32x16& od, int vb, bf16x8 pa0, bf16x8 pa1, bf16x8 pa2, bf16x8 pa3) {
    const s16x4 l0 = tr_read<v_rd_off(D0, 0, 0)>(vb), h0 = tr_read<v_rd_off(D0, 0, 1)>(vb), l1 = tr_read<v_rd_off(D0, 1, 0)>(vb), h1 = tr_read<v_rd_off(D0, 1, 1)>(vb);
    const s16x4 l2 = tr_read<v_rd_off(D0, 2, 0)>(vb), h2 = tr_read<v_rd_off(D0, 2, 1)>(vb), l3 = tr_read<v_rd_off(D0, 3, 0)>(vb), h3 = tr_read<v_rd_off(D0, 3, 1)>(vb);
    asm volatile("s_waitcnt lgkmcnt(0)" ::: "memory"); SBAR();
#define PK(L, H) (bf16x8){L[0], L[1], L[2], L[3], H[0], H[1], H[2], H[3]}
    od = __builtin_amdgcn_mfma_f32_32x32x16_bf16(pa0, PK(l0, h0), od, 0, 0, 0);
    od = __builtin_amdgcn_mfma_f32_32x32x16_bf16(pa1, PK(l1, h1), od, 0, 0, 0);
    od = __builtin_amdgcn_mfma_f32_32x32x16_bf16(pa2, PK(l2, h2), od, 0, 0, 0);
    od = __builtin_amdgcn_mfma_f32_32x32x16_bf16(pa3, PK(l3, h3), od, 0, 0, 0);
#undef PK
}
__device__ __forceinline__ void pv_d0(f32x16* o, int vb, bf16x8 pa0, bf16x8 pa1, bf16x8 pa2, bf16x8 pa3) {
    pv_one<0>(o[0], vb, pa0, pa1, pa2, pa3); pv_one<1>(o[1], vb, pa0, pa1, pa2, pa3); pv_one<2>(o[2], vb, pa0, pa1, pa2, pa3); pv_one<3>(o[3], vb, pa0, pa1, pa2, pa3);
}
__device__ __forceinline__ void qkt(f32x16& p0, f32x16& p1, const char* Ks, const bf16x8* qr, int r32, int hi, int mm) {
    p0 = f32x16{}; p1 = f32x16{};
#pragma unroll
    for (int d0 = 0; d0 < 4; ++d0) { const int cb = (mm * 64 + d0 * 16 + hi * 8) * 2;
        const bf16x8 b0 = *reinterpret_cast<const bf16x8*>(Ks + KSWZ(r32, cb));
        const bf16x8 b1 = *reinterpret_cast<const bf16x8*>(Ks + KSWZ(32 + r32, cb));
        p0 = __builtin_amdgcn_mfma_f32_32x32x16_bf16(b0, qr[d0], p0, 0, 0, 0);
        p1 = __builtin_amdgcn_mfma_f32_32x32x16_bf16(b1, qr[d0], p1, 0, 0, 0); }
}
__device__ __forceinline__ void partialSM(f32x16& p0, f32x16& p1, const float* Tb, int drel, int r32, int hi, float Tl, float Tr) {
    constexpr float C = 0.125f * LOG2E;
    if (drel >= 122 || drel <= -154) {
        const float t = drel > 0 ? Tr : Tl;
#pragma unroll
        for (int r = 0; r < 16; ++r) { p0[r] = fmaf(p0[r], C, t); p1[r] = fmaf(p1[r], C, t); }
    } else {
        const float* tb = Tb + (drel + 256 - r32 + 4 * hi);
#pragma unroll
        for (int r = 0; r < 16; ++r) { const int o = (r & 3) + 8 * (r >> 2); p0[r] = fmaf(p0[r], C, tb[o]); p1[r] = fmaf(p1[r], C, tb[o + 32]); }
    }
#pragma unroll
    for (int r = 0; r < 16; ++r) p0[r] = __builtin_amdgcn_exp2f(p0[r]);
}
__device__ __forceinline__ void finishSM(f32x16& p0, f32x16& p1, float& l_reg, bf16x8& pa0, bf16x8& pa1, bf16x8& pa2, bf16x8& pa3) {
#pragma unroll
    for (int r = 0; r < 16; ++r) p1[r] = __builtin_amdgcn_exp2f(p1[r]);
    float ps = 0;
#pragma unroll
    for (int r = 0; r < 16; ++r) ps += p0[r];
#pragma unroll
    for (int r = 0; r < 16; ++r) ps += p1[r];
    { auto rr = __builtin_amdgcn_permlane32_swap(__float_as_uint(ps), __float_as_uint(ps), false, false);
      ps = __uint_as_float(rr[0]) + __uint_as_float(rr[1]); }
    l_reg += ps;
#define PK4(P, BASE, OUT) do { unsigned a0 = cvt_pk_bf16(P[BASE + 0], P[BASE + 1]), a1 = cvt_pk_bf16(P[BASE + 2], P[BASE + 3]);   \
    unsigned b0 = cvt_pk_bf16(P[BASE + 4], P[BASE + 5]), b1 = cvt_pk_bf16(P[BASE + 6], P[BASE + 7]);                              \
    auto r0 = __builtin_amdgcn_permlane32_swap(a0, b0, false, false); auto r1 = __builtin_amdgcn_permlane32_swap(a1, b1, false, false); \
    u32x4 w = {r0[0], r1[0], r0[1], r1[1]}; OUT = *reinterpret_cast<bf16x8*>(&w); } while (0)
    PK4(p0, 0, pa0); PK4(p0, 8, pa1); PK4(p1, 0, pa2); PK4(p1, 8, pa3);
#undef PK4
}

__device__ __forceinline__ void attn_unit(int b, int h, int qb, const bf16_t* __restrict__ Qb, const bf16_t* __restrict__ Kb, const bf16_t* __restrict__ Vb, bf16_t* __restrict__ Ob,
                                          const float* __restrict__ TbG, const float* __restrict__ gsub, float lam, char* lds) {
    const int tid = threadIdx.x, wid = tid >> 6, lane = tid & 63, r32 = lane & 31, hi = lane >> 5, rg = wid & 3, mm = wid >> 2;
    char* V_lds = lds; char* K_lds = lds + 2 * SHM_V; float* Tb = (float*)(lds + TB_OFF);
    const int q0 = qb * 128, q0w = q0 + rg * 32;
    Tb[tid] = TbG[h * 512 + tid];
    const float Tl = TbG[h * 512 + 0], Tr = TbG[h * 512 + 511];
    float l_reg = 0; f32x16 o[4] = {}; bf16x8 qr[4];
    const bf16_t* Qw = Qb + (size_t)(b * SEQ + q0w + r32) * LD + h * 128 + mm * 64 + hi * 8;
#pragma unroll
    for (int d0 = 0; d0 < 4; ++d0) qr[d0] = *reinterpret_cast<const bf16x8*>(Qw + d0 * 16);
    const bf16_t* Kh = Kb + (size_t)(b * SEQ) * LD + h * 128; const bf16_t* Vh = Vb + (size_t)(b * SEQ) * LD + h * 128;
    const int sr = tid >> 4, sc = (tid & 15) * 8, vst0 = v_st(sr, sc), vst1 = v_st(32 + sr, sc);
    const int vb0 = (int)(uintptr_t)V_lds + v_rd_base(lane);
    struct { bf16x8 vs0, vs1, ks0, ks1; } sr_[2];
#define SLOAD(i, k0) do { sr_[i].vs0 = *reinterpret_cast<const bf16x8*>(&Vh[(size_t)((k0) + sr) * LD + sc]); sr_[i].vs1 = *reinterpret_cast<const bf16x8*>(&Vh[(size_t)((k0) + 32 + sr) * LD + sc]); \
    sr_[i].ks0 = *reinterpret_cast<const bf16x8*>(&Kh[(size_t)((k0) + sr) * LD + sc]); sr_[i].ks1 = *reinterpret_cast<const bf16x8*>(&Kh[(size_t)((k0) + 32 + sr) * LD + sc]); } while (0)
#define SWRITE(bb, i) do { *(bf16x8*)(V_lds + (bb) * SHM_V + vst0) = sr_[i].vs0;          \
    *(bf16x8*)(V_lds + (bb) * SHM_V + vst1) = sr_[i].vs1; const int kc = sc * 2;               \
    *(bf16x8*)(K_lds + (bb) * SHM_K + KSWZ(sr, kc)) = sr_[i].ks0;                       \
    *(bf16x8*)(K_lds + (bb) * SHM_K + KSWZ(32 + sr, kc)) = sr_[i].ks1; } while (0)
#define SWAIT() asm volatile("s_waitcnt vmcnt(4)" ::: "memory")
    f32x16 pA0, pA1, pB0, pB1; bf16x8 pa0, pa1, pa2, pa3; constexpr int NT = SEQ / KVBLK;
    constexpr int SE = 0, SO = 1;
    SLOAD(SE, 0); asm volatile("s_waitcnt vmcnt(0)" ::: "memory"); SWRITE(0, SE); __syncthreads();
    qkt(pA0, pA1, K_lds, qr, r32, hi, mm); partialSM(pA0, pA1, Tb, 0 - q0w, r32, hi, Tl, Tr);
    SLOAD(SO, KVBLK); SLOAD(SE, 2 * KVBLK);
    SWAIT(); SWRITE(1, SO); __syncthreads();
    for (int j = 1; j + 1 < NT; j += 2) {
        SBAR(); qkt(pB0, pB1, K_lds + SHM_K, qr, r32, hi, mm);
        finishSM(pA0, pA1, l_reg, pa0, pa1, pa2, pa3); SBAR();
        SLOAD(SO, (j + 2) * KVBLK); SBAR();
        pv_d0(o, vb0, pa0, pa1, pa2, pa3); partialSM(pB0, pB1, Tb, j * KVBLK - q0w, r32, hi, Tl, Tr);
        __syncthreads(); SWAIT(); SWRITE(0, SE);
        __syncthreads();
        SBAR(); qkt(pA0, pA1, K_lds, qr, r32, hi, mm);
        finishSM(pB0, pB1, l_reg, pa0, pa1, pa2, pa3); SBAR();
        if (j + 3 < NT) SLOAD(SE, (j + 3) * KVBLK); SBAR();
        pv_d0(o, vb0 + SHM_V, pa0, pa1, pa2, pa3); partialSM(pA0, pA1, Tb, (j + 1) * KVBLK - q0w, r32, hi, Tl, Tr);
        __syncthreads(); SWAIT(); SWRITE(1, SO);
        __syncthreads();
    }
    SBAR(); qkt(pB0, pB1, K_lds + SHM_K, qr, r32, hi, mm);
    finishSM(pA0, pA1, l_reg, pa0, pa1, pa2, pa3); SBAR();
    pv_d0(o, vb0, pa0, pa1, pa2, pa3); partialSM(pB0, pB1, Tb, (NT - 1) * KVBLK - q0w, r32, hi, Tl, Tr);
    finishSM(pB0, pB1, l_reg, pa0, pa1, pa2, pa3); SBAR();
    pv_d0(o, vb0 + SHM_V, pa0, pa1, pa2, pa3);
    asm volatile("s_waitcnt vmcnt(0)" ::: "memory");
#undef SLOAD
#undef SWRITE
#undef SWAIT
    float* li_l = (float*)(lds + LI_OFF) + wid * 64;
    __syncthreads();
    if (hi == 0) li_l[r32] = l_reg; asm volatile("s_waitcnt lgkmcnt(0)" ::: "memory");
    const float fsc = mm ? lam : 1.0f;
    float* Em = (float*)(lds + mm * E_BYTES);
#pragma unroll
    for (int r = 0; r < 16; ++r) { const int orow = crow(r, hi); const float f = fsc * __builtin_amdgcn_rcpf(li_l[orow]);
#pragma unroll
        for (int d0 = 0; d0 < 4; ++d0) Em[(rg * 32 + orow) * E_STRIDE + d0 * 32 + r32] = o[d0][r] * f; }
    __syncthreads();
    {
        const int row = tid >> 2, qt = tid & 3;
        const float* e0 = (const float*)lds + row * E_STRIDE + qt * 32; const float* e1 = e0 + E_BYTES / 4;
        f32x4 d[8]; float ss = 0.f;
#pragma unroll
        for (int c = 0; c < 8; ++c) { d[c] = *(const f32x4*)(e0 + 4 * c) - *(const f32x4*)(e1 + 4 * c); ss += (d[c][0] * d[c][0] + d[c][1] * d[c][1]) + (d[c][2] * d[c][2] + d[c][3] * d[c][3]); }
        ss += __shfl_xor(ss, 1); ss += __shfl_xor(ss, 2);
        const float rs = __builtin_amdgcn_rsqf(ss * (1.0f / 128.0f) + EPS) * 0.8f;
        bf16_t* op = Ob + (size_t)(b * SEQ + q0 + row) * LD + h * 128 + qt * 32;
#pragma unroll
        for (int c = 0; c < 4; ++c) { const f32x4 g0 = *(const f32x4*)(gsub + qt * 32 + 8 * c), g1 = *(const f32x4*)(gsub + qt * 32 + 8 * c + 4);
            const f32x4 a = d[2 * c] * rs * g0, bq = d[2 * c + 1] * rs * g1;
            u32x4 w; w.x = cvt_pk_bf16(a[0], a[1]); w.y = cvt_pk_bf16(a[2], a[3]); w.z = cvt_pk_bf16(bq[0], bq[1]); w.w = cvt_pk_bf16(bq[2], bq[3]);
            *(u32x4*)(op + 8 * c) = w; }
    }
    __syncthreads();
}
}

namespace lru {
constexpr int XC_OFF = 0, XCF_OFF = 16384, AS_OFF = XCF_OFF + 16640, BS_OFF = AS_OFF + 16640, SEGP_OFF = BS_OFF + 16640, SEGH_OFF = SEGP_OFF + 2048, CAR_OFF = SEGH_OFF + 2048, CW_OFF = CAR_OFF + 512;
__device__ __forceinline__ void lru_unit(int b, int n, int hh, const bf16_t* __restrict__ XL, const bf16_t* __restrict__ GY, bf16_t* __restrict__ LO, const bf16_t* __restrict__ WL,
                                         const float* __restrict__ conv_w, const float* __restrict__ conv_b, const float* __restrict__ rb, const float* __restrict__ ib, const float* __restrict__ lamp, char* lds) {
    const int tid = threadIdx.x, wid = tid >> 6, lane = tid & 63, r32 = lane & 31, hi = lane >> 5;
    const int tt = wid & 1, ct = wid >> 1;
    char* XC = lds + XC_OFF; float* XCF = (float*)(lds + XCF_OFF); float* AS = (float*)(lds + AS_OFF); float* BS = (float*)(lds + BS_OFF);
    float* SEGP = (float*)(lds + SEGP_OFF); float* SEGH = (float*)(lds + SEGH_OFF); float* CAR = (float*)(lds + CAR_OFF); float* CW = (float*)(lds + CW_OFF);
    for (int i = tid; i < 640; i += 512) CW[i] = i < 512 ? conv_w[(i >> 7) * DM + n * 128 + (i & 127)] : conv_b[n * 128 + (i - 512)];
    __syncthreads();
    const int crow_ = tid >> 3, cg = tid & 7;
    for (int dir = 0; dir < 2; ++dir) {
        bf16x8 wf[8];
        { const bf16_t* wp = WL + (size_t)((((dir * 8 + n) * 2 + hh) * 4 + ct) * 32 + r32) * 128 + 8 * hi;
#pragma unroll
          for (int ks = 0; ks < 8; ++ks) wf[ks] = *reinterpret_cast<const bf16x8*>(wp + 16 * ks); }
        float brv[8], biv[8], kcv[8];
#pragma unroll
        for (int q2 = 0; q2 < 2; ++q2)
#pragma unroll
            for (int s = 0; s < 4; ++s) { const int ch = dir * DM + n * 128 + hh * 64 + ct * 16 + 8 * q2 + 4 * hi + s;
                brv[4 * q2 + s] = rb[ch]; biv[4 * q2 + s] = ib[ch];
                const float L = lamp[ch]; kcv[4 * q2 + s] = -8.0f * log1pf(__expf(-L)) * LOG2E; }
        if (tid < 128) CAR[tid] = 0.f;
        for (int ci = 0; ci < SEQ / 64; ++ci) {
            const int t0 = dir == 0 ? ci * 64 : (SEQ / 64 - 1 - ci) * 64;
            {
                float xc[16];
#pragma unroll
                for (int c = 0; c < 16; ++c) xc[c] = CW[512 + cg * 16 + c];
#pragma unroll
                for (int j = 0; j < 4; ++j) { const int t = t0 + crow_ + j - 2;
                    if (t >= 0 && t < SEQ) { const bf16_t* xp = XL + (size_t)(b * SEQ + t) * DM + n * 128 + cg * 16;
                        const u32x4 x0 = *(const u32x4*)xp, x1 = *(const u32x4*)(xp + 8);
                        const float* w = CW + j * 128 + cg * 16;
                        xc[0] += w[0] * bf_lo(x0.x); xc[1] += w[1] * bf_hi(x0.x); xc[2] += w[2] * bf_lo(x0.y); xc[3] += w[3] * bf_hi(x0.y);
                        xc[4] += w[4] * bf_lo(x0.z); xc[5] += w[5] * bf_hi(x0.z); xc[6] += w[6] * bf_lo(x0.w); xc[7] += w[7] * bf_hi(x0.w);
                        xc[8] += w[8] * bf_lo(x1.x); xc[9] += w[9] * bf_hi(x1.x); xc[10] += w[10] * bf_lo(x1.y); xc[11] += w[11] * bf_hi(x1.y);
                        xc[12] += w[12] * bf_lo(x1.z); xc[13] += w[13] * bf_hi(x1.z); xc[14] += w[14] * bf_lo(x1.w); xc[15] += w[15] * bf_hi(x1.w); } }
                u32x4 w0, w1; w0.x = cvt_pk_bf16(xc[0], xc[1]); w0.y = cvt_pk_bf16(xc[2], xc[3]); w0.z = cvt_pk_bf16(xc[4], xc[5]); w0.w = cvt_pk_bf16(xc[6], xc[7]);
                w1.x = cvt_pk_bf16(xc[8], xc[9]); w1.y = cvt_pk_bf16(xc[10], xc[11]); w1.z = cvt_pk_bf16(xc[12], xc[13]); w1.w = cvt_pk_bf16(xc[14], xc[15]);
                *(u32x4*)(XC + KSWZ(crow_, cg * 32)) = w0; *(u32x4*)(XC + KSWZ(crow_, cg * 32 + 16)) = w1;
                if ((cg >> 2) == hh) { float* xf = XCF + crow_ * 65 + (cg & 3) * 16;
#pragma unroll
                    for (int c = 0; c < 16; ++c) xf[c] = xc[c]; }
            }
            __syncthreads();
            {
                f32x16 acc = {};
#pragma unroll
                for (int ks = 0; ks < 8; ++ks) { const bf16x8 xb = *reinterpret_cast<const bf16x8*>(XC + KSWZ(tt * 32 + r32, (16 * ks + 8 * hi) * 2));
                    acc = __builtin_amdgcn_mfma_f32_32x32x16_bf16(wf[ks], xb, acc, 0, 0, 0); }
                const int tok = tt * 32 + r32;
#pragma unroll
                for (int q2 = 0; q2 < 2; ++q2)
#pragma unroll
                    for (int s = 0; s < 4; ++s) { const int chl = ct * 16 + 8 * q2 + 4 * hi + s;
                        const float rgate = sigmoidf_(acc[8 * q2 + s] + brv[4 * q2 + s]), igate = sigmoidf_(acc[8 * q2 + 4 + s] + biv[4 * q2 + s]);
                        const float a = __builtin_amdgcn_exp2f(rgate * kcv[4 * q2 + s]);
                        const float mult = __builtin_amdgcn_sqrtf(fmaxf(1.0f - a * a, 0.0f));
                        AS[tok * 65 + chl] = a; BS[tok * 65 + chl] = mult * igate * XCF[tok * 65 + chl]; }
            }
            __syncthreads();
            const int ch = lane, seg = wid;
            {
                float Pp = 1.f, Hh = 0.f;
#pragma unroll
                for (int p = 0; p < 8; ++p) { const int pos = seg * 8 + p, tl = dir ? 63 - pos : pos; const float a = AS[tl * 65 + ch], bb = BS[tl * 65 + ch]; Hh = a * Hh + bb; Pp *= a; }
                SEGP[seg * 64 + ch] = Pp; SEGH[seg * 64 + ch] = Hh;
            }
            __syncthreads();
            {
                float c = CAR[(ci & 1) * 64 + ch];
                for (int s = 0; s < seg; ++s) c = SEGP[s * 64 + ch] * c + SEGH[s * 64 + ch];
#pragma unroll
                for (int p = 0; p < 8; ++p) { const int pos = seg * 8 + p, tl = dir ? 63 - pos : pos; const float a = AS[tl * 65 + ch], bb = BS[tl * 65 + ch]; c = a * c + bb;
                    const size_t gi = (size_t)(b * SEQ + t0 + tl) * DM + n * 128 + hh * 64 + ch;
                    if (dir == 0) LO[gi] = f2bf(c);
                    else { const float hf = bf1(LO[gi]), gy = bf1(GY[gi]); LO[gi] = f2bf((hf + c) * gy); } }
                if (seg == 7) CAR[((ci + 1) & 1) * 64 + ch] = c;
            }
        }
        asm volatile("s_waitcnt vmcnt(0)" ::: "memory");
        __syncthreads();
    }
}
}

__device__ __forceinline__ void transpose_item(const float* W, int N, bf16_t* WT, int ldt, int k0, int n0, size_t drow0, LAS float* scr, int lane) {
#pragma unroll 8
    for (int i = 0; i < 32; ++i) { const int kk = 2 * i + (lane >> 5); scr[kk * 33 + (lane & 31)] = W[(size_t)(k0 + kk) * N + n0 + (lane & 31)]; }
    LDS_WAIT(); asm volatile("" ::: "memory");
    const int c = lane & 7;
#pragma unroll
    for (int j = 0; j < 4; ++j) { const int nn = (lane >> 3) + 8 * j; const LAS float* s = scr + (8 * c) * 33 + nn;
        u32x4 o; o.x = cvt_pk_bf16(s[0 * 33], s[1 * 33]); o.y = cvt_pk_bf16(s[2 * 33], s[3 * 33]); o.z = cvt_pk_bf16(s[4 * 33], s[5 * 33]); o.w = cvt_pk_bf16(s[6 * 33], s[7 * 33]);
        *(GAS u32x4*)(WT + (drow0 + nn) * ldt + k0 + 8 * c) = o; }
    LDS_WAIT(); asm volatile("" ::: "memory");
}
__device__ __forceinline__ void transpose_mat(const float* W, int K, int N, bf16_t* WT, size_t drow_base, int item, LAS float* scr, int lane) {
    const int nblk = N / 32, kb = item / nblk, nb = item % nblk;
    transpose_item(W, N, WT, K, 64 * kb, 32 * nb, drow_base + 32 * nb, scr, lane);
}
__device__ __forceinline__ int rel_bucket(int rel) {
    const int ret = rel > 0 ? 16 : 0; const int nabs = rel < 0 ? -rel : rel;
    if (nabs < 8) return ret + nabs;
    int large = (31 - __clz(nabs * nabs)) + 2; large = large < 15 ? large : 15;
    return ret + large;
}

struct Params { const float* in[26]; float* out; unsigned char* ws; int ph_lo, ph_hi; };

__global__ void __launch_bounds__(512, 2) mk_fwd(Params P) {
    extern __shared__ __attribute__((aligned(16))) unsigned char lds[];
    LAS unsigned char* ldsl = (LAS unsigned char*)lds;
    volatile LAS unsigned* MISC = (volatile LAS unsigned*)(ldsl + MISC_OFF);
    const int tid = threadIdx.x, lane = tid & 63, wave = __builtin_amdgcn_readfirstlane(tid >> 6);
    const int G = gridDim.x, bx = blockIdx.x;
    const int vcu = (G % 8 == 0) ? (bx % 8) * (G / 8) + bx / 8 : bx;
    unsigned char* ws = P.ws;
    if (tid < 32) MISC[tid] = 0u;
    __syncthreads();
    XcdBarrier bar; bar.bar = (unsigned*)(ws + WS_CTL) + CW_BAR; bar.x = 0; bar.st = nullptr;
    if (P.ph_hi - P.ph_lo > 1) bar = xcd_barrier_post((unsigned*)(ws + WS_CTL) + CW_BAR, MISC + 8);
    const int lo = P.ph_lo, hi = P.ph_hi;
#define IN(k) (lo <= (k) && (k) < hi)
#define BOTH(k) (IN(k) && IN((k) + 1))
    const float* x = P.in[0];
    bf16_t* RA = (bf16_t*)(ws + WS_RA); bf16_t* QB = (bf16_t*)(ws + WS_Q); bf16_t* KB = (bf16_t*)(ws + WS_K); bf16_t* VB = (bf16_t*)(ws + WS_V);
    bf16_t* XL = (bf16_t*)(ws + WS_XL); bf16_t* GY = (bf16_t*)(ws + WS_GY); bf16_t* LO = (bf16_t*)(ws + WS_LO);
    bf16_t* SA = (bf16_t*)P.out; bf16_t* SR = (bf16_t*)P.out + (size_t)MTOK * DM;
    bf16_t* WIN = (bf16_t*)(ws + WS_WIN); bf16_t* WCAT = (bf16_t*)(ws + WS_WCAT); bf16_t* WOUT = (bf16_t*)(ws + WS_WOUT); bf16_t* WLRU = (bf16_t*)(ws + WS_WLRU);
    bf16_t* WGU = (bf16_t*)(ws + WS_WGU); bf16_t* WDN = (bf16_t*)(ws + WS_WDN); bf16_t* HG = (bf16_t*)(ws + WS_HG);
    float* TBG = (float*)(ws + WS_TAB); float* MISCG = (float*)(ws + WS_TAB + 16384);
    float* AFF = (float*)(ws + WS_AFF); int* SELI = (int*)(ws + WS_SELI); float* SELV = (float*)(ws + WS_SELV);
    const int gw = vcu * 8 + wave, NGW = G * 8;

    if (IN(0)) {
        LAS float* scr = (LAS float*)(ldsl + wave * 16384);
        constexpr int I_IN = (DM / 64) * (DIN / 32), I_SQ = (DM / 64) * (DM / 32);
        for (int it = gw; it < I_IN + 3 * I_SQ; it += NGW) {
            int r = it;
            if (r < I_IN) { transpose_mat(P.in[2], DM, DIN, WIN, 0, r, scr, lane); continue; } r -= I_IN;
            if (r < I_SQ) { transpose_mat(P.in[18], DM, DM, WCAT, 0, r, scr, lane); continue; } r -= I_SQ;
            if (r < I_SQ) { transpose_mat(P.in[19], DM, DM, WCAT, DM, r, scr, lane); continue; } r -= I_SQ;
            transpose_mat(P.in[20], DM, DM, WOUT, 0, r, scr, lane);
        }
        for (int e = gw * 64 + lane; e < 2 * 8 * 2 * 4 * 32 * 128; e += NGW * 64) {
            const int k = e & 127, rho = (e >> 7) & 31, ct = (e >> 12) & 3, hh = (e >> 14) & 1, n = (e >> 15) & 7, dir = e >> 18;
            const int type = (rho >> 3) & 1, s = rho & 3, hi_ = (rho >> 2) & 1, q2 = rho >> 4;
            const int dcol = hh * 64 + ct * 16 + 8 * q2 + 4 * hi_ + s;
            const float* src = type ? P.in[15] : P.in[13];
            WLRU[e] = f2bf(src[(size_t)((dir * 8 + n) * 128 + k) * 128 + dcol]);
        }
        if (vcu == 0) {
            float gqm = 0.f, gkm = 0.f;
            for (int i = 0; i < 64; ++i) { gqm = fmaxf(gqm, fabsf(P.in[3][i])); gkm = fmaxf(gkm, fabsf(P.in[4][i])); }
            for (int e = tid; e < NH * 512; e += 512) { const int h = e >> 9, idx = e & 511;
                float bm = -1e30f; for (int bk = 0; bk < 32; ++bk) bm = fmaxf(bm, P.in[10][bk * NH + h]);
                const float Mh = 8.0f * gqm * gkm + bm;
                TBG[e] = (P.in[10][rel_bucket(idx - 256) * NH + h] - Mh) * LOG2E; }
            if (tid == 0) { float s1 = 0.f, s2 = 0.f; for (int i = 0; i < 64; ++i) { s1 += P.in[5][i] * P.in[6][i]; s2 += P.in[7][i] * P.in[8][i]; }
                MISCG[0] = __expf(s1) - __expf(s2) + 0.2f; }
        }
        for (int m = gw; m < MTOK; m += NGW) {
            const GAS f32x4* xr = (const GAS f32x4*)(x + (size_t)m * DM) + lane; const f32x4* gr = (const f32x4*)P.in[1] + lane;
            f32x4 v[4]; float s = 0.f;
#pragma unroll
            for (int j = 0; j < 4; ++j) { v[j] = xr[64 * j]; s += (v[j].x * v[j].x + v[j].y * v[j].y) + (v[j].z * v[j].z + v[j].w * v[j].w); }
            const float rs = __builtin_amdgcn_rsqf(wave_sum(s) * (1.0f / DM) + EPS);
            GAS u32x2* o8 = (GAS u32x2*)(RA + (size_t)m * DM) + lane;
#pragma unroll
            for (int j = 0; j < 4; ++j) { const f32x4 g = gr[64 * j]; u32x2 w; w.x = cvt_pk_bf16(v[j].x * rs * g.x, v[j].y * rs * g.y); w.y = cvt_pk_bf16(v[j].z * rs * g.z, v[j].w * rs * g.w); o8[64 * j] = w; }
        }
        if (BOTH(0)) xcd_barrier(bar);
    }

    if (IN(1)) {
        pg8::DenseOrder S{(const char*)RA, (const char*)WIN, DM, DM, MTOK / 256, DIN / 256, G, bx};
        pg8::EpiProj E{QB, KB, VB, XL, GY, SA, SR, P.in[3], P.in[4]};
        pg8::gemm_phase<pg8::EpiProj, pg8::DenseOrder, true, true>(ldsl, DM, S, E);
        if (BOTH(1)) xcd_barrier(bar);
    }

    if (IN(2)) {
        for (int u = vcu; u < 256; u += G)
            lru::lru_unit(u >> 4, (u >> 1) & 7, u & 1, XL, GY, LO, WLRU, P.in[11], P.in[12], P.in[14], P.in[16], P.in[17], (char*)lds);
        __syncthreads();
        const float lam = MISCG[0];
        for (int u = vcu; u < BATCH * NH * 16; u += G) {
            const int bh = (u >> 4), qb = u & 15;
            att::attn_unit(bh >> 3, bh & 7, qb, QB, KB, VB, RA, TBG, P.in[9], lam, (char*)lds);
        }
        if (BOTH(2)) xcd_barrier(bar);
    }

    if (IN(3)) {
        pg8::BranchOrder S{(const char*)RA, (long long)((const char*)LO - (const char*)RA), (const char*)WCAT, G, bx};
        pg8::EpiBranch E; E.sa = SA; E.sr = SR; E.mixed = XL;
        pg8::gemm_phase<pg8::EpiBranch, pg8::BranchOrder, true, true>(ldsl, DM, S, E);
        if (BOTH(3)) xcd_barrier(bar);
    }

    if (IN(4)) {
        pg8::DenseOrder S{(const char*)XL, (const char*)WOUT, DM, DM, MTOK / 256, DM / 256, G, bx};
        pg8::EpiOut E; E.x = x; E.out = P.out;
        pg8::gemm_phase<pg8::EpiOut, pg8::DenseOrder, true, true>(ldsl, DM, S, E);
        if (BOTH(4)) xcd_barrier(bar);
    }

    if (IN(5)) {
        LAS float* WR = (LAS float*)ldsl;
        LAS float* hrow = (LAS float*)(ldsl + 81920) + wave * 1024;
        for (int i = tid; i < DM * NE; i += 512) WR[(i >> 4) * 20 + (i & 15)] = P.in[22][i];
        __syncthreads();
        for (int m = gw; m < MTOK; m += NGW) {
            const GAS f32x4* xr = (const GAS f32x4*)(P.out + (size_t)m * DM) + lane; const f32x4* gr = (const f32x4*)P.in[21] + lane;
            f32x4 v[4]; float s = 0.f;
#pragma unroll
            for (int j = 0; j < 4; ++j) { v[j] = xr[64 * j]; s += (v[j].x * v[j].x + v[j].y * v[j].y) + (v[j].z * v[j].z + v[j].w * v[j].w); }
            const float rs = __builtin_amdgcn_rsqf(wave_sum(s) * (1.0f / DM) + EPS);
            GAS u32x2* o8 = (GAS u32x2*)(RA + (size_t)m * DM) + lane;
#pragma unroll
            for (int j = 0; j < 4; ++j) { const f32x4 g = gr[64 * j]; const f32x4 hv = v[j] * rs * g;
                u32x2 w; w.x = cvt_pk_bf16(hv.x, hv.y); w.y = cvt_pk_bf16(hv.z, hv.w); o8[64 * j] = w;
                *(LAS f32x4*)(hrow + 256 * j + 4 * lane) = hv; }
            LDS_WAIT();
            float part[16];
#pragma unroll
            for (int e = 0; e < 16; ++e) part[e] = 0.f;
#pragma unroll 4
            for (int k = 0; k < 16; ++k) { const int d = lane + 64 * k; const float hv = hrow[d]; const LAS f32x4* wp = (const LAS f32x4*)(WR + d * 20);
#pragma unroll
                for (int c = 0; c < 4; ++c) { const f32x4 w = wp[c]; part[4 * c + 0] += hv * w.x; part[4 * c + 1] += hv * w.y; part[4 * c + 2] += hv * w.z; part[4 * c + 3] += hv * w.w; } }
            float mx = -1e30f;
#pragma unroll
            for (int e = 0; e < 16; ++e) { part[e] = wave_sum(part[e]); mx = fmaxf(mx, part[e]); }
            float den = 0.f;
#pragma unroll
            for (int e = 0; e < 16; ++e) { part[e] = __expf(part[e] - mx); den += part[e]; }
            float pv = part[0];
#pragma unroll
            for (int e = 1; e < 16; ++e) pv = (lane == e) ? part[e] : pv;
            if (lane < 16) AFF[(size_t)((m >> 11) * NE + lane) * SEQ + (m & (SEQ - 1))] = pv / den;
            LDS_WAIT();
        }
        if (BOTH(5)) xcd_barrier(bar);
    }

    if (IN(6)) {
        LAS u64* sk = (LAS u64*)ldsl;
        for (int p = vcu; p < BATCH * NE; p += G) {
            for (int t = tid; t < SEQ; t += 512) sk[t] = ((u64)__float_as_uint(AFF[(size_t)p * SEQ + t]) << 32) | (u64)(0xFFFFFFFFu - (unsigned)t);
            __syncthreads();
            for (int k = 2; k <= SEQ; k <<= 1)
                for (int j = k >> 1; j > 0; j >>= 1) {
#pragma unroll
                    for (int t2 = 0; t2 < 2; ++t2) { const int t = tid + 512 * t2; const int i = ((t & ~(j - 1)) << 1) | (t & (j - 1)), l = i | j;
                        const u64 a = sk[i], bq = sk[l]; const bool desc = ((i & k) == 0);
                        if ((a < bq) == desc) { sk[i] = bq; sk[l] = a; } }
                    __syncthreads();
                }
            if (tid < CAP) { const u64 kv = sk[tid]; SELI[p * CAP + tid] = (int)(0xFFFFFFFFu - (unsigned)kv); SELV[p * CAP + tid] = __uint_as_float((unsigned)(kv >> 32)); }
            __syncthreads();
        }
        LAS float* scr = (LAS float*)(ldsl + 16384 + wave * 8704);
        constexpr int I_GU = (DM / 64) * (FFE / 32), I_DN = (FFE / 64) * (DM / 32);
        for (int it = gw; it < NE * (2 * I_GU + I_DN); it += NGW) {
            const int e = it / (2 * I_GU + I_DN); int r = it % (2 * I_GU + I_DN);
            if (r < 2 * I_GU) { const int up = r >= I_GU; if (up) r -= I_GU;
                const int nblk = FFE / 32, kb = r / nblk, nb = r % nblk, n0 = 32 * nb;
                const float* W = (up ? P.in[24] : P.in[23]) + (size_t)e * DM * FFE;
                const size_t drow0 = (size_t)e * 4096 + (size_t)(n0 >> 7) * 256 + (n0 & 127) + (up ? 128 : 0);
                transpose_item(W, FFE, WGU, DM, 64 * kb, n0, drow0, scr, lane);
            } else { r -= 2 * I_GU;
                transpose_mat(P.in[25] + (size_t)e * FFE * DM, FFE, DM, WDN, (size_t)e * DM, r, scr, lane); }
        }
        if (BOTH(6)) xcd_barrier(bar);
    }

    const bool pvalid = (G == 256);
    const int pj = bx / 8, pe = 2 * (bx % 8) + (pj >> 4), pb = pj & 15, pair = pb * NE + pe;

    if (IN(7)) {
        pg8::MoeUpOrder S{(const char*)RA, (const char*)WGU, SELI, pb, pe, pair, pvalid};
        pg8::EpiMoeUp E; E.hg = HG;
        pg8::gemm_phase<pg8::EpiMoeUp, pg8::MoeUpOrder, true, true>(ldsl, DM, S, E);
        if (BOTH(7)) xcd_barrier(bar);
    }

    if (IN(8)) {
        LAS int* idxL = (LAS int*)(ldsl + X_IDX_OFF); LAS float* valL = (LAS float*)(ldsl + X_IDX_OFF + 1024);
        if (tid < CAP) { idxL[tid] = pvalid ? SELI[pair * CAP + tid] : 0; valL[tid] = pvalid ? SELV[pair * CAP + tid] : 0.f; }
        __syncthreads();
        pg8::MoeDownOrder S{(const char*)HG, (const char*)WDN, pb, pe, pair, pvalid};
        pg8::EpiMoeDown E; E.out = P.out; E.scr = (LAS float*)(ldsl + X_SCR_OFF); E.idxL = idxL; E.valL = valL; E.b = pb;
        pg8::gemm_phase<pg8::EpiMoeDown, pg8::MoeDownOrder, true, true>(ldsl, FFE, S, E);
    }
#undef IN
#undef BOTH
}

extern "C" void kernel_launch(void* const* d_in, const int* in_sizes, int n_in, void* d_out, int out_size, void* d_ws, size_t ws_size, hipStream_t stream) {
    static int grid = 0;
    if (grid == 0) {
        if (n_in != 26 || in_sizes[0] != MTOK * DM || out_size != MTOK * DM || ws_size < WS_END) {
            fprintf(stderr, "kernel_launch: shape/workspace mismatch: n_in %d in0 %d out %d ws %zu (need %zu)\n", n_in, n_in > 0 ? in_sizes[0] : -1, out_size, ws_size, (size_t)WS_END); grid = -1; return; }
        int dev = 0, cus = 0;
        if (hipGetDevice(&dev) != hipSuccess || hipDeviceGetAttribute(&cus, hipDeviceAttributeMultiprocessorCount, dev) != hipSuccess) { grid = -1; return; }
        if (hipFuncSetAttribute((const void*)mk_fwd, hipFuncAttributeMaxDynamicSharedMemorySize, LDS_BYTES) != hipSuccess) { fprintf(stderr, "kernel_launch: hipFuncSetAttribute failed\n"); grid = -1; return; }
        int per_cu = 0;
        if (hipOccupancyMaxActiveBlocksPerMultiprocessor(&per_cu, (const void*)mk_fwd, 512, LDS_BYTES) != hipSuccess || per_cu < 1) fprintf(stderr, "kernel_launch: occupancy query says %d\n", per_cu);
        (void)hipGetLastError();
        grid = cus;
        if (grid != 256) fprintf(stderr, "kernel_launch: %d CUs; the MoE phases need 256\n", grid);
    }
    if (grid < 0) return;
    (void)hipMemsetAsync((char*)d_ws + WS_CTL, 0, CTL_ZERO_BYTES, stream);
    Params p{};
    for (int i = 0; i < 26; ++i) p.in[i] = (const float*)d_in[i];
    p.out = (float*)d_out; p.ws = (unsigned char*)d_ws;
#if MK_ONE_LAUNCH
    p.ph_lo = 0; p.ph_hi = NPHASE;
    hipLaunchKernelGGL(mk_fwd, dim3(grid), dim3(512), LDS_BYTES, stream, p);
#else
    for (int ph = 0; ph < NPHASE; ++ph) { p.ph_lo = ph; p.ph_hi = ph + 1; hipLaunchKernelGGL(mk_fwd, dim3(grid), dim3(512), LDS_BYTES, stream, p); }
#endif
    const hipError_t le = hipPeekAtLastError();
    if (le != hipSuccess) fprintf(stderr, "kernel_launch: launch failed: %s\n", hipGetErrorName(le));
}
```

```cpp
#include <hip/hip_runtime.h>
#include <cstdio>
#include <cstdint>

#define GAS __attribute__((address_space(1)))
#define LAS __attribute__((address_space(3)))
typedef unsigned short bf16_t;
typedef short bf16x8 __attribute__((ext_vector_type(8)));
typedef short s16x4 __attribute__((ext_vector_type(4)));
typedef float f32x2 __attribute__((ext_vector_type(2)));
typedef float f32x4 __attribute__((ext_vector_type(4)));
typedef float f32x16 __attribute__((ext_vector_type(16)));
typedef unsigned u32x2 __attribute__((ext_vector_type(2)));
typedef unsigned u32x4 __attribute__((ext_vector_type(4)));
typedef unsigned long long u64;
typedef int i32x8 __attribute__((ext_vector_type(8)));
typedef int i32x4 __attribute__((ext_vector_type(4)));

#ifndef MK_ONE_LAUNCH
#define MK_ONE_LAUNCH 1
#endif

constexpr int BATCH = 16, SEQ = 2048, DM = 1024, MTOK = BATCH * SEQ, NH = 8, DIN = 7168, NE = 16, CAP = 256, FFE = 2048;
constexpr float EPS = 1e-6f;
constexpr float LOG2E = 1.4426950408889634f;
constexpr int NPHASE = 11;

constexpr size_t MiB = 1u << 20;
constexpr size_t WS_CTL = 0, CTL_ZERO_BYTES = 64 * 1024;
constexpr size_t WS_TAB = 1 * MiB;
constexpr size_t WS_WIN = 2 * MiB;
constexpr size_t WS_WCAT = 16 * MiB;
constexpr size_t WS_WOUT = 20 * MiB;
constexpr size_t WS_WLRU = 22 * MiB;
constexpr size_t WS_AFF = 23 * MiB;
constexpr size_t WS_SELI = 25 * MiB;
constexpr size_t WS_SELV = 25 * MiB + 256 * 1024;
constexpr size_t WS_SELRS = 25 * MiB + 512 * 1024;
constexpr size_t WS_RS = 25 * MiB + 768 * 1024;
constexpr size_t WS_RA = 26 * MiB;
constexpr size_t WS_Q = 90 * MiB, WS_K = 154 * MiB, WS_V = 218 * MiB;
constexpr size_t WS_WGU = 90 * MiB;
constexpr size_t WS_WDN = 218 * MiB;
constexpr size_t WS_XL = 282 * MiB;
constexpr size_t WS_GY = 346 * MiB;
constexpr size_t WS_LO = 410 * MiB;
constexpr size_t WS_HG = 282 * MiB;
constexpr size_t WS_YE = 90 * MiB;
constexpr size_t WS_XN8 = 474 * MiB;
constexpr size_t WS_WIN8 = 506 * MiB;
constexpr size_t WS_H16 = 410 * MiB;
constexpr size_t WS_INV = 538 * MiB;
constexpr size_t WS_END = 539 * MiB;
constexpr int CW_BAR = 1024;

constexpr int RING_BYTES = 131072;
constexpr int X_SCR_OFF = 131072;
constexpr int X_IDX_OFF = X_SCR_OFF + 8 * 2304;
constexpr int MISC_OFF = X_IDX_OFF + 2048;
constexpr int LDS_BYTES = 152576;

typedef __bf16 bf16x2_t __attribute__((ext_vector_type(2)));
__device__ __forceinline__ unsigned cvt_pk_bf16(float lo, float hi) { const f32x2 v = {lo, hi}; const bf16x2_t b = __builtin_convertvector(v, bf16x2_t); return __builtin_bit_cast(unsigned, b); }
__device__ __forceinline__ float bf_lo(unsigned w) { return __uint_as_float(w << 16); }
__device__ __forceinline__ float bf_hi(unsigned w) { return __uint_as_float(w & 0xffff0000u); }
__device__ __forceinline__ float bf1(bf16_t b) { return __uint_as_float(((unsigned)b) << 16); }
__device__ __forceinline__ bf16_t f2bf(float f) { return (bf16_t)(cvt_pk_bf16(f, 0.f) & 0xffffu); }
__device__ __forceinline__ unsigned pk4_fp8(float a, float b, float c, float d) { int w = 0; w = __builtin_amdgcn_cvt_pk_fp8_f32(a, b, w, false); w = __builtin_amdgcn_cvt_pk_fp8_f32(c, d, w, true); return (unsigned)w; }
__device__ __forceinline__ int lane_id() { int r; asm volatile("v_mbcnt_lo_u32_b32 %0, -1, 0\n\tv_mbcnt_hi_u32_b32 %0, -1, %0" : "=v"(r)); return r; }
__device__ __forceinline__ float wave_sum(float v) {
#pragma unroll
    for (int o = 1; o < 64; o <<= 1) v += __shfl_xor(v, o);
    return v;
}
constexpr float GATE_Q = 255.996f, GATE_QI = 1.0f / 255.996f, GATE_QL = -7.99997745f;
template <int CTRL> __device__ __forceinline__ float dppf(float x) { return __uint_as_float((unsigned)__builtin_amdgcn_mov_dpp((int)__float_as_uint(x), CTRL, 0xF, 0xF, true)); }
__device__ __forceinline__ float row16_max(float x) { x = fmaxf(x, dppf<0xB1>(x)); x = fmaxf(x, dppf<0x4E>(x)); x = fmaxf(x, dppf<0x141>(x)); x = fmaxf(x, dppf<0x140>(x)); return x; }
__device__ __forceinline__ float row16_sum(float x) { x += dppf<0xB1>(x); x += dppf<0x4E>(x); x += dppf<0x141>(x); x += dppf<0x140>(x); return x; }
__device__ __forceinline__ float sigmoidf_(float x) { return __builtin_amdgcn_rcpf(1.0f + __builtin_amdgcn_exp2f(-x * LOG2E)); }
__device__ __forceinline__ float gelu_tanh(float y) { const float u = 0.7978845608028654f * (y + 0.044715f * y * y * y); return y * __builtin_amdgcn_rcpf(1.0f + __builtin_amdgcn_exp2f(-2.0f * LOG2E * u)); }
#define LDS_WAIT() asm volatile("s_waitcnt lgkmcnt(0)" ::: "memory")
#define VM_WAIT() asm volatile("s_waitcnt vmcnt(0)" ::: "memory")

#define XB_TMO      128
#define XB_XCNT(j)  (256  + 64 * (j))
#define XB_XSUB(j)  (1280 + 64 * (j))
#define XB_XGEN(j)  (2304 + 64 * (j))
#define XB_TOP      3328
#define XB_TOPGEN   3392
#define XCD_BAR_WORDS 3456
#define XB_SPIN_CAP (1u << 18)
__device__ __forceinline__ unsigned xb_ld(unsigned* p)              { return __hip_atomic_load(p, __ATOMIC_RELAXED, __HIP_MEMORY_SCOPE_AGENT); }
__device__ __forceinline__ unsigned xb_add(unsigned* p, unsigned v) { return __hip_atomic_fetch_add(p, v, __ATOMIC_RELAXED, __HIP_MEMORY_SCOPE_AGENT); }
__device__ __forceinline__ unsigned xb_xcc_id() { return (unsigned)__builtin_amdgcn_s_getreg((3 << 11) | 20) & 0xFu; }
#define XB_SPIN(cond, bar) do { unsigned _sp = 0; while (cond) { __builtin_amdgcn_s_sleep(1); \
    if ((++_sp & 255u) == 0u) { if (xb_ld(&(bar)[XB_TMO])) break; if (_sp > XB_SPIN_CAP) { atomicAdd(&(bar)[XB_TMO], 1u); break; } } } } while (0)
struct XcdBarrier { unsigned* bar; unsigned x; volatile LAS unsigned* st; };
__device__ __forceinline__ XcdBarrier xcd_barrier_post(unsigned* bar, volatile LAS unsigned* st) {
    XcdBarrier b; b.bar = bar; b.x = xb_xcc_id(); b.st = st;
    if (threadIdx.x == 0) (void)xb_add(&bar[XB_XCNT(b.x)], 1u);
    return b;
}
__device__ __forceinline__ void xcd_barrier_complete(unsigned* bar, unsigned x, unsigned& nloc, unsigned& nx) {
    const unsigned G = gridDim.x * gridDim.y * gridDim.z;
    unsigned sum, cnt, mine, sp = 0u;
    for (;;) {
        sum = 0u; cnt = 0u; mine = 0u;
#pragma unroll
        for (unsigned j = 0; j < 16; ++j) { const unsigned c = xb_ld(&bar[XB_XCNT(j)]); sum += c; cnt += (c > 0u) ? 1u : 0u; mine = (j == x) ? c : mine; }
        if (sum == G) break;
        __builtin_amdgcn_s_sleep(1);
        if ((++sp & 255u) == 0u) { if (xb_ld(&bar[XB_TMO])) break; if (sp > XB_SPIN_CAP) { atomicAdd(&bar[XB_TMO], 1u); break; } }
    }
    nloc = mine > 0u ? mine : 1u; nx = cnt > 0u ? cnt : 1u;
}
__device__ __forceinline__ int lane_id();
__device__ __forceinline__ void xcd_barrier(const XcdBarrier& b, const int wave) {
    asm volatile("s_waitcnt vmcnt(0)" ::: "memory");
    __syncthreads();
    if (wave == 0 && lane_id() == 0) {
        unsigned* bar = b.bar;
        __builtin_amdgcn_s_waitcnt(0);
        unsigned nloc = b.st[0], nx = b.st[1];
        if (nloc == 0u) { xcd_barrier_complete(bar, b.x, nloc, nx); b.st[0] = nloc; b.st[1] = nx; }
        const unsigned old = xb_add(&bar[XB_XSUB(b.x)], 1u);
        const unsigned gen = old / nloc;
        if (old + 1u == (gen + 1u) * nloc) {
            __builtin_amdgcn_fence(__ATOMIC_RELEASE, "agent");
            asm volatile("s_waitcnt vmcnt(0)" ::: "memory");
            const unsigned og = xb_add(&bar[XB_TOP], 1u);
            const unsigned tg = og / nx;
            if (og + 1u == (tg + 1u) * nx) xb_add(&bar[XB_TOPGEN], 1u);
            else XB_SPIN(xb_ld(&bar[XB_TOPGEN]) == tg, bar);
            __builtin_amdgcn_fence(__ATOMIC_ACQUIRE, "agent");
            xb_add(&bar[XB_XGEN(b.x)], 1u);
            asm volatile("s_waitcnt vmcnt(0)" ::: "memory");
        } else {
            XB_SPIN(xb_ld(&bar[XB_XGEN(b.x)]) == gen, bar);
            __builtin_amdgcn_fence(__ATOMIC_ACQUIRE, "agent");
            asm volatile("s_waitcnt vmcnt(0)" ::: "memory");
        }
    }
    __syncthreads();
}

namespace pg8 {
constexpr int BM = 256, BK = 64, HALF = 128, HTB = HALF * BK * 2, STAGE_BYTES = 8 * HTB, NXCD = 8, WGM = 8;
__host__ __device__ __forceinline__ int lds_byte(int r, int c) { const int st = (r >> 4) * 2 + (c >> 5), rr = r & 15, cc = c & 31, ob = rr * 64 + cc * 2; return st * 1024 + (ob ^ (((ob >> 9) & 1) << 5)); }
__host__ __device__ __forceinline__ void stage_rc(int b, int& R, int& C) { const int st = b / 1024, sb = b % 1024, swz = sb ^ (((sb >> 9) & 1) << 5); R = (st >> 1) * 16 + swz / 64; C = (st & 1) * 32 + (swz % 64) / 2; }
__host__ __device__ __forceinline__ int perm32(int rho) { const int n = rho >> 4, i = rho & 15; return 8 * (i >> 2) + 4 * n + (i & 3); }

struct Unit { int pm, pn, aux; const char* A; const char* B; const char* A2; };
__device__ __forceinline__ const char* uni(const char* p) {
    const unsigned long long v = (unsigned long long)p; const unsigned lo = __builtin_amdgcn_readfirstlane((unsigned)v), hi = __builtin_amdgcn_readfirstlane((unsigned)(v >> 32));
    return (const char*)(((unsigned long long)hi << 32) | lo);
}

__device__ __forceinline__ bool tile_of(int L, int nM, int nN, int& pm, int& pn) {
    const int nwg = nM * nN; if (L >= nwg) return false;
    int wgid = L; { const int q = nwg / NXCD, r = nwg % NXCD, xcd = wgid % NXCD, off = wgid / NXCD; wgid = (xcd < r ? xcd * (q + 1) : r * (q + 1) + (xcd - r) * q) + off; }
    const int nig = WGM * nN, gid = wgid / nig, fm = gid * WGM, gsz = (nM - fm) < WGM ? (nM - fm) : WGM;
    pm = fm + ((wgid % nig) % gsz); pn = (wgid % nig) / gsz; return true;
}

template <class Epi, class Sched, bool ALIGN_EPI, bool SP2, bool FP8 = false, int SCALE_B = 0x7f7f7f7f>
__device__ __forceinline__ void gemm_phase(LAS unsigned char* lds, const int KB  , const Sched& S, const Epi& E, const int wid  ) {
    const int lane = lane_id(), tid = wid * 64 + lane, wr = wid >> 2, wc = wid & 3, fr = lane & 15, fq = lane >> 4;
    const int nt = KB / (BK * 2);
    unsigned voffA[2][2], voffB[2];
#pragma unroll
    for (int i = 0; i < 2; ++i) { int R, C; stage_rc(tid * 16 + i * 8192, R, C);
        voffB[i] = (unsigned)(Epi::browmap(R) * KB + C * 2);
#pragma unroll
        for (int h = 0; h < 2; ++h) voffA[h][i] = S.aoff(R + HALF * h, C); }
    const size_t kstep = (size_t)(BK * 2);
    const size_t hstepB = (size_t)Epi::BHSTEP_ROWS * KB;
    const unsigned ldsw = (unsigned)wid * 1024u;
    const int aoff = lds_byte(wr * 64 + fr, fq * 8), boff = lds_byte(wc * 32 + fr, fq * 8);
#define PG8_SA(b, h) (((b) * 2 + (h)) * HTB)
#define PG8_SB(b, h) ((4 + (b) * 2 + (h)) * HTB)
#define PG8_STAGE_A(bufoff, gbase, h) do { _Pragma("unroll") for (int _i = 0; _i < 2; ++_i) { unsigned vo_ = voffA[h][_i]; asm volatile("" : "+v"(vo_)); \
        __builtin_amdgcn_global_load_lds((const unsigned*)((const char*)(gbase) + vo_), (LAS unsigned*)(lds + (bufoff) + ldsw + _i * 8192), 16, 0, 0); } } while (0)
#define PG8_STAGE_B(bufoff, gbase) do { _Pragma("unroll") for (int _i = 0; _i < 2; ++_i) { unsigned vo_ = voffB[_i]; asm volatile("" : "+v"(vo_)); \
        __builtin_amdgcn_global_load_lds((const unsigned*)((const char*)(gbase) + vo_), (LAS unsigned*)(lds + (bufoff) + ldsw + _i * 8192), 16, 0, 0); } } while (0)
#define PG8_LD8(p) __builtin_shufflevector(*(const LAS i32x4*)(p), *(const LAS i32x4*)((p) + 1024), 0, 1, 2, 3, 4, 5, 6, 7)
#define PG8_LDA(dst, b, h) do { _Pragma("unroll") for (int m = 0; m < 4; ++m) { if constexpr (FP8) { dst##8[m] = PG8_LD8(lds + PG8_SA(b, h) + aoff + m * 2048); } else { _Pragma("unroll") for (int k = 0; k < 2; ++k) dst[m][k] = *(const LAS bf16x8*)(lds + PG8_SA(b, h) + aoff + m * 2048 + k * 1024); } } } while (0)
#define PG8_LDB(dst, b, h) do { _Pragma("unroll") for (int n = 0; n < 2; ++n) { if constexpr (FP8) { dst##8[n] = PG8_LD8(lds + PG8_SB(b, h) + boff + n * 2048); } else { _Pragma("unroll") for (int k = 0; k < 2; ++k) dst[n][k] = *(const LAS bf16x8*)(lds + PG8_SB(b, h) + boff + n * 2048 + k * 1024); } } } while (0)
#define PG8_MMA(ai, bj, At, Bt) do { if constexpr (FP8) __builtin_amdgcn_sched_barrier(0); __builtin_amdgcn_s_setprio(1); _Pragma("unroll") for (int m = 0; m < 4; ++m) _Pragma("unroll") for (int n = 0; n < 2; ++n) { \
        if constexpr (FP8) { acc[ai][bj][m][n] = __builtin_amdgcn_mfma_scale_f32_16x16x128_f8f6f4(Bt##8[n], At##8[m], acc[ai][bj][m][n], 0, 0, 0, SCALE_B, 0, 0x7f7f7f7f); } \
        else { _Pragma("unroll") for (int k = 0; k < 2; ++k) acc[ai][bj][m][n] = __builtin_amdgcn_mfma_f32_16x16x32_bf16(Bt[n][k], At[m][k], acc[ai][bj][m][n], 0, 0, 0); } } \
        __builtin_amdgcn_s_setprio(0); if constexpr (FP8) __builtin_amdgcn_sched_barrier(0); } while (0)
#define PG8_WAIT_V(n) asm volatile("s_waitcnt vmcnt(" #n ")" ::: "memory")
#define PG8_WAIT_L(n) asm volatile("s_waitcnt lgkmcnt(" #n ")" ::: "memory")
#define PG8_BAR __builtin_amdgcn_s_barrier()
#define PG8_SCHED __builtin_amdgcn_sched_barrier(0)
    Unit cur, nxt; int ui = 0;
    if (!S.next(0, cur)) return;
    f32x4 acc[2][2][4][2];
#pragma unroll
    for (int a = 0; a < 2; ++a)
#pragma unroll
        for (int b = 0; b < 2; ++b)
#pragma unroll
            for (int m = 0; m < 4; ++m)
#pragma unroll
                for (int n = 0; n < 2; ++n) acc[a][b][m][n] = (f32x4){0.f, 0.f, 0.f, 0.f};
    bf16x8 At[4][2], B0[2][2], B1[2][2]; i32x8 At8[4], B08[2], B18[2];
    const char* cA = uni(cur.A); const char* cB = uni(cur.B); const char* cA2 = uni(cur.A2);
    if constexpr (SP2) {
        PG8_STAGE_B(PG8_SB(0, 0), cB); PG8_STAGE_B(PG8_SB(0, 1), cB + hstepB); PG8_STAGE_A(PG8_SA(0, 0), cA, 0); PG8_STAGE_A(PG8_SA(0, 1), cA, 1);
        if (wr == 1) PG8_BAR;
        PG8_WAIT_V(2); PG8_BAR;
        PG8_STAGE_B(PG8_SB(1, 0), cB + kstep); PG8_STAGE_A(PG8_SA(1, 0), cA + kstep, 0); PG8_STAGE_B(PG8_SB(1, 1), cB + hstepB + kstep);
        PG8_WAIT_V(6); PG8_BAR;
    } else {
        PG8_STAGE_B(PG8_SB(0, 0), cB); PG8_STAGE_A(PG8_SA(0, 0), cA, 0); PG8_STAGE_B(PG8_SB(0, 1), cB + hstepB); PG8_STAGE_A(PG8_SA(0, 1), cA, 1);
        if (wr == 1) PG8_BAR;
        PG8_WAIT_V(4); PG8_BAR;
        PG8_STAGE_B(PG8_SB(1, 0), cB + kstep); PG8_STAGE_A(PG8_SA(1, 0), cA + kstep, 0); PG8_STAGE_B(PG8_SB(1, 1), cB + hstepB + kstep);
        PG8_WAIT_V(6); PG8_BAR;
    }
    for (;;) {
        const bool has_next = S.next(ui + 1, nxt);
        const char* nA = uni(has_next ? nxt.A : cA); const char* nB = uni(has_next ? nxt.B : cB);
#pragma nounroll
        for (int t = 0; t < nt; t += 2) {
            const bool last = (t == nt - 2);
            const char* a1 = ((Sched::TSW && t + 1 >= Sched::TSW) ? cA2 : cA) + (size_t)(t + 1) * kstep;
            const char* a2 = last ? nA : ((Sched::TSW && t + 2 >= Sched::TSW) ? cA2 : cA) + (size_t)(t + 2) * kstep; const char* b2 = last ? nB : cB + (size_t)(t + 2) * kstep;
            const char* a3 = a2 + kstep; const char* b3 = b2 + kstep;
            if constexpr (Sched::TSW != 0) { if (t == Sched::TSW) { const int l2 = lane_id(); E.mid(acc, cur, wr, wc, l2 & 15, l2 >> 4); } }
            if constexpr (SP2) {
            PG8_LDB(B0, 0, 0); PG8_LDB(B1, 0, 1); PG8_SCHED; PG8_LDA(At, 0, 0); PG8_STAGE_A(PG8_SA(1, 1), a1, 1);
            PG8_WAIT_V(8); PG8_WAIT_L(0); PG8_BAR; PG8_MMA(0, 0, At, B0); PG8_MMA(0, 1, At, B1); PG8_BAR; PG8_SCHED;
            PG8_LDA(At, 0, 1); PG8_STAGE_B(PG8_SB(0, 0), b2); PG8_STAGE_B(PG8_SB(0, 1), b2 + hstepB); PG8_STAGE_A(PG8_SA(0, 0), a2, 0);
            PG8_WAIT_V(8); PG8_WAIT_L(0); PG8_BAR; PG8_MMA(1, 0, At, B0); PG8_MMA(1, 1, At, B1); PG8_BAR; PG8_SCHED;
            PG8_LDB(B0, 1, 0); PG8_LDB(B1, 1, 1); PG8_SCHED; PG8_LDA(At, 1, 0); PG8_STAGE_A(PG8_SA(0, 1), a2, 1);
            PG8_WAIT_V(8); PG8_WAIT_L(0); PG8_BAR; PG8_MMA(0, 0, At, B0); PG8_MMA(0, 1, At, B1); PG8_BAR; PG8_SCHED;
            PG8_LDA(At, 1, 1); PG8_STAGE_B(PG8_SB(1, 0), b3); PG8_STAGE_B(PG8_SB(1, 1), b3 + hstepB); PG8_STAGE_A(PG8_SA(1, 0), a3, 0);
            PG8_WAIT_V(8); PG8_WAIT_L(0); PG8_BAR; PG8_MMA(1, 0, At, B0); PG8_MMA(1, 1, At, B1); PG8_BAR; PG8_SCHED;
            } else {
            PG8_LDB(B0, 0, 0); PG8_SCHED; PG8_LDA(At, 0, 0); PG8_STAGE_A(PG8_SA(1, 1), a1, 1);
            PG8_WAIT_L(8); PG8_BAR; PG8_WAIT_L(0); PG8_MMA(0, 0, At, B0); PG8_BAR; PG8_SCHED;
            PG8_LDB(B1, 0, 1); PG8_STAGE_B(PG8_SB(0, 0), b2);
            PG8_BAR; PG8_WAIT_L(0); PG8_MMA(0, 1, At, B1); PG8_BAR;
            PG8_LDA(At, 0, 1); PG8_STAGE_A(PG8_SA(0, 0), a2, 0);
            PG8_BAR; PG8_WAIT_L(0); PG8_MMA(1, 0, At, B0); PG8_BAR; PG8_SCHED;
            PG8_STAGE_B(PG8_SB(0, 1), b2 + hstepB);
            PG8_WAIT_V(6); PG8_BAR; PG8_MMA(1, 1, At, B1); PG8_BAR;
            PG8_LDB(B0, 1, 0); PG8_SCHED; PG8_LDA(At, 1, 0); PG8_STAGE_A(PG8_SA(0, 1), a2, 1);
            PG8_WAIT_L(8); PG8_BAR; PG8_WAIT_L(0); PG8_MMA(0, 0, At, B0); PG8_BAR; PG8_SCHED;
            PG8_LDB(B1, 1, 1); PG8_STAGE_B(PG8_SB(1, 0), b3);
            PG8_BAR; PG8_WAIT_L(0); PG8_MMA(0, 1, At, B1); PG8_BAR;
            PG8_LDA(At, 1, 1); PG8_STAGE_A(PG8_SA(1, 0), a3, 0);
            PG8_BAR; PG8_WAIT_L(0); PG8_MMA(1, 0, At, B0); PG8_BAR; PG8_SCHED;
            PG8_STAGE_B(PG8_SB(1, 1), b3 + hstepB);
            PG8_WAIT_V(6); PG8_BAR; PG8_MMA(1, 1, At, B1); PG8_BAR;
            }
        }
        if constexpr (ALIGN_EPI) { if (wr == 0) PG8_BAR; }
        { const int l2 = lane_id(); E(acc, cur, wr, wc, l2 & 15, l2 >> 4, wid, l2); }
        if (!has_next) break;
#pragma unroll
        for (int a = 0; a < 2; ++a)
#pragma unroll
            for (int b = 0; b < 2; ++b)
#pragma unroll
                for (int m = 0; m < 4; ++m)
#pragma unroll
                    for (int n = 0; n < 2; ++n) acc[a][b][m][n] = (f32x4){0.f, 0.f, 0.f, 0.f};
        cur = nxt; cA = nA; cB = nB; cA2 = uni(cur.A2); ++ui;
        if constexpr (ALIGN_EPI) { if (wr == 1) PG8_BAR; }
    }
    PG8_WAIT_V(0);
    if constexpr (!ALIGN_EPI) { if (wr == 0) PG8_BAR; }
    PG8_BAR;
#undef PG8_SA
#undef PG8_SB
#undef PG8_STAGE_A
#undef PG8_STAGE_B
#undef PG8_LDA
#undef PG8_LDB
#undef PG8_MMA
#undef PG8_LD8
#undef PG8_WAIT_V
#undef PG8_WAIT_L
#undef PG8_BAR
#undef PG8_SCHED
}

struct DenseOrder {
    static constexpr int TSW = 0;
    const char* A; const char* Bt; int arow, brow, nM, nN, G, c;
    __device__ __forceinline__ unsigned aoff(int row, int C) const { return (unsigned)(row * arow + C * 2); }
    __device__ __forceinline__ bool next(int i, Unit& u) const {
        int pm, pn; if (!tile_of(i * G + c, nM, nN, pm, pn)) return false;
        u.pm = pm; u.pn = pn; u.aux = 0; u.A = A + (size_t)pm * BM * arow; u.A2 = u.A; u.B = Bt + (size_t)pn * BM * brow; return true;
    }
};
struct BranchOrder {
    static constexpr int TSW = 16;
    const char* A0; const char* A1; const char* Bt; int G, c;
    __device__ __forceinline__ unsigned aoff(int row, int C) const { return (unsigned)(row * DM + C) * 2u; }
    __device__ __forceinline__ bool next(int i, Unit& u) const {
        int pm, pn; if (!tile_of(i * G + c, MTOK / BM, DM / BM, pm, pn)) return false;
        u.pm = pm; u.pn = pn; u.aux = 0; u.A = A0 + (size_t)pm * BM * DM * 2; u.A2 = A1 + (size_t)pm * BM * DM * 2 - TSW * 128; u.B = Bt + (size_t)pn * BM * (2 * DM) * 2; return true;
    }
};
struct MoeUpOrder {
    static constexpr int TSW = 0;
    const char* hn; const char* wgu; const int* idx; int b, e, pair; bool valid;
    __device__ __forceinline__ unsigned aoff(int row, int C) const { const int tok = valid ? idx[pair * CAP + row] : 0; return (unsigned)((b * SEQ + tok) * DM + C * 2); }
    __device__ __forceinline__ bool next(int i, Unit& u) const {
        if (!valid || i >= 16) return false;
        u.pm = pair; u.pn = i; u.aux = 0; u.A = hn; u.A2 = hn; u.B = wgu + (size_t)((e * 16 + i) * 256) * DM; return true;
    }
};
struct MoeDownOrder {
    static constexpr int TSW = 0;
    const char* hg; const char* wdn; int c; bool valid;
    __device__ __forceinline__ unsigned aoff(int row, int C) const { return (unsigned)(row * FFE + C * 2); }
    __device__ __forceinline__ bool next(int i, Unit& u) const {
        if (!valid || i >= 4) return false;
        const int x = c & 7, j = c >> 3, nt = j & 3, q = i * 8 + (j >> 2), e = 2 * x + (q >> 4), b = q & 15, pair = b * NE + e;
        u.pm = pair; u.pn = nt; u.aux = i; u.A = hg + (size_t)pair * CAP * FFE; u.A2 = u.A; u.B = wdn + (size_t)(e * DM + nt * BM) * FFE; return true;
    }
};

struct EpiProj {
    static constexpr int BHSTEP_ROWS = 32;
    __host__ __device__ static __forceinline__ int browmap(int R) { return 64 * (R >> 5) + perm32(R & 31); }
    bf16_t *q, *k, *v, *xl, *gy; const LAS float* gl;
    __device__ __forceinline__ void operator()(const f32x4 (&acc)[2][2][4][2], const Unit& u, int wr, int wc, int fr, int fq, int wid, int lane) const {
        const int type = u.pn >> 2;
        const int row0 = u.pm * BM + wr * 64 + fr, col0 = (u.pn & 3) * 256 + 64 * wc + 8 * fq;
        bf16_t* dst = type == 0 ? q : type == 1 ? k : type == 2 ? v : type == 3 ? xl : gy;
        if (type < 2) {
            const LAS float* g = gl + type * 64;
            f32x4 gv[2][2];
#pragma unroll
            for (int bj = 0; bj < 2; ++bj)
#pragma unroll
                for (int n = 0; n < 2; ++n) gv[bj][n] = *(const LAS f32x4*)(g + 32 * bj + 8 * fq + 4 * n);
#pragma unroll
            for (int ai = 0; ai < 2; ++ai)
#pragma unroll
                for (int m = 0; m < 4; ++m) {
                    float ss = 0.f;
#pragma unroll
                    for (int bj = 0; bj < 2; ++bj)
#pragma unroll
                        for (int n = 0; n < 2; ++n) { const f32x4 x = acc[ai][bj][m][n]; ss += (x[0] * x[0] + x[1] * x[1]) + (x[2] * x[2] + x[3] * x[3]); }
                    { auto r16 = __builtin_amdgcn_permlane16_swap(__float_as_uint(ss), __float_as_uint(ss), false, false); ss = __uint_as_float(r16[0]) + __uint_as_float(r16[1]);
                      auto r32 = __builtin_amdgcn_permlane32_swap(__float_as_uint(ss), __float_as_uint(ss), false, false); ss = __uint_as_float(r32[0]) + __uint_as_float(r32[1]); }
                    const float rs = __builtin_amdgcn_rsqf(ss * (1.0f / 64.0f) + EPS) * (type == 0 ? 0.125f * LOG2E : 1.0f);
                    bf16_t* rowp = dst + (size_t)(row0 + ai * HALF + m * 16) * DM + col0;
#pragma unroll
                    for (int bj = 0; bj < 2; ++bj) { const f32x4 v0 = acc[ai][bj][m][0] * rs * gv[bj][0], v1 = acc[ai][bj][m][1] * rs * gv[bj][1];
                        u32x4 w; w.x = cvt_pk_bf16(v0[0], v0[1]); w.y = cvt_pk_bf16(v0[2], v0[3]); w.z = cvt_pk_bf16(v1[0], v1[1]); w.w = cvt_pk_bf16(v1[2], v1[3]);
                        *(u32x4*)(rowp + 32 * bj) = w; }
                }
        } else {
#pragma unroll
            for (int ai = 0; ai < 2; ++ai)
#pragma unroll
                for (int m = 0; m < 4; ++m) { bf16_t* rowp = dst + (size_t)(row0 + ai * HALF + m * 16) * DM + col0;
#pragma unroll
                    for (int bj = 0; bj < 2; ++bj) { f32x4 v0 = acc[ai][bj][m][0], v1 = acc[ai][bj][m][1];
                        if (type == 4) {
#pragma unroll
                            for (int j = 0; j < 4; ++j) { v0[j] = gelu_tanh(v0[j]); v1[j] = gelu_tanh(v1[j]); }
                        }
                        u32x4 w; w.x = cvt_pk_bf16(v0[0], v0[1]); w.y = cvt_pk_bf16(v0[2], v0[3]); w.z = cvt_pk_bf16(v1[0], v1[1]); w.w = cvt_pk_bf16(v1[2], v1[3]);
                        *(u32x4*)(rowp + 32 * bj) = w; } }
        }
    }
};
struct WideMap { static constexpr int BHSTEP_ROWS = 8; __host__ __device__ static __forceinline__ int browmap(int R) { return 64 * (R >> 5) + 16 * ((R >> 2) & 3) + 4 * ((R >> 4) & 1) + (R & 3); } };
struct EpiGate : WideMap {
    unsigned char *sa, *sr; float gsc;
    __device__ __forceinline__ void operator()(const f32x4 (&acc)[2][2][4][2], const Unit& u, int wr, int wc, int fr, int fq, int wid, int lane) const {
        int row0 = u.pm * BM + wr * 64 + fr; asm volatile("" : "+v"(row0));
        const int col0 = (u.pn & 3) * 256 + 64 * wc + 16 * fq;
        unsigned char* d8 = (u.pn >> 2) == 0 ? sa : sr;
        const float ke = -LOG2E * gsc;
#pragma unroll
        for (int ai = 0; ai < 2; ++ai)
#pragma unroll
            for (int m = 0; m < 4; ++m) { unsigned char* rowp = d8 + (unsigned)((row0 + ai * HALF + m * 16) * DM + col0);
                unsigned wd[4];
#pragma unroll
                for (int bj = 0; bj < 2; ++bj)
#pragma unroll
                    for (int n = 0; n < 2; ++n) { unsigned b[4];
#pragma unroll
                        for (int j = 0; j < 4; ++j) b[j] = (unsigned)(__builtin_amdgcn_rcpf(GATE_QI + __builtin_amdgcn_exp2f(acc[ai][bj][m][n][j] * ke + GATE_QL)));
                        wd[2 * bj + n] = (b[0] | (b[1] << 8)) | ((b[2] | (b[3] << 8)) << 16); }
                *(u32x4*)rowp = (u32x4){wd[0], wd[1], wd[2], wd[3]}; }
    }
};
struct EpiNull { static constexpr int BHSTEP_ROWS = 32; __host__ __device__ static __forceinline__ int browmap(int R) { return 64 * (R >> 5) + perm32(R & 31); }
    float* sink;
    __device__ __forceinline__ void operator()(const f32x4 (&acc)[2][2][4][2], const Unit& u, int wr, int wc, int fr, int fq, int wid, int lane) const {
        float s = 0.f;
#pragma unroll
        for (int ai = 0; ai < 2; ++ai)
#pragma unroll
            for (int bj = 0; bj < 2; ++bj)
#pragma unroll
                for (int m = 0; m < 4; ++m)
#pragma unroll
                    for (int n = 0; n < 2; ++n) s += acc[ai][bj][m][n][0] + acc[ai][bj][m][n][1] + acc[ai][bj][m][n][2] + acc[ai][bj][m][n][3];
        if (s == 123456.789f) sink[0] = s;
    } };
struct PermMap { static constexpr int BHSTEP_ROWS = 128; __host__ __device__ static __forceinline__ int browmap(int R) { return (R & ~31) + perm32(R & 31); } };
struct PlainMap { static constexpr int BHSTEP_ROWS = 128; __host__ __device__ static __forceinline__ int browmap(int R) { return R; } };

struct EpiBranch : PermMap {
    const unsigned char *sa, *sr; bf16_t* mixed;
#define GB(w, i) ((float)(((w) >> (8 * (i))) & 0xffu) + 0.5f)
    __device__ __forceinline__ void mid(f32x4 (&acc)[2][2][4][2], const Unit& u, int wr, int wc, int fr, int fq) const {
        int row0 = u.pm * BM + wr * 64 + fr; asm volatile("" : "+v"(row0));
        const int col0 = u.pn * BM + wc * 32 + 8 * fq;
        u32x2 ga[2][2], gg[2][2];
#define MID_LOAD(buf, grp) do { const unsigned off_ = (unsigned)((row0 + ((grp) >> 2) * HALF + ((grp) & 3) * 16) * DM + col0); \
            _Pragma("unroll") for (int bj = 0; bj < 2; ++bj) { ga[buf][bj] = *(const u32x2*)(sa + off_ + bj * HALF); gg[buf][bj] = *(const u32x2*)(sr + off_ + bj * HALF); } } while (0)
        MID_LOAD(0, 0);
#pragma unroll
        for (int grp = 0; grp < 8; ++grp) { const int ai = grp >> 2, m = grp & 3, cb = grp & 1;
            if (grp + 1 < 8) MID_LOAD(cb ^ 1, grp + 1);
            __builtin_amdgcn_sched_barrier(0);
#pragma unroll
            for (int bj = 0; bj < 2; ++bj) { const u32x2 a = ga[cb][bj], g = gg[cb][bj];
                f32x4& c0 = acc[ai][bj][m][0]; f32x4& c1 = acc[ai][bj][m][1];
                c0[0] *= GB(a.x, 0) * __builtin_amdgcn_rcpf(GB(g.x, 0)); c0[1] *= GB(a.x, 1) * __builtin_amdgcn_rcpf(GB(g.x, 1)); c0[2] *= GB(a.x, 2) * __builtin_amdgcn_rcpf(GB(g.x, 2)); c0[3] *= GB(a.x, 3) * __builtin_amdgcn_rcpf(GB(g.x, 3));
                c1[0] *= GB(a.y, 0) * __builtin_amdgcn_rcpf(GB(g.y, 0)); c1[1] *= GB(a.y, 1) * __builtin_amdgcn_rcpf(GB(g.y, 1)); c1[2] *= GB(a.y, 2) * __builtin_amdgcn_rcpf(GB(g.y, 2)); c1[3] *= GB(a.y, 3) * __builtin_amdgcn_rcpf(GB(g.y, 3)); }
            __builtin_amdgcn_sched_barrier(0); }
#undef MID_LOAD
    }
    __device__ __forceinline__ void operator()(const f32x4 (&acc)[2][2][4][2], const Unit& u, int wr, int wc, int fr, int fq, int wid, int lane) const {
        int row0 = u.pm * BM + wr * 64 + fr; asm volatile("" : "+v"(row0));
        const int col0 = u.pn * BM + wc * 32 + 8 * fq;
        u32x2 g[2][4][2];
#pragma unroll
        for (int ai = 0; ai < 2; ++ai)
#pragma unroll
            for (int m = 0; m < 4; ++m) { const unsigned off = (unsigned)((row0 + ai * HALF + m * 16) * DM + col0);
#pragma unroll
                for (int bj = 0; bj < 2; ++bj) g[ai][m][bj] = *(const u32x2*)(sr + off + bj * HALF); }
        __builtin_amdgcn_sched_barrier(0);
#pragma unroll
        for (int ai = 0; ai < 2; ++ai)
#pragma unroll
            for (int m = 0; m < 4; ++m) { const unsigned off = (unsigned)((row0 + ai * HALF + m * 16) * DM + col0);
#pragma unroll
                for (int bj = 0; bj < 2; ++bj) { const f32x4 a0 = acc[ai][bj][m][0] * GATE_QI, a1 = acc[ai][bj][m][1] * GATE_QI; const u32x2 gw = g[ai][m][bj];
                    u32x4 w; w.x = cvt_pk_bf16(a0[0] * GB(gw.x, 0), a0[1] * GB(gw.x, 1)); w.y = cvt_pk_bf16(a0[2] * GB(gw.x, 2), a0[3] * GB(gw.x, 3));
                    w.z = cvt_pk_bf16(a1[0] * GB(gw.y, 0), a1[1] * GB(gw.y, 1)); w.w = cvt_pk_bf16(a1[2] * GB(gw.y, 2), a1[3] * GB(gw.y, 3));
                    *(u32x4*)(mixed + off + bj * HALF) = w; } }
    }
#undef GB
};
struct EpiOut : PermMap {
    const float* x; bf16_t* h16;
    __device__ __forceinline__ void operator()(const f32x4 (&acc)[2][2][4][2], const Unit& u, int wr, int wc, int fr, int fq, int wid, int lane) const {
        int row0 = u.pm * BM + wr * 64 + fr; asm volatile("" : "+v"(row0));
        const int col0 = u.pn * BM + wc * 32 + 8 * fq;
#pragma unroll
        for (int ai = 0; ai < 2; ++ai) {
            f32x4 xv[4][2][2];
#pragma unroll
            for (int m = 0; m < 4; ++m) { const unsigned off = (unsigned)((row0 + ai * HALF + m * 16) * DM + col0);
#pragma unroll
                for (int bj = 0; bj < 2; ++bj) { xv[m][bj][0] = *(const f32x4*)(x + off + bj * HALF); xv[m][bj][1] = *(const f32x4*)(x + off + bj * HALF + 4); } }
            __builtin_amdgcn_sched_barrier(0);
#pragma unroll
            for (int m = 0; m < 4; ++m) { const unsigned off = (unsigned)((row0 + ai * HALF + m * 16) * DM + col0);
#pragma unroll
                for (int bj = 0; bj < 2; ++bj) { const f32x4 v0 = xv[m][bj][0] + acc[ai][bj][m][0], v1 = xv[m][bj][1] + acc[ai][bj][m][1];
                    u32x4 w; w.x = cvt_pk_bf16(v0[0], v0[1]); w.y = cvt_pk_bf16(v0[2], v0[3]); w.z = cvt_pk_bf16(v1[0], v1[1]); w.w = cvt_pk_bf16(v1[2], v1[3]);
                    *(u32x4*)(h16 + off + bj * HALF) = w; } }
            __builtin_amdgcn_sched_barrier(0);
        }
    }
};
struct EpiMoeUp : PermMap {
    unsigned char* hg; const LAS float* rsl;
    __device__ __forceinline__ void operator()(const f32x4 (&acc)[2][2][4][2], const Unit& u, int wr, int wc, int fr, int fq, int wid, int lane) const {
        int row0 = wr * 64 + fr; asm volatile("" : "+v"(row0));
        const int col0 = u.pn * 128 + wc * 32 + 8 * fq;
        unsigned char* base = hg + (size_t)u.pm * CAP * FFE;
        float scv[2][4];
#pragma unroll
        for (int ai = 0; ai < 2; ++ai)
#pragma unroll
            for (int m = 0; m < 4; ++m) scv[ai][m] = rsl[row0 + ai * HALF + m * 16];
#pragma unroll
        for (int ai = 0; ai < 2; ++ai)
#pragma unroll
            for (int m = 0; m < 4; ++m) { float r[8]; const float sc = scv[ai][m], sc2 = sc * sc, ke = -LOG2E * sc;
#pragma unroll
                for (int n = 0; n < 2; ++n)
#pragma unroll
                    for (int j = 0; j < 4; ++j) { const float ga = acc[ai][0][m][n][j]; r[4 * n + j] = (ga * acc[ai][1][m][n][j]) * (sc2 * __builtin_amdgcn_rcpf(1.0f + __builtin_amdgcn_exp2f(ga * ke))); }
                u32x2 w; w.x = pk4_fp8(r[0], r[1], r[2], r[3]); w.y = pk4_fp8(r[4], r[5], r[6], r[7]);
                *(u32x2*)(base + (unsigned)((row0 + ai * HALF + m * 16) * FFE + col0)) = w; }
    }
};
struct EpiMoeDown : WideMap {
    unsigned char* ye; const LAS float* vall;
    __device__ __forceinline__ void operator()(const f32x4 (&acc)[2][2][4][2], const Unit& u, int wr, int wc, int fr, int fq, int wid, int lane) const {
        int row0 = wr * 64 + fr; asm volatile("" : "+v"(row0));
        const int col0 = u.pn * BM + wc * 64 + 16 * fq;
        unsigned char* base = ye + (size_t)u.pm * CAP * DM;
        float vsv[2][4];
#pragma unroll
        for (int ai = 0; ai < 2; ++ai)
#pragma unroll
            for (int m = 0; m < 4; ++m) vsv[ai][m] = vall[u.aux * CAP + row0 + ai * HALF + m * 16];
#pragma unroll
        for (int ai = 0; ai < 2; ++ai)
#pragma unroll
            for (int m = 0; m < 4; ++m) { const int row = row0 + ai * HALF + m * 16; const float vs = vsv[ai][m];
                const f32x4 v0 = acc[ai][0][m][0] * vs, v1 = acc[ai][0][m][1] * vs, v2 = acc[ai][1][m][0] * vs, v3 = acc[ai][1][m][1] * vs;
                u32x4 w; w.x = pk4_fp8(v0[0], v0[1], v0[2], v0[3]); w.y = pk4_fp8(v1[0], v1[1], v1[2], v1[3]); w.z = pk4_fp8(v2[0], v2[1], v2[2], v2[3]); w.w = pk4_fp8(v3[0], v3[1], v3[2], v3[3]);
                *(u32x4*)(base + (unsigned)(row * DM + col0)) = w; }
    }
};
}

namespace att {
constexpr int KVBLK = 64, LD = DM;
constexpr int SHM_V = KVBLK * 128 * 2, SHM_K = KVBLK * 128 * 2;
constexpr int NBUF = 4, BUFB = SHM_V + SHM_K;
constexpr int TB_OFF = NBUF * BUFB;
constexpr int E_STRIDE = 132, E_BYTES = 128 * E_STRIDE * 4;
constexpr int LI_OFF = 2 * E_BYTES;
#define KSWZ(row, colB) ((row) * 256 + ((colB) ^ (((row) & 7) << 4)))
#define SBAR() __builtin_amdgcn_sched_barrier(0)
__device__ __forceinline__ int crow(int r, int hi) { return (r & 3) + 8 * (r >> 2) + 4 * hi; }
__device__ __forceinline__ int v_st(int k, int c) { const int kk = (k & ~0xC) | ((k & 4) << 1) | ((k & 8) >> 1); return ((kk >> 3) * 4 + (c >> 5)) * 512 + ((kk & 7) * 32 + (c & 31)) * 2; }
__device__ __forceinline__ int v_rd_base(int lane) { return ((lane & 3) << 3) | (((lane >> 2) & 3) << 6) | (((lane >> 4) & 1) << 5) | (((lane >> 5) & 1) << 8); }
constexpr int v_rd_off(int d0, int ks, int half) { return d0 * 512 + ks * 4096 + half * 2048; }
typedef short v4i16_t __attribute__((ext_vector_type(4)));
__device__ __forceinline__ s16x4 vtr(const LAS char* p) { return __builtin_bit_cast(s16x4, __builtin_amdgcn_ds_read_tr16_b64_v4i16((LAS v4i16_t*)p)); }
template <int OFF> __device__ __forceinline__ s16x4 tr_read(int vb) {
    s16x4 r; asm volatile("ds_read_b64_tr_b16 %0, %1 offset:%2" : "=&v"(r) : "v"(vb), "i"(OFF) : "memory"); return r;
}
template <int OFF> __device__ __forceinline__ bf16x8 lds_read128(int a) {
    bf16x8 r; asm volatile("ds_read_b128 %0, %1 offset:%2" : "=&v"(r) : "v"(a), "i"(OFF) : "memory"); return r;
}
template <int D0> __device__ __forceinline__ void pv_one(f32x16& od, int vb, bf16x8 pa0, bf16x8 pa1, bf16x8 pa2, bf16x8 pa3) {
    const s16x4 l0 = tr_read<v_rd_off(D0, 0, 0)>(vb), h0 = tr_read<v_rd_off(D0, 0, 1)>(vb), l1 = tr_read<v_rd_off(D0, 1, 0)>(vb), h1 = tr_read<v_rd_off(D0, 1, 1)>(vb);
    const s16x4 l2 = tr_read<v_rd_off(D0, 2, 0)>(vb), h2 = tr_read<v_rd_off(D0, 2, 1)>(vb), l3 = tr_read<v_rd_off(D0, 3, 0)>(vb), h3 = tr_read<v_rd_off(D0, 3, 1)>(vb);
    asm volatile("s_waitcnt lgkmcnt(0)" ::: "memory"); SBAR();
#define PK(L, H) (bf16x8){L[0], L[1], L[2], L[3], H[0], H[1], H[2], H[3]}
    od = __builtin_amdgcn_mfma_f32_32x32x16_bf16(pa0, PK(l0, h0), od, 0, 0, 0);
    od = __builtin_amdgcn_mfma_f32_32x32x16_bf16(pa1, PK(l1, h1), od, 0, 0, 0);
    od = __builtin_amdgcn_mfma_f32_32x32x16_bf16(pa2, PK(l2, h2), od, 0, 0, 0);
    od = __builtin_amdgcn_mfma_f32_32x32x16_bf16(pa3, PK(l3, h3), od, 0, 0, 0);
#undef PK
}
__device__ __forceinline__ void pv_d0(f32x16* o, int vb, bf16x8 pa0, bf16x8 pa1, bf16x8 pa2, bf16x8 pa3) {
    pv_one<0>(o[0], vb, pa0, pa1, pa2, pa3); pv_one<1>(o[1], vb, pa0, pa1, pa2, pa3); pv_one<2>(o[2], vb, pa0, pa1, pa2, pa3); pv_one<3>(o[3], vb, pa0, pa1, pa2, pa3);
}
template <int VAR = 0> __device__ __forceinline__ void qkt(f32x16& p0, f32x16& p1, const char* Ks, const bf16x8* qr, int r32, int hi, int mm, const float* Tb, int drel, const f32x16& cvec) {
    if constexpr (VAR == 3) { p0 = cvec; p1 = cvec; return; }
    const bool far = (drel >= 122 || drel <= -154);
    if (!far) {
        const float* tb = Tb + (drel + 256 - r32 + 4 * hi);
#pragma unroll
        for (int r = 0; r < 16; ++r) { const int o = (r & 3) + 8 * (r >> 2); p0[r] = tb[o]; p1[r] = tb[o + 32]; }
    }
    { const int cb = (mm * 64 + hi * 8) * 2;
      const bf16x8 b0 = *reinterpret_cast<const bf16x8*>(Ks + KSWZ(r32, cb));
      const bf16x8 b1 = *reinterpret_cast<const bf16x8*>(Ks + KSWZ(32 + r32, cb));
      if (far) { p0 = __builtin_amdgcn_mfma_f32_32x32x16_bf16(b0, qr[0], cvec, 0, 0, 0); p1 = __builtin_amdgcn_mfma_f32_32x32x16_bf16(b1, qr[0], cvec, 0, 0, 0); }
      else     { p0 = __builtin_amdgcn_mfma_f32_32x32x16_bf16(b0, qr[0], p0, 0, 0, 0);   p1 = __builtin_amdgcn_mfma_f32_32x32x16_bf16(b1, qr[0], p1, 0, 0, 0); } }
#pragma unroll
    for (int d0 = 1; d0 < 4; ++d0) { const int cb = (mm * 64 + d0 * 16 + hi * 8) * 2;
        const bf16x8 b0 = *reinterpret_cast<const bf16x8*>(Ks + KSWZ(r32, cb));
        const bf16x8 b1 = *reinterpret_cast<const bf16x8*>(Ks + KSWZ(32 + r32, cb));
        p0 = __builtin_amdgcn_mfma_f32_32x32x16_bf16(b0, qr[d0], p0, 0, 0, 0);
        p1 = __builtin_amdgcn_mfma_f32_32x32x16_bf16(b1, qr[d0], p1, 0, 0, 0); }
}
template <class F> __device__ __forceinline__ void qkt2(f32x16& p0, f32x16& p1, const char* Ks, const bf16x8* qr, int r32, int hi, int mm, const float* Tb, int drel, const f32x16& cvec, F&& gap) {
    const bool far = (drel >= 122 || drel <= -154);
    bf16x8 kf[8];
#pragma unroll
    for (int d0 = 0; d0 < 4; ++d0) { const int cb = (mm * 64 + d0 * 16 + hi * 8) * 2;
        kf[2 * d0] = *reinterpret_cast<const bf16x8*>(Ks + KSWZ(r32, cb)); kf[2 * d0 + 1] = *reinterpret_cast<const bf16x8*>(Ks + KSWZ(32 + r32, cb)); }
    SBAR();
    if (!far) {
        const float* tb = Tb + (drel + 256 - r32 + 4 * hi);
#pragma unroll
        for (int r = 0; r < 16; ++r) { const int o = (r & 3) + 8 * (r >> 2); p0[r] = tb[o]; p1[r] = tb[o + 32]; }
        p0 = __builtin_amdgcn_mfma_f32_32x32x16_bf16(kf[0], qr[0], p0, 0, 0, 0); p1 = __builtin_amdgcn_mfma_f32_32x32x16_bf16(kf[1], qr[0], p1, 0, 0, 0);
    } else { p0 = __builtin_amdgcn_mfma_f32_32x32x16_bf16(kf[0], qr[0], cvec, 0, 0, 0); p1 = __builtin_amdgcn_mfma_f32_32x32x16_bf16(kf[1], qr[0], cvec, 0, 0, 0); }
    gap(0); gap(1); SBAR();
#pragma unroll
    for (int d0 = 1; d0 < 4; ++d0) {
        p0 = __builtin_amdgcn_mfma_f32_32x32x16_bf16(kf[2 * d0], qr[d0], p0, 0, 0, 0); gap(2 * d0); SBAR();
        p1 = __builtin_amdgcn_mfma_f32_32x32x16_bf16(kf[2 * d0 + 1], qr[d0], p1, 0, 0, 0); gap(2 * d0 + 1); SBAR(); }
}
__device__ __forceinline__ void partialSM(f32x16& p0) {
#pragma unroll
    for (int r = 0; r < 16; ++r) p0[r] = __builtin_amdgcn_exp2f(p0[r]);
}
__device__ __forceinline__ void finishSM(f32x16& p0, f32x16& p1, float& l_reg, bf16x8& pa0, bf16x8& pa1, bf16x8& pa2, bf16x8& pa3) {
#pragma unroll
    for (int r = 0; r < 16; ++r) p1[r] = __builtin_amdgcn_exp2f(p1[r]);
    float ps = 0;
#pragma unroll
    for (int r = 0; r < 16; ++r) ps += p0[r];
#pragma unroll
    for (int r = 0; r < 16; ++r) ps += p1[r];
    { auto rr = __builtin_amdgcn_permlane32_swap(__float_as_uint(ps), __float_as_uint(ps), false, false);
      ps = __uint_as_float(rr[0]) + __uint_as_float(rr[1]); }
    l_reg += ps;
#define PK4(P, BASE, OUT) do { unsigned a0 = cvt_pk_bf16(P[BASE + 0], P[BASE + 1]), a1 = cvt_pk_bf16(P[BASE + 2], P[BASE + 3]);   \
    unsigned b0 = cvt_pk_bf16(P[BASE + 4], P[BASE + 5]), b1 = cvt_pk_bf16(P[BASE + 6], P[BASE + 7]);                              \
    auto r0 = __builtin_amdgcn_permlane32_swap(a0, b0, false, false); auto r1 = __builtin_amdgcn_permlane32_swap(a1, b1, false, false); \
    u32x4 w = {r0[0], r1[0], r0[1], r1[1]}; OUT = *reinterpret_cast<bf16x8*>(&w); } while (0)
    PK4(p0, 0, pa0); PK4(p0, 8, pa1); PK4(p1, 0, pa2); PK4(p1, 8, pa3);
#undef PK4
}

constexpr int E2_OFF = 2 * BUFB, E2_STRIDE = 136, E2_BYTES = 128 * E2_STRIDE * 2;
constexpr int LI2_OFF = E2_OFF + 2 * E2_BYTES, TB2_OFF = LI2_OFF + 2048, GS_OFF = TB2_OFF + 2048;
template <int NTL, int VAR = 0> __device__ __forceinline__ void attn_phase(int vcu, int G, const bf16_t* __restrict__ Qb, const bf16_t* __restrict__ Kb, const bf16_t* __restrict__ Vb, bf16_t* __restrict__ Ob,
                                          const float* __restrict__ TbG, const float* __restrict__ gsub, float lam, char* lds, const int wid) {
    const int lane = lane_id(), tid = wid * 64 + lane, r32 = lane & 31, hi = lane >> 5, rg = wid & 3, mm = wid >> 2;
    constexpr int NUNITS = BATCH * NH * 16;
    if (vcu >= NUNITS) return;
    char* V_lds = lds; char* K_lds = lds + SHM_V; float* Tb = (float*)(lds + TB2_OFF); float* GS = (float*)(lds + GS_OFF);
    unsigned offK[2], offV[2];
#pragma unroll
    for (int i = 0; i < 2; ++i) { const int pc = 2 * wid + i;
        { const int row = pc * 4 + (lane >> 4), c = (lane & 15) ^ (row & 7); offK[i] = (unsigned)(row * LD + c * 8) * 2u; }
        { const int sub = pc * 2 + (lane >> 5), kk = (sub >> 2) * 8 + ((lane & 31) >> 2), k = (kk & ~0xC) | ((kk & 4) << 1) | ((kk & 8) >> 1), col = (sub & 3) * 32 + (lane & 3) * 8; offV[i] = (unsigned)(k * LD + col) * 2u; } }
    LAS unsigned char* ldsl_ = (LAS unsigned char*)(unsigned char*)lds;
    const int vb0 = (int)(uintptr_t)V_lds + v_rd_base(lane);
    const LAS char* vbase = (const LAS char*)(LAS unsigned char*)(unsigned char*)V_lds + v_rd_base(lane);
#define DMA(Kh_, Vh_, t, boff) do { if constexpr (VAR == 5) break; const char* kt_ = (Kh_) + (size_t)(t) * (KVBLK * LD * 2); const char* vt_ = (Vh_) + (size_t)(t) * (KVBLK * LD * 2); \
        _Pragma("unroll") for (int i_ = 0; i_ < 2; ++i_) { \
            __builtin_amdgcn_global_load_lds((const unsigned*)(vt_ + offV[i_]), (LAS unsigned*)(ldsl_ + (boff) + (2 * wid + i_) * 1024), 16, 0, 0); \
            __builtin_amdgcn_global_load_lds((const unsigned*)(kt_ + offK[i_]), (LAS unsigned*)(ldsl_ + (boff) + SHM_V + (2 * wid + i_) * 1024), 16, 0, 0); } } while (0)
#define WBAR(N) do { asm volatile("s_waitcnt vmcnt(" #N ") lgkmcnt(0)" ::: "memory"); if constexpr (VAR != 7) __builtin_amdgcn_s_barrier(); asm volatile("" ::: "memory"); } while (0)
#define VRDSET(V, D0, boff) do { if constexpr (VAR == 4) break; _Pragma("unroll") for (int ks_ = 0; ks_ < 4; ++ks_) { V[2 * ks_] = vtr(vbase + (boff) + v_rd_off(D0, ks_, 0)); V[2 * ks_ + 1] = vtr(vbase + (boff) + v_rd_off(D0, ks_, 1)); } } while (0)
#define VFRAG(V, ks) (bf16x8){V[2 * (ks)][0], V[2 * (ks)][1], V[2 * (ks)][2], V[2 * (ks)][3], V[2 * (ks) + 1][0], V[2 * (ks) + 1][1], V[2 * (ks) + 1][2], V[2 * (ks) + 1][3]}
#define PIECE(P, B, q) do { if constexpr (VAR != 1) { P[(B) + 2 * (q)] = __builtin_amdgcn_exp2f(P[(B) + 2 * (q)]); P[(B) + 2 * (q) + 1] = __builtin_amdgcn_exp2f(P[(B) + 2 * (q) + 1]); } \
        ps += P[(B) + 2 * (q)]; ps += P[(B) + 2 * (q) + 1]; cq[q] = cvt_pk_bf16(P[(B) + 2 * (q)], P[(B) + 2 * (q) + 1]); } while (0)
#define PFIN(OUT) do { auto r0_ = __builtin_amdgcn_permlane32_swap(cq[0], cq[2], false, false); auto r1_ = __builtin_amdgcn_permlane32_swap(cq[1], cq[3], false, false); \
        u32x4 w_ = {r0_[0], r1_[0], r0_[1], r1_[1]}; OUT = *reinterpret_cast<bf16x8*>(&w_); } while (0)
#define PVBLOCK(D0, VC, VN, P, B, OUT, boff) do { \
        if ((D0) < 3) VRDSET(VN, (D0) + 1, boff); \
        if constexpr (VAR != 2) o[D0] = __builtin_amdgcn_mfma_f32_32x32x16_bf16(pa0, VFRAG(VC, 0), o[D0], 0, 0, 0); PIECE(P, B, 0); SBAR(); \
        if constexpr (VAR != 2) o[D0] = __builtin_amdgcn_mfma_f32_32x32x16_bf16(pa1, VFRAG(VC, 1), o[D0], 0, 0, 0); PIECE(P, B, 1); SBAR(); \
        if constexpr (VAR != 2) o[D0] = __builtin_amdgcn_mfma_f32_32x32x16_bf16(pa2, VFRAG(VC, 2), o[D0], 0, 0, 0); PIECE(P, B, 2); SBAR(); \
        if constexpr (VAR != 2) o[D0] = __builtin_amdgcn_mfma_f32_32x32x16_bf16(pa3, VFRAG(VC, 3), o[D0], 0, 0, 0); PIECE(P, B, 3); PFIN(OUT); SBAR(); } while (0)
#define LSUM() do { auto rr_ = __builtin_amdgcn_permlane32_swap(__float_as_uint(ps), __float_as_uint(ps), false, false); l_reg += __uint_as_float(rr_[0]) + __uint_as_float(rr_[1]); ps = 0.f; } while (0)
#define UNIT_PTRS(u_, b_, h_, q0_, Kh_, Vh_, Qw_) const int b_ = (u_) >> 7, h_ = ((u_) >> 4) & 7, q0_ = ((u_) & 15) * 128; \
        const char* Kh_ = (const char*)(Kb + (size_t)(b_ * SEQ) * LD + h_ * 128); const char* Vh_ = (const char*)(Vb + (size_t)(b_ * SEQ) * LD + h_ * 128); \
        const bf16_t* Qw_ = Qb + (size_t)(b_ * SEQ + q0_ + rg * 32 + r32) * LD + h_ * 128 + mm * 64 + hi * 8
    constexpr int NT = NTL;
    bf16x8 qr[4]; int htab = -1;
    { UNIT_PTRS(vcu, b0_, h0_, q00_, Kh0_, Vh0_, Qw0_);
      DMA(Kh0_, Vh0_, 0, 0); if (NT > 1) DMA(Kh0_, Vh0_, 1, BUFB);
#pragma unroll
      for (int d0 = 0; d0 < 4; ++d0) qr[d0] = *reinterpret_cast<const bf16x8*>(Qw0_ + d0 * 16);
      if (tid < 128) GS[tid] = gsub[tid]; }
    for (int u = vcu; u < NUNITS; u += G) {
        UNIT_PTRS(u, b, h, q0, Kh, Vh, Qw); (void)Qw;
        const int q0w = q0 + rg * 32;
        if (h != htab) { const int t2 = wid * 64 + lane_id(); Tb[t2] = TbG[h * 512 + t2]; htab = h; }
        const float Tl = TbG[h * 512 + 0];
        f32x16 o[4] = {}; float l_reg = 0.f, ps = 0.f;
        f32x16 pC0, pC1; bf16x8 pa0, pa1, pa2, pa3, pn0, pn1, pn2, pn3;
        s16x4 VA[8], VB[8]; unsigned cq[4];
        if constexpr (VAR == 4) {
#pragma unroll
            for (int i = 0; i < 8; ++i) { VA[i] = s16x4{}; VB[i] = s16x4{}; } }
        f32x16 cvec;
#pragma unroll
        for (int r = 0; r < 16; ++r) cvec[r] = Tl;
        WBAR(0);
        if (NT > 2) DMA(Kh, Vh, 2, 2 * BUFB);
        { const int l5 = lane_id(); qkt<VAR>(pC0, pC1, K_lds, qr, l5 & 31, l5 >> 5, mm, Tb, 0 - q0w, cvec); }
        PIECE(pC0, 0, 0); PIECE(pC0, 0, 1); PIECE(pC0, 0, 2); PIECE(pC0, 0, 3); PFIN(pa0);
        PIECE(pC0, 8, 0); PIECE(pC0, 8, 1); PIECE(pC0, 8, 2); PIECE(pC0, 8, 3); PFIN(pa1);
        PIECE(pC1, 0, 0); PIECE(pC1, 0, 1); PIECE(pC1, 0, 2); PIECE(pC1, 0, 3); PFIN(pa2);
        PIECE(pC1, 8, 0); PIECE(pC1, 8, 1); PIECE(pC1, 8, 2); PIECE(pC1, 8, 3); PFIN(pa3);
        LSUM();
        if (NT > 2) WBAR(4); else WBAR(0);
        for (int j = 1; j < NT; ++j) {
            const int bp = ((j - 1) & 3) * BUFB, bc = (j & 3) * BUFB;
            if (j + 2 < NT) DMA(Kh, Vh, j + 2, ((j + 2) & 3) * BUFB);
            if constexpr (VAR == 6) { if (j + 2 < NT) WBAR(4); else WBAR(0); continue; }
            SBAR(); VRDSET(VA, 0, bp);
            { const int drel = j * KVBLK - q0w; if (drel >= 122 && drel < 122 + KVBLK) {
                const float Tr = Tb[511];
#pragma unroll
                for (int r = 0; r < 16; ++r) cvec[r] = Tr; } }
            qkt<VAR>(pC0, pC1, K_lds + bc, qr, r32, hi, mm, Tb, j * KVBLK - q0w, cvec); SBAR();
            PVBLOCK(0, VA, VB, pC0, 0, pn0, bp);
            PVBLOCK(1, VB, VA, pC0, 8, pn1, bp);
            PVBLOCK(2, VA, VB, pC1, 0, pn2, bp);
            PVBLOCK(3, VB, VA, pC1, 8, pn3, bp);
            LSUM();
            pa0 = pn0; pa1 = pn1; pa2 = pn2; pa3 = pn3;
            if (j + 2 < NT) WBAR(4); else WBAR(0);
        }
        pv_d0(o, vb0 + ((NT - 1) & 3) * BUFB, pa0, pa1, pa2, pa3);
        float* li_l = (float*)(lds + LI2_OFF) + wid * 64;
        { const int l3 = lane_id(); if (l3 < 32) li_l[l3] = l_reg; }
        WBAR(0);
        const int un = u + G;
        if (un < NUNITS) {
            const int bn_ = un >> 7, hn_ = (un >> 4) & 7, q0n_ = (un & 15) * 128; const int l4 = lane_id();
            const char* Khn_ = (const char*)(Kb + (size_t)(bn_ * SEQ) * LD + hn_ * 128); const char* Vhn_ = (const char*)(Vb + (size_t)(bn_ * SEQ) * LD + hn_ * 128);
            const bf16_t* Qwn_ = Qb + (size_t)(bn_ * SEQ + q0n_ + rg * 32 + (l4 & 31)) * LD + hn_ * 128 + mm * 64 + (l4 >> 5) * 8;
            DMA(Khn_, Vhn_, 0, 0); if (NT > 1) DMA(Khn_, Vhn_, 1, BUFB);
#pragma unroll
            for (int d0 = 0; d0 < 4; ++d0) qr[d0] = *reinterpret_cast<const bf16x8*>(Qwn_ + d0 * 16);
        }
        const float fsc = mm ? lam : 1.0f;
        bf16_t* Em = (bf16_t*)(lds + E2_OFF + mm * E2_BYTES);
#pragma unroll
        for (int r = 0; r < 16; ++r) { const int orow = crow(r, hi); const float f = fsc * __builtin_amdgcn_rcpf(li_l[orow]);
#pragma unroll
            for (int d0 = 0; d0 < 4; ++d0) Em[(rg * 32 + orow) * E2_STRIDE + d0 * 32 + r32] = f2bf(o[d0][r] * f); }
        asm volatile("s_waitcnt lgkmcnt(0)" ::: "memory"); if constexpr (VAR != 7) __builtin_amdgcn_s_barrier(); asm volatile("" ::: "memory");
        {
            const int row = tid >> 2, qt = tid & 3;
            const bf16_t* e0 = (const bf16_t*)(lds + E2_OFF) + row * E2_STRIDE + qt * 32; const bf16_t* e1 = e0 + E2_BYTES / 2;
            float d[32]; float ss = 0.f;
#pragma unroll
            for (int c = 0; c < 4; ++c) { const u32x4 a = *(const u32x4*)(e0 + 8 * c), bq = *(const u32x4*)(e1 + 8 * c);
                d[8 * c + 0] = bf_lo(a.x) - bf_lo(bq.x); d[8 * c + 1] = bf_hi(a.x) - bf_hi(bq.x); d[8 * c + 2] = bf_lo(a.y) - bf_lo(bq.y); d[8 * c + 3] = bf_hi(a.y) - bf_hi(bq.y);
                d[8 * c + 4] = bf_lo(a.z) - bf_lo(bq.z); d[8 * c + 5] = bf_hi(a.z) - bf_hi(bq.z); d[8 * c + 6] = bf_lo(a.w) - bf_lo(bq.w); d[8 * c + 7] = bf_hi(a.w) - bf_hi(bq.w); }
#pragma unroll
            for (int c = 0; c < 32; ++c) ss += d[c] * d[c];
            ss += __shfl_xor(ss, 1); ss += __shfl_xor(ss, 2);
            const float rs = __builtin_amdgcn_rsqf(ss * (1.0f / 128.0f) + EPS) * 0.8f;
            bf16_t* op = Ob + (size_t)(b * SEQ + q0 + row) * LD + h * 128 + qt * 32;
            const float* gq = GS + qt * 32;
#pragma unroll
            for (int c = 0; c < 4; ++c) {
                u32x4 w; w.x = cvt_pk_bf16(d[8 * c + 0] * rs * gq[8 * c + 0], d[8 * c + 1] * rs * gq[8 * c + 1]); w.y = cvt_pk_bf16(d[8 * c + 2] * rs * gq[8 * c + 2], d[8 * c + 3] * rs * gq[8 * c + 3]);
                w.z = cvt_pk_bf16(d[8 * c + 4] * rs * gq[8 * c + 4], d[8 * c + 5] * rs * gq[8 * c + 5]); w.w = cvt_pk_bf16(d[8 * c + 6] * rs * gq[8 * c + 6], d[8 * c + 7] * rs * gq[8 * c + 7]);
                *(u32x4*)(op + 8 * c) = w; }
        }
    }
    asm volatile("s_waitcnt vmcnt(0) lgkmcnt(0)" ::: "memory"); __builtin_amdgcn_s_barrier(); asm volatile("" ::: "memory");
#undef UNIT_PTRS
#undef VRDSET
#undef VFRAG
#undef PIECE
#undef PFIN
#undef PVBLOCK
#undef LSUM
#undef DMA
#undef WBAR
}
constexpr int BUF2 = 65536;
template <int VAR = 0> __device__ __forceinline__ void attn_phase2(int vcu, int G, const bf16_t* __restrict__ Qb, const bf16_t* __restrict__ Kb, const bf16_t* __restrict__ Vb, bf16_t* __restrict__ Ob,
                                          const float* __restrict__ TbG, const float* __restrict__ gsub, float lam, char* lds, const int wid) {
    const int lane = lane_id(), tid = wid * 64 + lane, r32 = lane & 31, hi = lane >> 5, rg = wid & 3, mm = wid >> 2;
    constexpr int NUNITS = BATCH * NH * 16, NT2 = SEQ / 128;
    if (vcu >= NUNITS) return;
    float* Tb = (float*)(lds + TB2_OFF); float* GS = (float*)(lds + GS_OFF);
    unsigned offK[2], offV[2];
#pragma unroll
    for (int i = 0; i < 2; ++i) { const int pc = 2 * wid + i;
        { const int row = pc * 4 + (lane >> 4), c = (lane & 15) ^ (row & 7); offK[i] = (unsigned)(row * LD + c * 8) * 2u; }
        { const int sub = pc * 2 + (lane >> 5), kk = (sub >> 2) * 8 + ((lane & 31) >> 2), k = (kk & ~0xC) | ((kk & 4) << 1) | ((kk & 8) >> 1), col = (sub & 3) * 32 + (lane & 3) * 8; offV[i] = (unsigned)(k * LD + col) * 2u; } }
    LAS unsigned char* ldsl_ = (LAS unsigned char*)(unsigned char*)lds;
    const LAS char* vbase = (const LAS char*)(LAS unsigned char*)(unsigned char*)lds + v_rd_base(lane);
    const int vbi0 = (int)(unsigned)(unsigned long long)vbase, ldsi0 = (int)(unsigned)(unsigned long long)ldsl_;
#define DMA2(Kh_, Vh_, t, boff) do { _Pragma("unroll") for (int s_ = 0; s_ < 2; ++s_) { const char* kt_ = (Kh_) + (size_t)(2 * (t) + s_) * (KVBLK * LD * 2); const char* vt_ = (Vh_) + (size_t)(2 * (t) + s_) * (KVBLK * LD * 2); \
        _Pragma("unroll") for (int i_ = 0; i_ < 2; ++i_) { \
            __builtin_amdgcn_global_load_lds((const unsigned*)(vt_ + offV[i_]), (LAS unsigned*)(ldsl_ + (boff) + s_ * SHM_V + (2 * wid + i_) * 1024), 16, 0, 0); \
            __builtin_amdgcn_global_load_lds((const unsigned*)(kt_ + offK[i_]), (LAS unsigned*)(ldsl_ + (boff) + 2 * SHM_V + s_ * SHM_K + (2 * wid + i_) * 1024), 16, 0, 0); } } } while (0)
#define DMAP(Kh_, Vh_, t, boff, p) do { const int s_ = (p) >> 2, i_ = ((p) >> 1) & 1; \
        if ((p) & 1) { const char* kt_ = (Kh_) + (size_t)(2 * (t) + s_) * (KVBLK * LD * 2); __builtin_amdgcn_global_load_lds((const unsigned*)(kt_ + offK[i_]), (LAS unsigned*)(ldsl_ + (boff) + 2 * SHM_V + s_ * SHM_K + (2 * wid + i_) * 1024), 16, 0, 0); } \
        else { const char* vt_ = (Vh_) + (size_t)(2 * (t) + s_) * (KVBLK * LD * 2); __builtin_amdgcn_global_load_lds((const unsigned*)(vt_ + offV[i_]), (LAS unsigned*)(ldsl_ + (boff) + s_ * SHM_V + (2 * wid + i_) * 1024), 16, 0, 0); } } while (0)
#define WBAR0() do { asm volatile("s_waitcnt vmcnt(0) lgkmcnt(0)" ::: "memory"); __builtin_amdgcn_s_barrier(); asm volatile("" ::: "memory"); } while (0)
#define VREQ(f) do { if ((f) < 32) { FL[(f) & 3] = tr_read<((f) >> 4) * SHM_V + v_rd_off((f) & 3, ((f) >> 2) & 3, 0)>(vbi); FH[(f) & 3] = tr_read<((f) >> 4) * SHM_V + v_rd_off((f) & 3, ((f) >> 2) & 3, 1)>(vbi); } } while (0)
#define VWAIT(f) asm volatile("s_waitcnt lgkmcnt(%2)" : "+v"(FL[(f) & 3]), "+v"(FH[(f) & 3]) : "n"((f) <= 28 ? 6 : 2 * (31 - (f))))
#define VFRG(f) (bf16x8){FL[(f) & 3][0], FL[(f) & 3][1], FL[(f) & 3][2], FL[(f) & 3][3], FH[(f) & 3][0], FH[(f) & 3][1], FH[(f) & 3][2], FH[(f) & 3][3]}
#define PVM(f, X) do { VREQ((f) + 3); VWAIT(f); o[(f) & 3] = __builtin_amdgcn_mfma_f32_32x32x16_bf16(((f) < 16 ? paA : paB)[((f) >> 2) & 3], VFRG(f), o[(f) & 3], 0, 0, 0); X; SBAR(); } while (0)
#define PIECE(P, B, q) do { P[(B) + 2 * (q)] = __builtin_amdgcn_exp2f(P[(B) + 2 * (q)]); P[(B) + 2 * (q) + 1] = __builtin_amdgcn_exp2f(P[(B) + 2 * (q) + 1]); \
        ps += P[(B) + 2 * (q)]; ps += P[(B) + 2 * (q) + 1]; cq[q] = cvt_pk_bf16(P[(B) + 2 * (q)], P[(B) + 2 * (q) + 1]); } while (0)
#define PFIN(OUT) do { auto r0_ = __builtin_amdgcn_permlane32_swap(cq[0], cq[2], false, false); auto r1_ = __builtin_amdgcn_permlane32_swap(cq[1], cq[3], false, false); \
        u32x4 w_ = {r0_[0], r1_[0], r0_[1], r1_[1]}; OUT = *reinterpret_cast<bf16x8*>(&w_); } while (0)
#define PC(P0, P1, PA, i) do { if ((i) < 8) PIECE(P0, ((i) >> 2) * 8, (i) & 3); else PIECE(P1, (((i) >> 2) & 1) * 8, (i) & 3); if (((i) & 3) == 3) PFIN(PA[(i) >> 2]); } while (0)
#define LSUM() do { auto rr_ = __builtin_amdgcn_permlane32_swap(__float_as_uint(ps), __float_as_uint(ps), false, false); l_reg += __uint_as_float(rr_[0]) + __uint_as_float(rr_[1]); ps = 0.f; } while (0)
#define UNIT_PTRS(u_, b_, h_, q0_, Kh_, Vh_, Qw_) const int b_ = (u_) >> 7, h_ = ((u_) >> 4) & 7, q0_ = ((u_) & 15) * 128; \
        const char* Kh_ = (const char*)(Kb + (size_t)(b_ * SEQ) * LD + h_ * 128); const char* Vh_ = (const char*)(Vb + (size_t)(b_ * SEQ) * LD + h_ * 128); \
        const bf16_t* Qw_ = Qb + (size_t)(b_ * SEQ + q0_ + rg * 32 + r32) * LD + h_ * 128 + mm * 64 + hi * 8
    bf16x8 qr[4]; int htab = -1;
    { UNIT_PTRS(vcu, b0_, h0_, q00_, Kh0_, Vh0_, Qw0_);
      DMA2(Kh0_, Vh0_, 0, 0);
#pragma unroll
      for (int d0 = 0; d0 < 4; ++d0) qr[d0] = *reinterpret_cast<const bf16x8*>(Qw0_ + d0 * 16);
      if (tid < 128) GS[tid] = gsub[tid]; }
    for (int u = vcu; u < NUNITS; u += G) {
        UNIT_PTRS(u, b, h, q0, Kh, Vh, Qw); (void)Qw;
        const int q0w = q0 + rg * 32;
        if (h != htab) { const int t2 = wid * 64 + lane_id(); Tb[t2] = TbG[h * 512 + t2]; htab = h; }
        const float Tl = TbG[h * 512 + 0];
        f32x16 o[4] = {}; float l_reg = 0.f, ps = 0.f;
        f32x16 pA0, pA1, pB0, pB1; bf16x8 paA[4], paB[4];
        s16x4 FL[4], FH[4]; unsigned cq[4];
        float tfar = Tl;
        WBAR0();
        for (int j = 0; j < NT2; ++j) {
            const int base = (j & 1) * BUF2; const int vbi = vbi0 + base;
            const bool dnext = (j + 1 < NT2); const int nboff = ((j + 1) & 1) * BUF2;
            SBAR();
            const int drela = j * 128 - q0w, drelb = drela + 64;
            if (drela >= 122 && drela < 122 + KVBLK) tfar = Tb[511];
            { const int l5 = lane_id(); f32x16 cv;
#pragma unroll
              for (int r = 0; r < 16; ++r) cv[r] = tfar;
              qkt2(pA0, pA1, lds + base + 2 * SHM_V, qr, l5 & 31, l5 >> 5, mm, Tb, drela, cv, [&](int p) { if (dnext) DMAP(Kh, Vh, j + 1, nboff, p); }); } SBAR();
            if (drelb >= 122 && drelb < 122 + KVBLK) tfar = Tb[511];
            VREQ(0); VREQ(1); VREQ(2);
            {
                const bool farb = (drelb >= 122 || drelb <= -154);
#define KREQ(i) do { if ((i) < 8) kw[(i) & 3] = lds_read128<2 * SHM_V + SHM_K + 8192 * ((i) & 1)>(kab + (((((i) >> 1) << 5) | (hi << 4)) ^ kxs)); } while (0)
#define KWAIT(i) asm volatile("s_waitcnt lgkmcnt(%1)" : "+v"(kw[(i) & 3]) : "n"((i) <= 4 ? 3 : 7 - (i)))
#define QKB(i, ACC) do { KREQ((i) + 3); KWAIT(i); ACC = __builtin_amdgcn_mfma_f32_32x32x16_bf16(kw[(i) & 3], qr[(i) >> 1], ACC, 0, 0, 0); PC(pA0, pA1, paA, i); SBAR(); } while (0)
                const int kxs = (r32 & 7) << 4, kab = ldsi0 + base + r32 * 256 + mm * 128;
                bf16x8 kw[4];
                KREQ(0); KREQ(1); KREQ(2); SBAR();
                if (!farb) { const float* tb = Tb + (drelb + 256 - r32 + 4 * hi);
#pragma unroll
                    for (int r = 0; r < 16; ++r) { const int oo = (r & 3) + 8 * (r >> 2); pB0[r] = tb[oo]; pB1[r] = tb[oo + 32]; } }
                else {
#pragma unroll
                    for (int r = 0; r < 16; ++r) { pB0[r] = tfar; pB1[r] = tfar; } }
                QKB(0, pB0); QKB(1, pB1); QKB(2, pB0); QKB(3, pB1); QKB(4, pB0); QKB(5, pB1); QKB(6, pB0); QKB(7, pB1);
#undef QKB
#undef KWAIT
#undef KREQ
            }
            PVM(0, PC(pA0, pA1, paA, 8)); PVM(1, PC(pA0, pA1, paA, 9)); PVM(2, PC(pA0, pA1, paA, 10)); PVM(3, PC(pA0, pA1, paA, 11));
            PVM(4, PC(pA0, pA1, paA, 12)); PVM(5, PC(pA0, pA1, paA, 13)); PVM(6, PC(pA0, pA1, paA, 14)); PVM(7, PC(pA0, pA1, paA, 15));
            PVM(8, PC(pB0, pB1, paB, 0)); PVM(9, PC(pB0, pB1, paB, 1)); PVM(10, PC(pB0, pB1, paB, 2)); PVM(11, PC(pB0, pB1, paB, 3));
            PVM(12, PC(pB0, pB1, paB, 4)); PVM(13, PC(pB0, pB1, paB, 5)); PVM(14, PC(pB0, pB1, paB, 6)); PVM(15, PC(pB0, pB1, paB, 7));
            PVM(16, PC(pB0, pB1, paB, 8)); PVM(17, PC(pB0, pB1, paB, 9)); PVM(18, PC(pB0, pB1, paB, 10)); PVM(19, PC(pB0, pB1, paB, 11));
            PVM(20, PC(pB0, pB1, paB, 12)); PVM(21, PC(pB0, pB1, paB, 13)); PVM(22, PC(pB0, pB1, paB, 14)); PVM(23, PC(pB0, pB1, paB, 15));
            PVM(24, (void)0); PVM(25, (void)0); PVM(26, (void)0); PVM(27, (void)0); PVM(28, (void)0); PVM(29, (void)0); PVM(30, (void)0); PVM(31, (void)0);
            LSUM();
            WBAR0();
        }
        float* li_l = (float*)(lds + LI2_OFF) + wid * 64;
        { const int l3 = lane_id(); if (l3 < 32) li_l[l3] = l_reg; }
        const int un = u + G;
        if (un < NUNITS) {
            const int bn_ = un >> 7, hn_ = (un >> 4) & 7, q0n_ = (un & 15) * 128; const int l4 = lane_id();
            const char* Khn_ = (const char*)(Kb + (size_t)(bn_ * SEQ) * LD + hn_ * 128); const char* Vhn_ = (const char*)(Vb + (size_t)(bn_ * SEQ) * LD + hn_ * 128);
            const bf16_t* Qwn_ = Qb + (size_t)(bn_ * SEQ + q0n_ + rg * 32 + (l4 & 31)) * LD + hn_ * 128 + mm * 64 + (l4 >> 5) * 8;
            DMA2(Khn_, Vhn_, 0, 0);
#pragma unroll
            for (int d0 = 0; d0 < 4; ++d0) qr[d0] = *reinterpret_cast<const bf16x8*>(Qwn_ + d0 * 16);
        }
        const float fsc = mm ? lam : 1.0f;
        bf16_t* Em = (bf16_t*)(lds + E2_OFF + mm * E2_BYTES);
        asm volatile("s_waitcnt lgkmcnt(0)" ::: "memory");
#pragma unroll
        for (int r = 0; r < 16; ++r) { const int orow = crow(r, hi); const float f = fsc * __builtin_amdgcn_rcpf(li_l[orow]);
#pragma unroll
            for (int d0 = 0; d0 < 4; ++d0) Em[(rg * 32 + orow) * E2_STRIDE + d0 * 32 + r32] = f2bf(o[d0][r] * f); }
        asm volatile("s_waitcnt lgkmcnt(0)" ::: "memory"); __builtin_amdgcn_s_barrier(); asm volatile("" ::: "memory");
        {
            const int row = tid >> 2, qt = tid & 3;
            const bf16_t* e0 = (const bf16_t*)(lds + E2_OFF) + row * E2_STRIDE + qt * 32; const bf16_t* e1 = e0 + E2_BYTES / 2;
            float d[32]; float ss = 0.f;
#pragma unroll
            for (int c = 0; c < 4; ++c) { const u32x4 a = *(const u32x4*)(e0 + 8 * c), bq = *(const u32x4*)(e1 + 8 * c);
                d[8 * c + 0] = bf_lo(a.x) - bf_lo(bq.x); d[8 * c + 1] = bf_hi(a.x) - bf_hi(bq.x); d[8 * c + 2] = bf_lo(a.y) - bf_lo(bq.y); d[8 * c + 3] = bf_hi(a.y) - bf_hi(bq.y);
                d[8 * c + 4] = bf_lo(a.z) - bf_lo(bq.z); d[8 * c + 5] = bf_hi(a.z) - bf_hi(bq.z); d[8 * c + 6] = bf_lo(a.w) - bf_lo(bq.w); d[8 * c + 7] = bf_hi(a.w) - bf_hi(bq.w); }
#pragma unroll
            for (int c = 0; c < 32; ++c) ss += d[c] * d[c];
            ss += __shfl_xor(ss, 1); ss += __shfl_xor(ss, 2);
            const float rs = __builtin_amdgcn_rsqf(ss * (1.0f / 128.0f) + EPS) * 0.8f;
            bf16_t* op = Ob + (size_t)(b * SEQ + q0 + row) * LD + h * 128 + qt * 32;
            const float* gq = GS + qt * 32;
#pragma unroll
            for (int c = 0; c < 4; ++c) {
                u32x4 w; w.x = cvt_pk_bf16(d[8 * c + 0] * rs * gq[8 * c + 0], d[8 * c + 1] * rs * gq[8 * c + 1]); w.y = cvt_pk_bf16(d[8 * c + 2] * rs * gq[8 * c + 2], d[8 * c + 3] * rs * gq[8 * c + 3]);
                w.z = cvt_pk_bf16(d[8 * c + 4] * rs * gq[8 * c + 4], d[8 * c + 5] * rs * gq[8 * c + 5]); w.w = cvt_pk_bf16(d[8 * c + 6] * rs * gq[8 * c + 6], d[8 * c + 7] * rs * gq[8 * c + 7]);
                *(u32x4*)(op + 8 * c) = w; }
        }
    }
    asm volatile("s_waitcnt vmcnt(0) lgkmcnt(0)" ::: "memory"); __builtin_amdgcn_s_barrier(); asm volatile("" ::: "memory");
#undef UNIT_PTRS
#undef DMAP
#undef DMA2
#undef WBAR0
#undef VREQ
#undef VFRG
#undef PVM
#undef PIECE
#undef PFIN
#undef PC
#undef LSUM
}
}

namespace lru {
constexpr int CT = 128, NCH = SEQ / CT;
constexpr int LST = 68;
constexpr int XC_OFF = 0, AS_OFF = CT * 256, BS_OFF = AS_OFF + CT * LST * 4, HT_OFF = BS_OFF + CT * LST * 4, SEGP_OFF = HT_OFF + CT * LST * 4, SEGH_OFF = SEGP_OFF + 2048, CAR_OFF = SEGH_OFF + 2048, CW_OFF = CAR_OFF + 512;
static_assert(CW_OFF + 2560 <= MISC_OFF, "LRU LDS map");
__device__ __forceinline__ void lru_unit(int b, int n, int hh, const bf16_t* __restrict__ XL, const bf16_t* __restrict__ GY, bf16_t* __restrict__ LO, const bf16_t* __restrict__ WL,
                                         const float* __restrict__ conv_w, const float* __restrict__ conv_b, const float* __restrict__ rb, const float* __restrict__ ib, const float* __restrict__ lamp, char* lds, const int wid) {
    const int lane = lane_id(), tid = wid * 64 + lane, r32 = lane & 31, hi = lane >> 5;
    const int tp = wid & 1, ct = wid >> 1;
    char* XC = lds + XC_OFF; float* AS = (float*)(lds + AS_OFF); float* BS = (float*)(lds + BS_OFF); float* HT = (float*)(lds + HT_OFF);
    float* SEGP = (float*)(lds + SEGP_OFF); float* SEGH = (float*)(lds + SEGH_OFF); float* CAR = (float*)(lds + CAR_OFF);
    const int crow_ = tid >> 3, cg = tid & 7;
    const bf16_t* xbase = XL + (size_t)(b * SEQ) * DM + n * 128 + cg * 16;
    float* CW = (float*)(lds + CW_OFF);
    for (int i = tid; i < 640; i += 512) CW[i] = i < 512 ? conv_w[(i >> 7) * DM + n * 128 + (i & 127)] : conv_b[n * 128 + (i - 512)];
    for (int dir = 0; dir < 2; ++dir) {
        bf16x8 wf[8];
        { const bf16_t* wp = WL + (size_t)((((dir * 8 + n) * 2 + hh) * 4 + ct) * 32 + r32) * 128 + 8 * hi;
#pragma unroll
          for (int ks = 0; ks < 8; ++ks) wf[ks] = *reinterpret_cast<const bf16x8*>(wp + 16 * ks); }
        f32x4 nbr[2], nbi[2], kcv[2];
#pragma unroll
        for (int q2 = 0; q2 < 2; ++q2)
#pragma unroll
            for (int s2 = 0; s2 < 4; ++s2) { const int ch = dir * DM + n * 128 + hh * 64 + ct * 16 + 8 * q2 + 4 * hi + s2;
                nbr[q2][s2] = -rb[ch] * LOG2E; nbi[q2][s2] = -ib[ch] * LOG2E;
                const float L = lamp[ch]; kcv[q2][s2] = -8.0f * log1pf(__expf(-L)) * LOG2E; }
        __syncthreads();
        if (tid < 128) CAR[tid] = 0.f;
        u32x4 xin[2][4][2];
#define XLOAD(T1) do { const int t1_ = (T1); \
        if (t1_ >= 2 && t1_ <= SEQ - CT - 2) {                                    \
            _Pragma("unroll") for (int hf = 0; hf < 2; ++hf) _Pragma("unroll") for (int j = 0; j < 4; ++j) { const bf16_t* xp = xbase + (size_t)(t1_ + 64 * hf + crow_ + j - 2) * DM; xin[hf][j][0] = *(const u32x4*)xp; xin[hf][j][1] = *(const u32x4*)(xp + 8); } \
        } else { \
            _Pragma("unroll") for (int hf = 0; hf < 2; ++hf) _Pragma("unroll") for (int j = 0; j < 4; ++j) { const int t = t1_ + 64 * hf + crow_ + j - 2; const bool ok = (t >= 0 && t < SEQ); const bf16_t* xp = xbase + (size_t)(ok ? t : 0) * DM; \
                xin[hf][j][0] = ok ? *(const u32x4*)xp : (u32x4){0u, 0u, 0u, 0u}; xin[hf][j][1] = ok ? *(const u32x4*)(xp + 8) : (u32x4){0u, 0u, 0u, 0u}; } } } while (0)
        XLOAD(dir == 0 ? 0 : SEQ - CT);
        u32x4 hfr[2] = {{0u, 0u, 0u, 0u}, {0u, 0u, 0u, 0u}}, gyr[2] = {{0u, 0u, 0u, 0u}, {0u, 0u, 0u, 0u}}; size_t gio_prev = 0;
        for (int ci = 0; ci <= NCH; ++ci) {
            const int t0 = dir == 0 ? ci * CT : (NCH - 1 - ci) * CT;
            const size_t gio = (size_t)(b * SEQ + t0 + crow_) * DM + n * 128 + hh * 64 + cg * 8;
            if (ci < NCH) {
#pragma unroll
                for (int hf = 0; hf < 2; ++hf) {
                    f32x2 xc[8];
#pragma unroll
                    for (int p = 0; p < 8; ++p) xc[p] = *(const f32x2*)(CW + 512 + cg * 16 + 2 * p);
#pragma unroll
                    for (int j = 0; j < 4; ++j) { const u32x4 x0 = xin[hf][j][0], x1 = xin[hf][j][1]; const f32x2* cwj = (const f32x2*)(CW + j * 128 + cg * 16);
                        xc[0] += cwj[0] * (f32x2){bf_lo(x0.x), bf_hi(x0.x)}; xc[1] += cwj[1] * (f32x2){bf_lo(x0.y), bf_hi(x0.y)}; xc[2] += cwj[2] * (f32x2){bf_lo(x0.z), bf_hi(x0.z)}; xc[3] += cwj[3] * (f32x2){bf_lo(x0.w), bf_hi(x0.w)};
                        xc[4] += cwj[4] * (f32x2){bf_lo(x1.x), bf_hi(x1.x)}; xc[5] += cwj[5] * (f32x2){bf_lo(x1.y), bf_hi(x1.y)}; xc[6] += cwj[6] * (f32x2){bf_lo(x1.z), bf_hi(x1.z)}; xc[7] += cwj[7] * (f32x2){bf_lo(x1.w), bf_hi(x1.w)}; }
                    u32x4 w0, w1; w0.x = cvt_pk_bf16(xc[0].x, xc[0].y); w0.y = cvt_pk_bf16(xc[1].x, xc[1].y); w0.z = cvt_pk_bf16(xc[2].x, xc[2].y); w0.w = cvt_pk_bf16(xc[3].x, xc[3].y);
                    w1.x = cvt_pk_bf16(xc[4].x, xc[4].y); w1.y = cvt_pk_bf16(xc[5].x, xc[5].y); w1.z = cvt_pk_bf16(xc[6].x, xc[6].y); w1.w = cvt_pk_bf16(xc[7].x, xc[7].y);
                    *(u32x4*)(XC + KSWZ(64 * hf + crow_, cg * 32)) = w0; *(u32x4*)(XC + KSWZ(64 * hf + crow_, cg * 32 + 16)) = w1;
                }
                if (ci + 1 < NCH) XLOAD(dir == 0 ? (ci + 1) * CT : (NCH - 2 - ci) * CT);
            }
            __syncthreads();
            if (ci > 0) {
#pragma unroll
                for (int hf = 0; hf < 2; ++hf) {
                    const f32x4 h0 = *(const f32x4*)(HT + (64 * hf + crow_) * LST + cg * 8), h1 = *(const f32x4*)(HT + (64 * hf + crow_) * LST + cg * 8 + 4);
                    float hv[8] = {h0[0], h0[1], h0[2], h0[3], h1[0], h1[1], h1[2], h1[3]};
                    if (dir == 1) { const u32x4 f = hfr[hf], g = gyr[hf];
                        hv[0] = (hv[0] + bf_lo(f.x)) * bf_lo(g.x); hv[1] = (hv[1] + bf_hi(f.x)) * bf_hi(g.x); hv[2] = (hv[2] + bf_lo(f.y)) * bf_lo(g.y); hv[3] = (hv[3] + bf_hi(f.y)) * bf_hi(g.y);
                        hv[4] = (hv[4] + bf_lo(f.z)) * bf_lo(g.z); hv[5] = (hv[5] + bf_hi(f.z)) * bf_hi(g.z); hv[6] = (hv[6] + bf_lo(f.w)) * bf_lo(g.w); hv[7] = (hv[7] + bf_hi(f.w)) * bf_hi(g.w); }
                    u32x4 w; w.x = cvt_pk_bf16(hv[0], hv[1]); w.y = cvt_pk_bf16(hv[2], hv[3]); w.z = cvt_pk_bf16(hv[4], hv[5]); w.w = cvt_pk_bf16(hv[6], hv[7]);
                    *(u32x4*)(LO + gio_prev + (size_t)(64 * hf) * DM) = w; }
            }
            if (ci == NCH) break;
            if (dir == 1) {
#pragma unroll
                for (int hf = 0; hf < 2; ++hf) { hfr[hf] = *(const u32x4*)(LO + gio + (size_t)(64 * hf) * DM); gyr[hf] = *(const u32x4*)(GY + gio + (size_t)(64 * hf) * DM); } }
            gio_prev = gio;
#pragma unroll
            for (int k2 = 0; k2 < 2; ++k2) {
                const int tok = 64 * tp + 32 * k2 + r32;
                f32x16 acc = {};
                bf16x8 xb[4];
#pragma unroll
                for (int ks = 0; ks < 4; ++ks) xb[ks] = *reinterpret_cast<const bf16x8*>(XC + KSWZ(tok, (16 * ks + 8 * hi) * 2));
                __builtin_amdgcn_sched_barrier(0);
#pragma unroll
                for (int ks = 0; ks < 8; ++ks) { acc = __builtin_amdgcn_mfma_f32_32x32x16_bf16(wf[ks], xb[ks & 3], acc, 0, 0, 0);
                    if (ks + 4 < 8) xb[ks & 3] = *reinterpret_cast<const bf16x8*>(XC + KSWZ(tok, (16 * (ks + 4) + 8 * hi) * 2));
                    __builtin_amdgcn_sched_barrier(0); }
#pragma unroll
                for (int q2 = 0; q2 < 2; ++q2) { const int chl = ct * 16 + 8 * q2 + 4 * hi;
                    const f32x4 rpre = (f32x4){acc[8 * q2 + 0], acc[8 * q2 + 1], acc[8 * q2 + 2], acc[8 * q2 + 3]} * (-LOG2E) + nbr[q2];
                    const f32x4 ipre = (f32x4){acc[8 * q2 + 4], acc[8 * q2 + 5], acc[8 * q2 + 6], acc[8 * q2 + 7]} * (-LOG2E) + nbi[q2];
                    f32x4 rg, ig, a;
#pragma unroll
                    for (int s2 = 0; s2 < 4; ++s2) { rg[s2] = __builtin_amdgcn_rcpf(1.0f + __builtin_amdgcn_exp2f(rpre[s2])); ig[s2] = __builtin_amdgcn_rcpf(1.0f + __builtin_amdgcn_exp2f(ipre[s2])); }
                    const f32x4 la = rg * kcv[q2];
#pragma unroll
                    for (int s2 = 0; s2 < 4; ++s2) a[s2] = __builtin_amdgcn_exp2f(la[s2]);
                    const f32x4 om = 1.0f - a * a; f32x4 mult;
#pragma unroll
                    for (int s2 = 0; s2 < 4; ++s2) mult[s2] = __builtin_amdgcn_sqrtf(om[s2]);
                    const u32x2 xw = *(const u32x2*)(XC + KSWZ(tok, ((hh * 64 + chl) >> 3) * 16) + 8 * hi);
                    const f32x4 xv = {bf_lo(xw.x), bf_hi(xw.x), bf_lo(xw.y), bf_hi(xw.y)};
                    *(f32x4*)(AS + tok * LST + chl) = a; *(f32x4*)(BS + tok * LST + chl) = mult * ig * xv; }
            }
            __syncthreads();
            const int ch = lane, seg = wid;
            float av[16], bv[16];
            {
                float Pp = 1.f, Hh = 0.f;
#pragma unroll
                for (int p = 0; p < 16; ++p) { const int pos = seg * 16 + p, tl = dir ? CT - 1 - pos : pos; av[p] = AS[tl * LST + ch]; bv[p] = BS[tl * LST + ch]; Hh = av[p] * Hh + bv[p]; Pp *= av[p]; }
                SEGP[seg * 64 + ch] = Pp; SEGH[seg * 64 + ch] = Hh;
            }
            __syncthreads();
            {
                float c = CAR[(ci & 1) * 64 + ch];
                {
                    int s2 = 0;
                    for (; s2 + 1 < seg; s2 += 2) { const float p0 = SEGP[s2 * 64 + ch], h0 = SEGH[s2 * 64 + ch], p1 = SEGP[(s2 + 1) * 64 + ch], h1 = SEGH[(s2 + 1) * 64 + ch]; c = p0 * c + h0; c = p1 * c + h1; }
                    if (s2 < seg) c = SEGP[s2 * 64 + ch] * c + SEGH[s2 * 64 + ch];
                }
#pragma unroll
                for (int p = 0; p < 16; ++p) { const int pos = seg * 16 + p, tl = dir ? CT - 1 - pos : pos; c = av[p] * c + bv[p]; HT[tl * LST + ch] = c; }
                if (seg == 7) CAR[((ci + 1) & 1) * 64 + ch] = c;
            }
        }
#undef XLOAD
        asm volatile("s_waitcnt vmcnt(0)" ::: "memory");
        __syncthreads();
    }
}
}

__device__ __forceinline__ void transpose_item(const float* W, int N, bf16_t* WT, int ldt, int k0, int n0, size_t drow0, LAS float* scr, int lane) {
#pragma unroll
    for (int i = 0; i < 32; ++i) { const int kk = 2 * i + (lane >> 5); scr[kk * 33 + (lane & 31)] = W[(size_t)(k0 + kk) * N + n0 + (lane & 31)]; }
    LDS_WAIT(); asm volatile("" ::: "memory");
    const int c = lane & 7;
#pragma unroll
    for (int j = 0; j < 4; ++j) { const int nn = (lane >> 3) + 8 * j; const LAS float* s = scr + (8 * c) * 33 + nn;
        u32x4 o; o.x = cvt_pk_bf16(s[0 * 33], s[1 * 33]); o.y = cvt_pk_bf16(s[2 * 33], s[3 * 33]); o.z = cvt_pk_bf16(s[4 * 33], s[5 * 33]); o.w = cvt_pk_bf16(s[6 * 33], s[7 * 33]);
        *(GAS u32x4*)(WT + (drow0 + nn) * ldt + k0 + 8 * c) = o; }
    LDS_WAIT(); asm volatile("" ::: "memory");
}
__device__ __forceinline__ void transpose_item_fp8(const float* W, int N, unsigned char* WT, int ldt, int k0, int n0, size_t drow0, LAS float* scr, int lane) {
#pragma unroll
    for (int i = 0; i < 32; ++i) { const int kk = 2 * i + (lane >> 5); scr[kk * 33 + (lane & 31)] = W[(size_t)(k0 + kk) * N + n0 + (lane & 31)] * 64.0f; }
    LDS_WAIT(); asm volatile("" ::: "memory");
    const int c = lane & 7;
#pragma unroll
    for (int j = 0; j < 4; ++j) { const int nn = (lane >> 3) + 8 * j; const LAS float* s = scr + (8 * c) * 33 + nn;
        u32x2 o; o.x = pk4_fp8(s[0 * 33], s[1 * 33], s[2 * 33], s[3 * 33]); o.y = pk4_fp8(s[4 * 33], s[5 * 33], s[6 * 33], s[7 * 33]);
        *(GAS u32x2*)(WT + (drow0 + nn) * ldt + k0 + 8 * c) = o; }
    LDS_WAIT(); asm volatile("" ::: "memory");
}
__device__ __forceinline__ void transpose_mat(const float* W, int K, int N, bf16_t* WT, size_t drow_base, int item, LAS float* scr, int lane) {
    const int nblk = N / 32, kb = item / nblk, nb = item % nblk;
    transpose_item(W, N, WT, K, 64 * kb, 32 * nb, drow_base + 32 * nb, scr, lane);
}
__device__ __forceinline__ int rel_bucket(int rel) {
    const int ret = rel > 0 ? 16 : 0; const int nabs = rel < 0 ? -rel : rel;
    if (nabs < 8) return ret + nabs;
    int large = (31 - __clz(nabs * nabs)) + 2; large = large < 15 ? large : 15;
    return ret + large;
}

struct Params { const float* in[26]; float* out; unsigned char* ws; int ph_lo, ph_hi, probe, pad; };

__global__ void __launch_bounds__(512, 2) mk_fwd(Params P) {
    extern __shared__ __attribute__((aligned(16))) unsigned char lds[];
    LAS unsigned char* ldsl = (LAS unsigned char*)lds;
    volatile LAS unsigned* MISC = (volatile LAS unsigned*)(ldsl + MISC_OFF);
    const int wave = __builtin_amdgcn_readfirstlane((int)threadIdx.x >> 6);
    const int G = gridDim.x, bx = blockIdx.x;
    const int vcu = (G % 8 == 0) ? (bx % 8) * (G / 8) + bx / 8 : bx;
    unsigned char* ws = P.ws;
    if (threadIdx.x < 32) MISC[threadIdx.x] = 0u;
    __syncthreads();
    XcdBarrier bar; bar.bar = (unsigned*)(ws + WS_CTL) + CW_BAR; bar.x = 0; bar.st = nullptr;
    if (P.ph_hi - P.ph_lo > 1) bar = xcd_barrier_post((unsigned*)(ws + WS_CTL) + CW_BAR, MISC + 8);
    const int lo = P.ph_lo, hi = P.ph_hi;
#define IN(k) (lo <= (k) && (k) < hi)
#define PH_IDS() const int lane = lane_id(), tid = wave * 64 + lane; (void)tid; (void)lane
#define BOTH(k) (IN(k) && IN((k) + 1))
    const float* x = P.in[0];
    bf16_t* RA = (bf16_t*)(ws + WS_RA); bf16_t* QB = (bf16_t*)(ws + WS_Q); bf16_t* KB = (bf16_t*)(ws + WS_K); bf16_t* VB = (bf16_t*)(ws + WS_V);
    bf16_t* XL = (bf16_t*)(ws + WS_XL); bf16_t* GY = (bf16_t*)(ws + WS_GY); bf16_t* LO = (bf16_t*)(ws + WS_LO);
    unsigned char* SA = (unsigned char*)P.out; unsigned char* SR = (unsigned char*)P.out + (size_t)MTOK * DM;
    bf16_t* WIN = (bf16_t*)(ws + WS_WIN); bf16_t* WCAT = (bf16_t*)(ws + WS_WCAT); bf16_t* WOUT = (bf16_t*)(ws + WS_WOUT); bf16_t* WLRU = (bf16_t*)(ws + WS_WLRU);
    bf16_t* WGU = (bf16_t*)(ws + WS_WGU); bf16_t* WDN = (bf16_t*)(ws + WS_WDN); bf16_t* HG = (bf16_t*)(ws + WS_HG);
    unsigned char* XN8 = ws + WS_XN8; unsigned char* WIN8 = ws + WS_WIN8;
    float* TBG = (float*)(ws + WS_TAB); float* MISCG = (float*)(ws + WS_TAB + 16384);
    unsigned short* INV = (unsigned short*)(ws + WS_INV); bf16_t* YE = (bf16_t*)(ws + WS_YE);
    bf16_t* H16 = (bf16_t*)(ws + WS_H16);
    float* SELRS = (float*)(ws + WS_SELRS); float* RSV = (float*)(ws + WS_RS);
    float* AFF = (float*)(ws + WS_AFF); int* SELI = (int*)(ws + WS_SELI); float* SELV = (float*)(ws + WS_SELV);
    const int gw = vcu * 8 + wave, NGW = G * 8;

    if (IN(0)) { PH_IDS();
        LAS float* scr = (LAS float*)(ldsl + wave * 16384);
        constexpr int I_IN = (DM / 64) * (DIN / 32), I_SQ = (DM / 64) * (DM / 32);
        for (int it = gw; it < I_IN + 3 * I_SQ; it += NGW) {
            int r = it;
            if (r < I_IN) { const int nb = r % (DIN / 32); if (nb < 5120 / 32) transpose_mat(P.in[2], DM, DIN, WIN, 0, r, scr, lane);
                if (nb >= 5120 / 32) { const int kb = r / (DIN / 32); transpose_item_fp8(P.in[2], DIN, WIN8, DM, 64 * kb, 32 * nb, (size_t)(32 * nb - 5120), scr, lane); }
                continue; } r -= I_IN;
            if (r < I_SQ) { const int kb = r / (DM / 32), nb = r % (DM / 32); transpose_item(P.in[18], DM, WCAT, 2 * DM, 64 * kb, 32 * nb, (size_t)(32 * nb), scr, lane); continue; } r -= I_SQ;
            if (r < I_SQ) { const int kb = r / (DM / 32), nb = r % (DM / 32); transpose_item(P.in[19], DM, WCAT + DM, 2 * DM, 64 * kb, 32 * nb, (size_t)(32 * nb), scr, lane); continue; } r -= I_SQ;
            transpose_mat(P.in[20], DM, DM, WOUT, 0, r, scr, lane);
        }
        for (int e = gw * 64 + lane; e < 2 * 8 * 2 * 4 * 32 * 128; e += NGW * 64) {
            const int k = e & 127, rho = (e >> 7) & 31, ct = (e >> 12) & 3, hh = (e >> 14) & 1, n = (e >> 15) & 7, dir = e >> 18;
            const int type = (rho >> 3) & 1, s = rho & 3, hi_ = (rho >> 2) & 1, q2 = rho >> 4;
            const int dcol = hh * 64 + ct * 16 + 8 * q2 + 4 * hi_ + s;
            const float* src = type ? P.in[15] : P.in[13];
            WLRU[e] = f2bf(src[(size_t)((dir * 8 + n) * 128 + k) * 128 + dcol]);
        }
        if (vcu == 0) {
            float gqm = 0.f, gkm = 0.f;
            for (int i = 0; i < 64; ++i) { gqm = fmaxf(gqm, fabsf(P.in[3][i])); gkm = fmaxf(gkm, fabsf(P.in[4][i])); }
            for (int e = tid; e < NH * 512; e += 512) { const int h = e >> 9, idx = e & 511;
                float bm = -1e30f; for (int bk = 0; bk < 32; ++bk) bm = fmaxf(bm, P.in[10][bk * NH + h]);
                const float Mh = 8.0f * gqm * gkm + bm;
                TBG[e] = (P.in[10][rel_bucket(idx - 256) * NH + h] - Mh) * LOG2E; }
            if (tid == 0) { float s1 = 0.f, s2 = 0.f; for (int i = 0; i < 64; ++i) { s1 += P.in[5][i] * P.in[6][i]; s2 += P.in[7][i] * P.in[8][i]; }
                MISCG[0] = __expf(s1) - __expf(s2) + 0.2f; }
        }
        for (int m = gw; m < MTOK; m += NGW) {
            const GAS f32x4* xr = (const GAS f32x4*)(x + (size_t)m * DM) + lane; const f32x4* gr = (const f32x4*)P.in[1] + lane;
            f32x4 v[4]; float s = 0.f;
#pragma unroll
            for (int j = 0; j < 4; ++j) { v[j] = xr[64 * j]; s += (v[j].x * v[j].x + v[j].y * v[j].y) + (v[j].z * v[j].z + v[j].w * v[j].w); }
            const float rs = __builtin_amdgcn_rsqf(wave_sum(s) * (1.0f / DM) + EPS);
            GAS u32x2* o8 = (GAS u32x2*)(RA + (size_t)m * DM) + lane;
            GAS unsigned* o4 = (GAS unsigned*)(XN8 + (size_t)m * DM) + lane;
#pragma unroll
            for (int j = 0; j < 4; ++j) { const f32x4 g = gr[64 * j]; const f32x4 y = v[j] * rs * g; u32x2 w; w.x = cvt_pk_bf16(y.x, y.y); w.y = cvt_pk_bf16(y.z, y.w); o8[64 * j] = w; o4[64 * j] = pk4_fp8(y.x, y.y, y.z, y.w); }
        }
        if (BOTH(0)) xcd_barrier(bar, wave);
    }

    if (IN(1)) {
#ifdef MK_PROBE_P1
        if (P.probe) { pg8::DenseOrder S{(const char*)RA, (const char*)WIN, DM * 2, DM * 2, MTOK / 256, 20, G, bx}; pg8::EpiNull E{(float*)(ws + WS_CTL + 32768)};
            pg8::gemm_phase<pg8::EpiNull, pg8::DenseOrder, true, true>(ldsl, DM * 2, S, E, wave); } else
#endif
        {
        LAS float* gl = (LAS float*)(ldsl + X_SCR_OFF);
        { PH_IDS(); if (tid < 128) gl[tid] = tid < 64 ? P.in[3][tid] : P.in[4][tid - 64]; }
        __syncthreads();
        { pg8::DenseOrder S{(const char*)RA, (const char*)WIN, DM * 2, DM * 2, MTOK / 256, 20, G, bx};
          pg8::EpiProj E{QB, KB, VB, XL, GY, gl};
          pg8::gemm_phase<pg8::EpiProj, pg8::DenseOrder, true, true>(ldsl, DM * 2, S, E, wave); }
        { pg8::DenseOrder S{(const char*)XN8, (const char*)WIN8, DM, DM, MTOK / 256, 8, G, bx};
          pg8::EpiGate E; E.sa = SA; E.sr = SR; E.gsc = 0.015625f;
          pg8::gemm_phase<pg8::EpiGate, pg8::DenseOrder, true, true, true>(ldsl, DM, S, E, wave); }
        }
        if (BOTH(1)) xcd_barrier(bar, wave);
    }

    if (IN(2)) {
        for (int u = vcu; u < 256; u += G)
            lru::lru_unit(u >> 4, (u >> 1) & 7, u & 1, XL, GY, LO, WLRU, P.in[11], P.in[12], P.in[14], P.in[16], P.in[17], (char*)lds, wave);
        __syncthreads();
    }
    if (IN(3)) {
        const float lam = MISCG[0];
#ifdef MK_PROBE_ATTN
        if (P.probe) att::attn_phase<MK_PROBE_ATTN, MK_PROBE_VAR>(vcu, G, QB, KB, VB, RA, TBG, P.in[9], lam, (char*)lds, wave); else
#endif
        att::attn_phase2<0>(vcu, G, QB, KB, VB, RA, TBG, P.in[9], lam, (char*)lds, wave);
        if (BOTH(3)) xcd_barrier(bar, wave);
    }

    if (IN(4)) {
        pg8::BranchOrder S{(const char*)RA, (const char*)LO, (const char*)WCAT, G, bx};
        pg8::EpiBranch E; E.sa = SA; E.sr = SR; E.mixed = XL;
        pg8::gemm_phase<pg8::EpiBranch, pg8::BranchOrder, true, true>(ldsl, DM * 4, S, E, wave);
        if (BOTH(4)) xcd_barrier(bar, wave);
    }

    if (IN(5)) {
        pg8::DenseOrder S{(const char*)XL, (const char*)WOUT, DM * 2, DM * 2, MTOK / 256, DM / 256, G, bx};
        pg8::EpiOut E; E.x = x; E.h16 = H16;
        pg8::gemm_phase<pg8::EpiOut, pg8::DenseOrder, true, true>(ldsl, DM * 2, S, E, wave);
        if (BOTH(5)) xcd_barrier(bar, wave);
    }

    if (IN(6)) { PH_IDS();
        LAS float* WRT = (LAS float*)ldsl;
        LAS float* GL = (LAS float*)(ldsl + 65536);
        for (int i = tid; i < DM * NE; i += 512) { const int k = i >> 4, e = i & 15; WRT[(k >> 2) * 64 + e * 4 + (k & 3)] = P.in[22][i]; }
        for (int i = tid; i < DM; i += 512) GL[i] = P.in[21][i];
        __syncthreads();
        const int r = lane & 15, q = lane >> 4;
        for (int g16 = gw; g16 < MTOK / 16; g16 += NGW) {
            const int R0 = g16 * 16;
            const GAS u32x4* hrow = (const GAS u32x4*)(H16 + (size_t)(R0 + r) * DM + 8 * q);
            GAS u32x2* o8 = (GAS u32x2*)((unsigned char*)RA + (size_t)(R0 + r) * DM + 8 * q);
            f32x4 acc = {0.f, 0.f, 0.f, 0.f}; float ss = 0.f;
            u32x4 hwv[32];
#pragma unroll
            for (int j = 0; j < 32; ++j) hwv[j] = hrow[4 * j];
            __builtin_amdgcn_sched_barrier(0);
#pragma unroll
            for (int j = 0; j < 32; ++j) {
                const u32x4 hw = hwv[j]; const f32x4 g0 = *(const LAS f32x4*)(GL + 32 * j + 8 * q), g1 = *(const LAS f32x4*)(GL + 32 * j + 8 * q + 4);
                const f32x4 y0 = (f32x4){bf_lo(hw.x), bf_hi(hw.x), bf_lo(hw.y), bf_hi(hw.y)} * g0, y1 = (f32x4){bf_lo(hw.z), bf_hi(hw.z), bf_lo(hw.w), bf_hi(hw.w)} * g1;
                ss += ((y0.x * y0.x + y0.y * y0.y) + (y0.z * y0.z + y0.w * y0.w)) + ((y1.x * y1.x + y1.y * y1.y) + (y1.z * y1.z + y1.w * y1.w));
                u32x2 o; o.x = pk4_fp8(y0.x, y0.y, y0.z, y0.w); o.y = pk4_fp8(y1.x, y1.y, y1.z, y1.w); o8[4 * j] = o;
                const f32x4 w0 = *(const LAS f32x4*)(WRT + (8 * j + 2 * q) * 64 + r * 4), w1 = *(const LAS f32x4*)(WRT + (8 * j + 2 * q + 1) * 64 + r * 4);
                acc = __builtin_amdgcn_mfma_f32_16x16x4f32(y0.x, w0.x, acc, 0, 0, 0); acc = __builtin_amdgcn_mfma_f32_16x16x4f32(y0.y, w0.y, acc, 0, 0, 0);
                acc = __builtin_amdgcn_mfma_f32_16x16x4f32(y0.z, w0.z, acc, 0, 0, 0); acc = __builtin_amdgcn_mfma_f32_16x16x4f32(y0.w, w0.w, acc, 0, 0, 0);
                acc = __builtin_amdgcn_mfma_f32_16x16x4f32(y1.x, w1.x, acc, 0, 0, 0); acc = __builtin_amdgcn_mfma_f32_16x16x4f32(y1.y, w1.y, acc, 0, 0, 0);
                acc = __builtin_amdgcn_mfma_f32_16x16x4f32(y1.z, w1.z, acc, 0, 0, 0); acc = __builtin_amdgcn_mfma_f32_16x16x4f32(y1.w, w1.w, acc, 0, 0, 0);
            }
            ss += __shfl_xor(ss, 16); ss += __shfl_xor(ss, 32);
            const float rs = __builtin_amdgcn_rsqf(ss * (1.0f / DM) + EPS);
            if (q == 0) RSV[R0 + r] = rs;
            f32x4 pr;
#pragma unroll
            for (int reg = 0; reg < 4; ++reg) { const float lg = acc[reg] * __shfl(rs, 4 * q + reg);
                const float mx = row16_max(lg);
                const float ex = __expf(lg - mx); const float den = row16_sum(ex);
                pr[reg] = ex / den; }
            *(GAS f32x4*)(AFF + (size_t)((R0 >> 11) * NE + r) * SEQ + (R0 & (SEQ - 1)) + 4 * q) = pr;
        }
        if (BOTH(6)) xcd_barrier(bar, wave);
    }

    if (IN(7)) { PH_IDS();
        LAS u64* sk = (LAS u64*)ldsl;
        for (int p = vcu; p < BATCH * NE; p += G) {
            for (int t = tid; t < SEQ; t += 512) sk[t] = ((u64)__float_as_uint(AFF[(size_t)p * SEQ + t]) << 32) | (u64)(0xFFFFFFFFu - (unsigned)t);
            __syncthreads();
            for (int k = 2; k <= SEQ; k <<= 1)
                for (int j = k >> 1; j > 0; j >>= 1) {
#pragma unroll
                    for (int t2 = 0; t2 < 2; ++t2) { const int t = tid + 512 * t2; const int i = ((t & ~(j - 1)) << 1) | (t & (j - 1)), l = i | j;
                        const u64 a = sk[i], bq = sk[l]; const bool desc = ((i & k) == 0);
                        if ((a < bq) == desc) { sk[i] = bq; sk[l] = a; } }
                    __syncthreads();
                }
            if (tid < CAP) { const u64 kv = sk[tid]; const int tok = (int)(0xFFFFFFFFu - (unsigned)kv); SELI[p * CAP + tid] = tok; SELV[p * CAP + tid] = __uint_as_float((unsigned)(kv >> 32)); SELRS[p * CAP + tid] = RSV[(p >> 4) * SEQ + tok]; }
            for (int t = tid; t < SEQ; t += 512) { const unsigned tok = 0xFFFFFFFFu - (unsigned)sk[t]; INV[(size_t)((p >> 4) * SEQ + tok) * NE + (p & 15)] = (unsigned short)(t < CAP ? t + 1 : 0); }
            __syncthreads();
        }
        LAS float* scr = (LAS float*)(ldsl + 16384 + wave * 8704);
        constexpr int I_GU = (DM / 64) * (FFE / 32), I_DN = (FFE / 64) * (DM / 32);
        for (int it = gw; it < NE * (2 * I_GU + I_DN); it += NGW) {
            const int e = it / (2 * I_GU + I_DN); int r = it % (2 * I_GU + I_DN);
            if (r < 2 * I_GU) { const int up = r >= I_GU; if (up) r -= I_GU;
                const int nblk = FFE / 32, kb = r / nblk, nb = r % nblk, n0 = 32 * nb;
                const float* W = (up ? P.in[24] : P.in[23]) + (size_t)e * DM * FFE;
                const size_t drow0 = (size_t)e * 4096 + (size_t)(n0 >> 7) * 256 + (n0 & 127) + (up ? 128 : 0);
                transpose_item_fp8(W, FFE, (unsigned char*)WGU, DM, 64 * kb, n0, drow0, scr, lane);
            } else { r -= 2 * I_GU;
                const int nblk = DM / 32, kb = r / nblk, nb = r % nblk;
                transpose_item_fp8(P.in[25] + (size_t)e * FFE * DM, DM, (unsigned char*)WDN, FFE, 64 * kb, 32 * nb, (size_t)e * DM + 32 * nb, scr, lane); }
        }
        if (BOTH(7)) xcd_barrier(bar, wave);
    }

    const bool pvalid = (G == 256);
    const int pj = bx / 8, pe = 2 * (bx % 8) + (pj >> 4), pb = pj & 15, pair = pb * NE + pe;

    if (IN(8)) {
        pg8::MoeUpOrder S{(const char*)RA, (const char*)WGU, SELI, pb, pe, pair, pvalid};
        LAS float* rsl = (LAS float*)(ldsl + X_SCR_OFF);
        { PH_IDS(); if (tid < CAP) rsl[tid] = pvalid ? SELRS[pair * CAP + tid] * 0.015625f : 0.f; }
        __syncthreads();
        pg8::EpiMoeUp E; E.hg = (unsigned char*)HG; E.rsl = rsl;
        pg8::gemm_phase<pg8::EpiMoeUp, pg8::MoeUpOrder, true, true, true>(ldsl, DM, S, E, wave);
        if (BOTH(8)) xcd_barrier(bar, wave);
    }

    if (IN(9)) {
        pg8::MoeDownOrder S{(const char*)HG, (const char*)WDN, bx, pvalid};
        LAS float* vall = (LAS float*)(ldsl + X_SCR_OFF);
        { PH_IDS(); for (int t = tid; t < 4 * CAP; t += 512) { const int i = t >> 8, x_ = bx & 7, j_ = bx >> 3, q_ = i * 8 + (j_ >> 2), e_ = 2 * x_ + (q_ >> 4), b_ = q_ & 15;
            vall[t] = pvalid ? SELV[(b_ * NE + e_) * CAP + (t & 255)] : 0.f; } }
        __syncthreads();
        pg8::EpiMoeDown E; E.ye = (unsigned char*)YE; E.vall = vall;
        pg8::gemm_phase<pg8::EpiMoeDown, pg8::MoeDownOrder, true, true, true>(ldsl, FFE, S, E, wave);
        if (BOTH(9)) xcd_barrier(bar, wave);
    }

    if (IN(10)) { PH_IDS();
        unsigned iv_next = lane < NE ? (unsigned)INV[(size_t)gw * NE + lane] : 0u;
        for (int m = gw; m < MTOK; m += NGW) {
            GAS f32x4* orow = (GAS f32x4*)(P.out + (size_t)m * DM) + lane; const GAS u32x2* hrow = (const GAS u32x2*)(H16 + (size_t)m * DM) + lane;
            const unsigned iv = iv_next;
            if (m + NGW < MTOK) iv_next = lane < NE ? (unsigned)INV[(size_t)(m + NGW) * NE + lane] : 0u;
            f32x4 v[4], sacc[4];
#pragma unroll
            for (int j = 0; j < 4; ++j) { const u32x2 hw = hrow[64 * j]; v[j] = (f32x4){bf_lo(hw.x), bf_hi(hw.x), bf_lo(hw.y), bf_hi(hw.y)}; sacc[j] = (f32x4){0.f, 0.f, 0.f, 0.f}; }
            unsigned mask = (unsigned)(__ballot(iv != 0u) & 0xFFFFull);
            const int bb = m >> 11;
            while (mask) {
                unsigned a[4][4];
#pragma unroll
                for (int c = 0; c < 4; ++c) {
                    if (mask) { const int e0 = __builtin_ctz(mask); mask &= mask - 1;
                        const unsigned s0 = (unsigned)__builtin_amdgcn_readlane((int)iv, e0) - 1u;
                        const GAS unsigned* y0 = (const GAS unsigned*)((const unsigned char*)YE + (size_t)((bb * NE + e0) * CAP + s0) * DM) + lane;
#pragma unroll
                        for (int j = 0; j < 4; ++j) a[c][j] = y0[64 * j];
                    } else {
#pragma unroll
                        for (int j = 0; j < 4; ++j) a[c][j] = 0u;
                    }
                }
#pragma unroll
                for (int c = 0; c < 4; ++c)
#pragma unroll
                    for (int j = 0; j < 4; ++j) { const f32x2 lo = __builtin_amdgcn_cvt_pk_f32_fp8((int)a[c][j], false), hi = __builtin_amdgcn_cvt_pk_f32_fp8((int)a[c][j], true);
                        sacc[j].x += lo.x; sacc[j].y += lo.y; sacc[j].z += hi.x; sacc[j].w += hi.y; }
            }
#pragma unroll
            for (int j = 0; j < 4; ++j) v[j] += sacc[j] * 0.015625f;
#pragma unroll
            for (int j = 0; j < 4; ++j) orow[64 * j] = v[j];
        }
    }
#undef IN
#undef BOTH
}

extern "C" void kernel_launch(void* const* d_in, const int* in_sizes, int n_in, void* d_out, int out_size, void* d_ws, size_t ws_size, hipStream_t stream) {
    static int grid = 0;
    if (grid == 0) {
        if (n_in != 26 || in_sizes[0] != MTOK * DM || out_size != MTOK * DM || ws_size < WS_END) {
            fprintf(stderr, "kernel_launch: shape/workspace mismatch: n_in %d in0 %d out %d ws %zu (need %zu)\n", n_in, n_in > 0 ? in_sizes[0] : -1, out_size, ws_size, (size_t)WS_END); grid = -1; return; }
        int dev = 0, cus = 0;
        if (hipGetDevice(&dev) != hipSuccess || hipDeviceGetAttribute(&cus, hipDeviceAttributeMultiprocessorCount, dev) != hipSuccess) { grid = -1; return; }
        if (hipFuncSetAttribute((const void*)mk_fwd, hipFuncAttributeMaxDynamicSharedMemorySize, LDS_BYTES) != hipSuccess) { fprintf(stderr, "kernel_launch: hipFuncSetAttribute failed\n"); grid = -1; return; }
        int per_cu = 0;
        if (hipOccupancyMaxActiveBlocksPerMultiprocessor(&per_cu, (const void*)mk_fwd, 512, LDS_BYTES) != hipSuccess || per_cu < 1) fprintf(stderr, "kernel_launch: occupancy query says %d\n", per_cu);
        (void)hipGetLastError();
        grid = cus;
        if (grid != 256) fprintf(stderr, "kernel_launch: %d CUs; the MoE phases need 256\n", grid);
    }
    if (grid < 0) return;
    (void)hipMemsetAsync((char*)d_ws + WS_CTL, 0, CTL_ZERO_BYTES, stream);
    Params p{};
    for (int i = 0; i < 26; ++i) p.in[i] = (const float*)d_in[i];
    p.out = (float*)d_out; p.ws = (unsigned char*)d_ws;
#if MK_ONE_LAUNCH
    p.ph_lo = 0; p.ph_hi = NPHASE;
    hipLaunchKernelGGL(mk_fwd, dim3(grid), dim3(512), LDS_BYTES, stream, p);
#else
    for (int ph = 0; ph < NPHASE; ++ph) { p.ph_lo = ph; p.ph_hi = ph + 1; hipLaunchKernelGGL(mk_fwd, dim3(grid), dim3(512), LDS_BYTES, stream, p);
#ifdef MK_PROBE_ATTN
        if (ph == 2) { Params q = p; q.ph_lo = 3; q.ph_hi = 4; q.probe = 1; hipLaunchKernelGGL(mk_fwd, dim3(grid), dim3(512), LDS_BYTES, stream, q); }
#endif
#ifdef MK_PROBE_P1
        if (ph == 1) { Params q = p; q.probe = 1; hipLaunchKernelGGL(mk_fwd, dim3(grid), dim3(512), LDS_BYTES, stream, q); }
#endif
#ifdef MK_REP_PHASE
        if (ph == MK_REP_PHASE) hipLaunchKernelGGL(mk_fwd, dim3(grid), dim3(512), LDS_BYTES, stream, p);
#endif
    }
#endif
    const hipError_t le = hipPeekAtLastError();
    if (le != hipSuccess) fprintf(stderr, "kernel_launch: launch failed: %s\n", hipGetErrorName(le));
}
```

```cpp
#include <hip/hip_runtime.h>
#include <cstdio>
#include <cstdint>

#define GAS __attribute__((address_space(1)))
#define LAS __attribute__((address_space(3)))
typedef unsigned short bf16_t;
typedef short bf16x8 __attribute__((ext_vector_type(8)));
typedef short s16x4 __attribute__((ext_vector_type(4)));
typedef float f32x2 __attribute__((ext_vector_type(2)));
typedef float f32x4 __attribute__((ext_vector_type(4)));
typedef float f32x16 __attribute__((ext_vector_type(16)));
typedef unsigned u32x2 __attribute__((ext_vector_type(2)));
typedef unsigned u32x4 __attribute__((ext_vector_type(4)));
typedef unsigned long long u64;
typedef int i32x8 __attribute__((ext_vector_type(8)));
typedef int i32x4 __attribute__((ext_vector_type(4)));

#ifndef MK_ONE_LAUNCH
#define MK_ONE_LAUNCH 1
#endif

constexpr int BATCH = 16, SEQ = 2048, DM = 1024, MTOK = BATCH * SEQ, NH = 8, DIN = 7168, NE = 16, CAP = 256, FFE = 2048;
constexpr float EPS = 1e-6f;
constexpr float LOG2E = 1.4426950408889634f;
constexpr int NPHASE = 11;

constexpr size_t MiB = 1u << 20;
constexpr size_t WS_CTL = 0, CTL_ZERO_BYTES = 64 * 1024;
constexpr size_t WS_TAB = 1 * MiB;
constexpr size_t WS_WIN = 2 * MiB;
constexpr size_t WS_WCAT = 16 * MiB;
constexpr size_t WS_WOUT = 20 * MiB;
constexpr size_t WS_WLRU = 22 * MiB;
constexpr size_t WS_AFF = 23 * MiB;
constexpr size_t WS_SELI = 25 * MiB;
constexpr size_t WS_SELV = 25 * MiB + 256 * 1024;
constexpr size_t WS_SELRS = 25 * MiB + 512 * 1024;
constexpr size_t WS_RS = 25 * MiB + 768 * 1024;
constexpr size_t WS_RA = 26 * MiB;
constexpr size_t WS_Q = 90 * MiB, WS_K = 154 * MiB, WS_V = 218 * MiB;
constexpr size_t WS_WGU = 90 * MiB;
constexpr size_t WS_WDN = 218 * MiB;
constexpr size_t WS_XL = 282 * MiB;
constexpr size_t WS_GY = 346 * MiB;
constexpr size_t WS_LO = 410 * MiB;
constexpr size_t WS_HG = 282 * MiB;
constexpr size_t WS_YE = 90 * MiB;
constexpr size_t WS_XN8 = 474 * MiB;
constexpr size_t WS_WIN8 = 506 * MiB;
constexpr size_t WS_H16 = 410 * MiB;
constexpr size_t WS_INV = 538 * MiB;
constexpr size_t WS_END = 539 * MiB;
constexpr int CW_BAR = 1024;

constexpr int RING_BYTES = 131072;
constexpr int X_SCR_OFF = 131072;
constexpr int X_IDX_OFF = X_SCR_OFF + 8 * 2304;
constexpr int MISC_OFF = X_IDX_OFF + 2048;
constexpr int LDS_BYTES = 152576;

typedef __bf16 bf16x2_t __attribute__((ext_vector_type(2)));
__device__ __forceinline__ unsigned cvt_pk_bf16(float lo, float hi) { const f32x2 v = {lo, hi}; const bf16x2_t b = __builtin_convertvector(v, bf16x2_t); return __builtin_bit_cast(unsigned, b); }
__device__ __forceinline__ float bf_lo(unsigned w) { return __uint_as_float(w << 16); }
__device__ __forceinline__ float bf_hi(unsigned w) { return __uint_as_float(w & 0xffff0000u); }
__device__ __forceinline__ float bf1(bf16_t b) { return __uint_as_float(((unsigned)b) << 16); }
__device__ __forceinline__ bf16_t f2bf(float f) { return (bf16_t)(cvt_pk_bf16(f, 0.f) & 0xffffu); }
__device__ __forceinline__ unsigned pk4_fp8(float a, float b, float c, float d) { int w = 0; w = __builtin_amdgcn_cvt_pk_fp8_f32(a, b, w, false); w = __builtin_amdgcn_cvt_pk_fp8_f32(c, d, w, true); return (unsigned)w; }
__device__ __forceinline__ int lane_id() { int r; asm volatile("v_mbcnt_lo_u32_b32 %0, -1, 0\n\tv_mbcnt_hi_u32_b32 %0, -1, %0" : "=v"(r)); return r; }
__device__ __forceinline__ float wave_sum(float v) {
#pragma unroll
    for (int o = 1; o < 64; o <<= 1) v += __shfl_xor(v, o);
    return v;
}
constexpr float GATE_Q = 255.996f, GATE_QI = 1.0f / 255.996f, GATE_QL = -7.99997745f;
template <int CTRL> __device__ __forceinline__ float dppf(float x) { return __uint_as_float((unsigned)__builtin_amdgcn_mov_dpp((int)__float_as_uint(x), CTRL, 0xF, 0xF, true)); }
__device__ __forceinline__ float row16_max(float x) { x = fmaxf(x, dppf<0xB1>(x)); x = fmaxf(x, dppf<0x4E>(x)); x = fmaxf(x, dppf<0x141>(x)); x = fmaxf(x, dppf<0x140>(x)); return x; }
__device__ __forceinline__ float row16_sum(float x) { x += dppf<0xB1>(x); x += dppf<0x4E>(x); x += dppf<0x141>(x); x += dppf<0x140>(x); return x; }
__device__ __forceinline__ float sigmoidf_(float x) { return __builtin_amdgcn_rcpf(1.0f + __builtin_amdgcn_exp2f(-x * LOG2E)); }
__device__ __forceinline__ float gelu_tanh(float y) { const float u = 0.7978845608028654f * (y + 0.044715f * y * y * y); return y * __builtin_amdgcn_rcpf(1.0f + __builtin_amdgcn_exp2f(-2.0f * LOG2E * u)); }
#define LDS_WAIT() asm volatile("s_waitcnt lgkmcnt(0)" ::: "memory")
#define VM_WAIT() asm volatile("s_waitcnt vmcnt(0)" ::: "memory")

#define XB_TMO      128
#define XB_XCNT(j)  (256  + 64 * (j))
#define XB_XSUB(j)  (1280 + 64 * (j))
#define XB_XGEN(j)  (2304 + 64 * (j))
#define XB_TOP      3328
#define XB_TOPGEN   3392
#define XCD_BAR_WORDS 3456
#define XB_SPIN_CAP (1u << 18)
__device__ __forceinline__ unsigned xb_ld(unsigned* p)              { return __hip_atomic_load(p, __ATOMIC_RELAXED, __HIP_MEMORY_SCOPE_AGENT); }
__device__ __forceinline__ unsigned xb_add(unsigned* p, unsigned v) { return __hip_atomic_fetch_add(p, v, __ATOMIC_RELAXED, __HIP_MEMORY_SCOPE_AGENT); }
__device__ __forceinline__ unsigned xb_xcc_id() { return (unsigned)__builtin_amdgcn_s_getreg((3 << 11) | 20) & 0xFu; }
#define XB_SPIN(cond, bar) do { unsigned _sp = 0; while (cond) { __builtin_amdgcn_s_sleep(1); \
    if ((++_sp & 255u) == 0u) { if (xb_ld(&(bar)[XB_TMO])) break; if (_sp > XB_SPIN_CAP) { atomicAdd(&(bar)[XB_TMO], 1u); break; } } } } while (0)
struct XcdBarrier { unsigned* bar; unsigned x; volatile LAS unsigned* st; };
__device__ __forceinline__ XcdBarrier xcd_barrier_post(unsigned* bar, volatile LAS unsigned* st) {
    XcdBarrier b; b.bar = bar; b.x = xb_xcc_id(); b.st = st;
    if (threadIdx.x == 0) (void)xb_add(&bar[XB_XCNT(b.x)], 1u);
    return b;
}
__device__ __forceinline__ void xcd_barrier_complete(unsigned* bar, unsigned x, unsigned& nloc, unsigned& nx) {
    const unsigned G = gridDim.x * gridDim.y * gridDim.z;
    unsigned sum, cnt, mine, sp = 0u;
    for (;;) {
        sum = 0u; cnt = 0u; mine = 0u;
#pragma unroll
        for (unsigned j = 0; j < 16; ++j) { const unsigned c = xb_ld(&bar[XB_XCNT(j)]); sum += c; cnt += (c > 0u) ? 1u : 0u; mine = (j == x) ? c : mine; }
        if (sum == G) break;
        __builtin_amdgcn_s_sleep(1);
        if ((++sp & 255u) == 0u) { if (xb_ld(&bar[XB_TMO])) break; if (sp > XB_SPIN_CAP) { atomicAdd(&bar[XB_TMO], 1u); break; } }
    }
    nloc = mine > 0u ? mine : 1u; nx = cnt > 0u ? cnt : 1u;
}
__device__ __forceinline__ int lane_id();
__device__ __forceinline__ void xcd_barrier(const XcdBarrier& b, const int wave) {
    asm volatile("s_waitcnt vmcnt(0)" ::: "memory");
    __syncthreads();
    if (wave == 0 && lane_id() == 0) {
        unsigned* bar = b.bar;
        __builtin_amdgcn_s_waitcnt(0);
        unsigned nloc = b.st[0], nx = b.st[1];
        if (nloc == 0u) { xcd_barrier_complete(bar, b.x, nloc, nx); b.st[0] = nloc; b.st[1] = nx; }
        const unsigned old = xb_add(&bar[XB_XSUB(b.x)], 1u);
        const unsigned gen = old / nloc;
        if (old + 1u == (gen + 1u) * nloc) {
            __builtin_amdgcn_fence(__ATOMIC_RELEASE, "agent");
            asm volatile("s_waitcnt vmcnt(0)" ::: "memory");
            const unsigned og = xb_add(&bar[XB_TOP], 1u);
            const unsigned tg = og / nx;
            if (og + 1u == (tg + 1u) * nx) xb_add(&bar[XB_TOPGEN], 1u);
            else XB_SPIN(xb_ld(&bar[XB_TOPGEN]) == tg, bar);
            __builtin_amdgcn_fence(__ATOMIC_ACQUIRE, "agent");
            xb_add(&bar[XB_XGEN(b.x)], 1u);
            asm volatile("s_waitcnt vmcnt(0)" ::: "memory");
        } else {
            XB_SPIN(xb_ld(&bar[XB_XGEN(b.x)]) == gen, bar);
            __builtin_amdgcn_fence(__ATOMIC_ACQUIRE, "agent");
            asm volatile("s_waitcnt vmcnt(0)" ::: "memory");
        }
    }
    __syncthreads();
}

namespace pg8 {
constexpr int BM = 256, BK = 64, HALF = 128, HTB = HALF * BK * 2, STAGE_BYTES = 8 * HTB, NXCD = 8, WGM = 8;
__host__ __device__ __forceinline__ int lds_byte(int r, int c) { const int st = (r >> 4) * 2 + (c >> 5), rr = r & 15, cc = c & 31, ob = rr * 64 + cc * 2; return st * 1024 + (ob ^ (((ob >> 9) & 1) << 5)); }
__host__ __device__ __forceinline__ void stage_rc(int b, int& R, int& C) { const int st = b / 1024, sb = b % 1024, swz = sb ^ (((sb >> 9) & 1) << 5); R = (st >> 1) * 16 + swz / 64; C = (st & 1) * 32 + (swz % 64) / 2; }
__host__ __device__ __forceinline__ int perm32(int rho) { const int n = rho >> 4, i = rho & 15; return 8 * (i >> 2) + 4 * n + (i & 3); }

struct Unit { int pm, pn, aux; const char* A; const char* B; const char* A2; };
__device__ __forceinline__ const char* uni(const char* p) {
    const unsigned long long v = (unsigned long long)p; const unsigned lo = __builtin_amdgcn_readfirstlane((unsigned)v), hi = __builtin_amdgcn_readfirstlane((unsigned)(v >> 32));
    return (const char*)(((unsigned long long)hi << 32) | lo);
}

__device__ __forceinline__ bool tile_of(int L, int nM, int nN, int& pm, int& pn) {
    const int nwg = nM * nN; if (L >= nwg) return false;
    int wgid = L; { const int q = nwg / NXCD, r = nwg % NXCD, xcd = wgid % NXCD, off = wgid / NXCD; wgid = (xcd < r ? xcd * (q + 1) : r * (q + 1) + (xcd - r) * q) + off; }
    const int nig = WGM * nN, gid = wgid / nig, fm = gid * WGM, gsz = (nM - fm) < WGM ? (nM - fm) : WGM;
    pm = fm + ((wgid % nig) % gsz); pn = (wgid % nig) / gsz; return true;
}

template <class Epi, class Sched, bool ALIGN_EPI, bool SP2, bool FP8 = false, int SCALE_B = 0x7f7f7f7f>
__device__ __forceinline__ void gemm_phase(LAS unsigned char* lds, const int KB  , const Sched& S, const Epi& E, const int wid  ) {
    const int lane = lane_id(), tid = wid * 64 + lane, wr = wid >> 2, wc = wid & 3, fr = lane & 15, fq = lane >> 4;
    const int nt = KB / (BK * 2);
    unsigned voffA[2][2], voffB[2];
#pragma unroll
    for (int i = 0; i < 2; ++i) { int R, C; stage_rc(tid * 16 + i * 8192, R, C);
        voffB[i] = (unsigned)(Epi::browmap(R) * KB + C * 2);
#pragma unroll
        for (int h = 0; h < 2; ++h) voffA[h][i] = S.aoff(R + HALF * h, C); }
    const size_t kstep = (size_t)(BK * 2);
    const size_t hstepB = (size_t)Epi::BHSTEP_ROWS * KB;
    const unsigned ldsw = (unsigned)wid * 1024u;
    const int aoff = lds_byte(wr * 64 + fr, fq * 8), boff = lds_byte(wc * 32 + fr, fq * 8);
#define PG8_SA(b, h) (((b) * 2 + (h)) * HTB)
#define PG8_SB(b, h) ((4 + (b) * 2 + (h)) * HTB)
#define PG8_STAGE_A(bufoff, gbase, h) do { _Pragma("unroll") for (int _i = 0; _i < 2; ++_i) { unsigned vo_ = voffA[h][_i]; asm volatile("" : "+v"(vo_)); \
        __builtin_amdgcn_global_load_lds((const unsigned*)((const char*)(gbase) + vo_), (LAS unsigned*)(lds + (bufoff) + ldsw + _i * 8192), 16, 0, 0); } } while (0)
#define PG8_STAGE_B(bufoff, gbase) do { _Pragma("unroll") for (int _i = 0; _i < 2; ++_i) { unsigned vo_ = voffB[_i]; asm volatile("" : "+v"(vo_)); \
        __builtin_amdgcn_global_load_lds((const unsigned*)((const char*)(gbase) + vo_), (LAS unsigned*)(lds + (bufoff) + ldsw + _i * 8192), 16, 0, 0); } } while (0)
#define PG8_LD8(p) __builtin_shufflevector(*(const LAS i32x4*)(p), *(const LAS i32x4*)((p) + 1024), 0, 1, 2, 3, 4, 5, 6, 7)
#define PG8_LDA(dst, b, h) do { _Pragma("unroll") for (int m = 0; m < 4; ++m) { if constexpr (FP8) { dst##8[m] = PG8_LD8(lds + PG8_SA(b, h) + aoff + m * 2048); } else { _Pragma("unroll") for (int k = 0; k < 2; ++k) dst[m][k] = *(const LAS bf16x8*)(lds + PG8_SA(b, h) + aoff + m * 2048 + k * 1024); } } } while (0)
#define PG8_LDB(dst, b, h) do { _Pragma("unroll") for (int n = 0; n < 2; ++n) { if constexpr (FP8) { dst##8[n] = PG8_LD8(lds + PG8_SB(b, h) + boff + n * 2048); } else { _Pragma("unroll") for (int k = 0; k < 2; ++k) dst[n][k] = *(const LAS bf16x8*)(lds + PG8_SB(b, h) + boff + n * 2048 + k * 1024); } } } while (0)
#define PG8_MMA(ai, bj, At, Bt) do { if constexpr (FP8) __builtin_amdgcn_sched_barrier(0); __builtin_amdgcn_s_setprio(1); _Pragma("unroll") for (int m = 0; m < 4; ++m) _Pragma("unroll") for (int n = 0; n < 2; ++n) { \
        if constexpr (FP8) { acc[ai][bj][m][n] = __builtin_amdgcn_mfma_scale_f32_16x16x128_f8f6f4(Bt##8[n], At##8[m], acc[ai][bj][m][n], 0, 0, 0, SCALE_B, 0, 0x7f7f7f7f); } \
        else { _Pragma("unroll") for (int k = 0; k < 2; ++k) acc[ai][bj][m][n] = __builtin_amdgcn_mfma_f32_16x16x32_bf16(Bt[n][k], At[m][k], acc[ai][bj][m][n], 0, 0, 0); } } \
        __builtin_amdgcn_s_setprio(0); if constexpr (FP8) __builtin_amdgcn_sched_barrier(0); } while (0)
#define PG8_WAIT_V(n) asm volatile("s_waitcnt vmcnt(" #n ")" ::: "memory")
#define PG8_WAIT_L(n) asm volatile("s_waitcnt lgkmcnt(" #n ")" ::: "memory")
#define PG8_BAR __builtin_amdgcn_s_barrier()
#define PG8_SCHED __builtin_amdgcn_sched_barrier(0)
    Unit cur, nxt; int ui = 0;
    if (!S.next(0, cur)) return;
    f32x4 acc[2][2][4][2];
#pragma unroll
    for (int a = 0; a < 2; ++a)
#pragma unroll
        for (int b = 0; b < 2; ++b)
#pragma unroll
            for (int m = 0; m < 4; ++m)
#pragma unroll
                for (int n = 0; n < 2; ++n) acc[a][b][m][n] = (f32x4){0.f, 0.f, 0.f, 0.f};
    bf16x8 At[4][2], B0[2][2], B1[2][2]; i32x8 At8[4], B08[2], B18[2];
    const char* cA = uni(cur.A); const char* cB = uni(cur.B); const char* cA2 = uni(cur.A2);
    if constexpr (SP2) {
        PG8_STAGE_B(PG8_SB(0, 0), cB); PG8_STAGE_B(PG8_SB(0, 1), cB + hstepB); PG8_STAGE_A(PG8_SA(0, 0), cA, 0); PG8_STAGE_A(PG8_SA(0, 1), cA, 1);
        if (wr == 1) PG8_BAR;
        PG8_WAIT_V(2); PG8_BAR;
        PG8_STAGE_B(PG8_SB(1, 0), cB + kstep); PG8_STAGE_A(PG8_SA(1, 0), cA + kstep, 0); PG8_STAGE_B(PG8_SB(1, 1), cB + hstepB + kstep);
        PG8_WAIT_V(6); PG8_BAR;
    } else {
        PG8_STAGE_B(PG8_SB(0, 0), cB); PG8_STAGE_A(PG8_SA(0, 0), cA, 0); PG8_STAGE_B(PG8_SB(0, 1), cB + hstepB); PG8_STAGE_A(PG8_SA(0, 1), cA, 1);
        if (wr == 1) PG8_BAR;
        PG8_WAIT_V(4); PG8_BAR;
        PG8_STAGE_B(PG8_SB(1, 0), cB + kstep); PG8_STAGE_A(PG8_SA(1, 0), cA + kstep, 0); PG8_STAGE_B(PG8_SB(1, 1), cB + hstepB + kstep);
        PG8_WAIT_V(6); PG8_BAR;
    }
    for (;;) {
        const bool has_next = S.next(ui + 1, nxt);
        const char* nA = uni(has_next ? nxt.A : cA); const char* nB = uni(has_next ? nxt.B : cB);
#pragma nounroll
        for (int t = 0; t < nt; t += 2) {
            const bool last = (t == nt - 2);
            const char* a1 = ((Sched::TSW && t + 1 >= Sched::TSW) ? cA2 : cA) + (size_t)(t + 1) * kstep;
            const char* a2 = last ? nA : ((Sched::TSW && t + 2 >= Sched::TSW) ? cA2 : cA) + (size_t)(t + 2) * kstep; const char* b2 = last ? nB : cB + (size_t)(t + 2) * kstep;
            const char* a3 = a2 + kstep; const char* b3 = b2 + kstep;
            if constexpr (Sched::TSW != 0) { if (t == Sched::TSW) { const int l2 = lane_id(); E.mid(acc, cur, wr, wc, l2 & 15, l2 >> 4); } }
            if constexpr (SP2) {
            PG8_LDB(B0, 0, 0); PG8_LDB(B1, 0, 1); PG8_SCHED; PG8_LDA(At, 0, 0); PG8_STAGE_A(PG8_SA(1, 1), a1, 1);
            PG8_WAIT_V(8); PG8_WAIT_L(0); PG8_BAR; PG8_MMA(0, 0, At, B0); PG8_MMA(0, 1, At, B1); PG8_BAR; PG8_SCHED;
            PG8_LDA(At, 0, 1); PG8_STAGE_B(PG8_SB(0, 0), b2); PG8_STAGE_B(PG8_SB(0, 1), b2 + hstepB); PG8_STAGE_A(PG8_SA(0, 0), a2, 0);
            PG8_WAIT_V(8); PG8_WAIT_L(0); PG8_BAR; PG8_MMA(1, 0, At, B0); PG8_MMA(1, 1, At, B1); PG8_BAR; PG8_SCHED;
            PG8_LDB(B0, 1, 0); PG8_LDB(B1, 1, 1); PG8_SCHED; PG8_LDA(At, 1, 0); PG8_STAGE_A(PG8_SA(0, 1), a2, 1);
            PG8_WAIT_V(8); PG8_WAIT_L(0); PG8_BAR; PG8_MMA(0, 0, At, B0); PG8_MMA(0, 1, At, B1); PG8_BAR; PG8_SCHED;
            PG8_LDA(At, 1, 1); PG8_STAGE_B(PG8_SB(1, 0), b3); PG8_STAGE_B(PG8_SB(1, 1), b3 + hstepB); PG8_STAGE_A(PG8_SA(1, 0), a3, 0);
            PG8_WAIT_V(8); PG8_WAIT_L(0); PG8_BAR; PG8_MMA(1, 0, At, B0); PG8_MMA(1, 1, At, B1); PG8_BAR; PG8_SCHED;
            } else {
            PG8_LDB(B0, 0, 0); PG8_SCHED; PG8_LDA(At, 0, 0); PG8_STAGE_A(PG8_SA(1, 1), a1, 1);
            PG8_WAIT_L(8); PG8_BAR; PG8_WAIT_L(0); PG8_MMA(0, 0, At, B0); PG8_BAR; PG8_SCHED;
            PG8_LDB(B1, 0, 1); PG8_STAGE_B(PG8_SB(0, 0), b2);
            PG8_BAR; PG8_WAIT_L(0); PG8_MMA(0, 1, At, B1); PG8_BAR;
            PG8_LDA(At, 0, 1); PG8_STAGE_A(PG8_SA(0, 0), a2, 0);
            PG8_BAR; PG8_WAIT_L(0); PG8_MMA(1, 0, At, B0); PG8_BAR; PG8_SCHED;
            PG8_STAGE_B(PG8_SB(0, 1), b2 + hstepB);
            PG8_WAIT_V(6); PG8_BAR; PG8_MMA(1, 1, At, B1); PG8_BAR;
            PG8_LDB(B0, 1, 0); PG8_SCHED; PG8_LDA(At, 1, 0); PG8_STAGE_A(PG8_SA(0, 1), a2, 1);
            PG8_WAIT_L(8); PG8_BAR; PG8_WAIT_L(0); PG8_MMA(0, 0, At, B0); PG8_BAR; PG8_SCHED;
            PG8_LDB(B1, 1, 1); PG8_STAGE_B(PG8_SB(1, 0), b3);
            PG8_BAR; PG8_WAIT_L(0); PG8_MMA(0, 1, At, B1); PG8_BAR;
            PG8_LDA(At, 1, 1); PG8_STAGE_A(PG8_SA(1, 0), a3, 0);
            PG8_BAR; PG8_WAIT_L(0); PG8_MMA(1, 0, At, B0); PG8_BAR; PG8_SCHED;
            PG8_STAGE_B(PG8_SB(1, 1), b3 + hstepB);
            PG8_WAIT_V(6); PG8_BAR; PG8_MMA(1, 1, At, B1); PG8_BAR;
            }
        }
        if constexpr (ALIGN_EPI) { if (wr == 0) PG8_BAR; }
        { const int l2 = lane_id(); E(acc, cur, wr, wc, l2 & 15, l2 >> 4, wid, l2); }
        if (!has_next) break;
#pragma unroll
        for (int a = 0; a < 2; ++a)
#pragma unroll
            for (int b = 0; b < 2; ++b)
#pragma unroll
                for (int m = 0; m < 4; ++m)
#pragma unroll
                    for (int n = 0; n < 2; ++n) acc[a][b][m][n] = (f32x4){0.f, 0.f, 0.f, 0.f};
        cur = nxt; cA = nA; cB = nB; cA2 = uni(cur.A2); ++ui;
        if constexpr (ALIGN_EPI) { if (wr == 1) PG8_BAR; }
    }
    PG8_WAIT_V(0);
    if constexpr (!ALIGN_EPI) { if (wr == 0) PG8_BAR; }
    PG8_BAR;
#undef PG8_SA
#undef PG8_SB
#undef PG8_STAGE_A
#undef PG8_STAGE_B
#undef PG8_LDA
#undef PG8_LDB
#undef PG8_MMA
#undef PG8_LD8
#undef PG8_WAIT_V
#undef PG8_WAIT_L
#undef PG8_BAR
#undef PG8_SCHED
}

struct DenseOrder {
    static constexpr int TSW = 0;
    const char* A; const char* Bt; int arow, brow, nM, nN, G, c;
    __device__ __forceinline__ unsigned aoff(int row, int C) const { return (unsigned)(row * arow + C * 2); }
    __device__ __forceinline__ bool next(int i, Unit& u) const {
        int pm, pn; if (!tile_of(i * G + c, nM, nN, pm, pn)) return false;
        u.pm = pm; u.pn = pn; u.aux = 0; u.A = A + (size_t)pm * BM * arow; u.A2 = u.A; u.B = Bt + (size_t)pn * BM * brow; return true;
    }
};
struct BranchOrder {
    static constexpr int TSW = 16;
    const char* A0; const char* A1; const char* Bt; int G, c;
    __device__ __forceinline__ unsigned aoff(int row, int C) const { return (unsigned)(row * DM + C) * 2u; }
    __device__ __forceinline__ bool next(int i, Unit& u) const {
        int pm, pn; if (!tile_of(i * G + c, MTOK / BM, DM / BM, pm, pn)) return false;
        u.pm = pm; u.pn = pn; u.aux = 0; u.A = A0 + (size_t)pm * BM * DM * 2; u.A2 = A1 + (size_t)pm * BM * DM * 2 - TSW * 128; u.B = Bt + (size_t)pn * BM * (2 * DM) * 2; return true;
    }
};
struct MoeUpOrder {
    static constexpr int TSW = 0;
    const char* hn; const char* wgu; const int* idx; int b, e, pair; bool valid;
    __device__ __forceinline__ unsigned aoff(int row, int C) const { const int tok = valid ? idx[pair * CAP + row] : 0; return (unsigned)((b * SEQ + tok) * DM + C * 2); }
    __device__ __forceinline__ bool next(int i, Unit& u) const {
        if (!valid || i >= 16) return false;
        u.pm = pair; u.pn = i; u.aux = 0; u.A = hn; u.A2 = hn; u.B = wgu + (size_t)((e * 16 + i) * 256) * DM; return true;
    }
};
struct MoeDownOrder {
    static constexpr int TSW = 0;
    const char* hg; const char* wdn; int c; bool valid;
    __device__ __forceinline__ unsigned aoff(int row, int C) const { return (unsigned)(row * FFE + C * 2); }
    __device__ __forceinline__ bool next(int i, Unit& u) const {
        if (!valid || i >= 4) return false;
        const int x = c & 7, j = c >> 3, nt = j & 3, q = i * 8 + (j >> 2), e = 2 * x + (q >> 4), b = q & 15, pair = b * NE + e;
        u.pm = pair; u.pn = nt; u.aux = i; u.A = hg + (size_t)pair * CAP * FFE; u.A2 = u.A; u.B = wdn + (size_t)(e * DM + nt * BM) * FFE; return true;
    }
};

struct EpiProj {
    static constexpr int BHSTEP_ROWS = 32;
    __host__ __device__ static __forceinline__ int browmap(int R) { return 64 * (R >> 5) + perm32(R & 31); }
    bf16_t *q, *k, *v, *xl, *gy; const LAS float* gl;
    __device__ __forceinline__ void operator()(const f32x4 (&acc)[2][2][4][2], const Unit& u, int wr, int wc, int fr, int fq, int wid, int lane) const {
        const int type = u.pn >> 2;
        const int row0 = u.pm * BM + wr * 64 + fr, col0 = (u.pn & 3) * 256 + 64 * wc + 8 * fq;
        bf16_t* dst = type == 0 ? q : type == 1 ? k : type == 2 ? v : type == 3 ? xl : gy;
        if (type < 2) {
            const LAS float* g = gl + type * 64;
            f32x4 gv[2][2];
#pragma unroll
            for (int bj = 0; bj < 2; ++bj)
#pragma unroll
                for (int n = 0; n < 2; ++n) gv[bj][n] = *(const LAS f32x4*)(g + 32 * bj + 8 * fq + 4 * n);
#pragma unroll
            for (int ai = 0; ai < 2; ++ai)
#pragma unroll
                for (int m = 0; m < 4; ++m) {
                    float ss = 0.f;
#pragma unroll
                    for (int bj = 0; bj < 2; ++bj)
#pragma unroll
                        for (int n = 0; n < 2; ++n) { const f32x4 x = acc[ai][bj][m][n]; ss += (x[0] * x[0] + x[1] * x[1]) + (x[2] * x[2] + x[3] * x[3]); }
                    { auto r16 = __builtin_amdgcn_permlane16_swap(__float_as_uint(ss), __float_as_uint(ss), false, false); ss = __uint_as_float(r16[0]) + __uint_as_float(r16[1]);
                      auto r32 = __builtin_amdgcn_permlane32_swap(__float_as_uint(ss), __float_as_uint(ss), false, false); ss = __uint_as_float(r32[0]) + __uint_as_float(r32[1]); }
                    const float rs = __builtin_amdgcn_rsqf(ss * (1.0f / 64.0f) + EPS) * (type == 0 ? 0.125f * LOG2E : 1.0f);
                    bf16_t* rowp = dst + (size_t)(row0 + ai * HALF + m * 16) * DM + col0;
#pragma unroll
                    for (int bj = 0; bj < 2; ++bj) { const f32x4 v0 = acc[ai][bj][m][0] * rs * gv[bj][0], v1 = acc[ai][bj][m][1] * rs * gv[bj][1];
                        u32x4 w; w.x = cvt_pk_bf16(v0[0], v0[1]); w.y = cvt_pk_bf16(v0[2], v0[3]); w.z = cvt_pk_bf16(v1[0], v1[1]); w.w = cvt_pk_bf16(v1[2], v1[3]);
                        *(u32x4*)(rowp + 32 * bj) = w; }
                }
        } else {
#pragma unroll
            for (int ai = 0; ai < 2; ++ai)
#pragma unroll
                for (int m = 0; m < 4; ++m) { bf16_t* rowp = dst + (size_t)(row0 + ai * HALF + m * 16) * DM + col0;
#pragma unroll
                    for (int bj = 0; bj < 2; ++bj) { f32x4 v0 = acc[ai][bj][m][0], v1 = acc[ai][bj][m][1];
                        if (type == 4) {
#pragma unroll
                            for (int j = 0; j < 4; ++j) { v0[j] = gelu_tanh(v0[j]); v1[j] = gelu_tanh(v1[j]); }
                        }
                        u32x4 w; w.x = cvt_pk_bf16(v0[0], v0[1]); w.y = cvt_pk_bf16(v0[2], v0[3]); w.z = cvt_pk_bf16(v1[0], v1[1]); w.w = cvt_pk_bf16(v1[2], v1[3]);
                        *(u32x4*)(rowp + 32 * bj) = w; } }
        }
    }
};
struct WideMap { static constexpr int BHSTEP_ROWS = 8; __host__ __device__ static __forceinline__ int browmap(int R) { return 64 * (R >> 5) + 16 * ((R >> 2) & 3) + 4 * ((R >> 4) & 1) + (R & 3); } };
struct EpiGate : WideMap {
    unsigned char *sa, *sr; float gsc;
    __device__ __forceinline__ void operator()(const f32x4 (&acc)[2][2][4][2], const Unit& u, int wr, int wc, int fr, int fq, int wid, int lane) const {
        int row0 = u.pm * BM + wr * 64 + fr; asm volatile("" : "+v"(row0));
        const int col0 = (u.pn & 3) * 256 + 64 * wc + 16 * fq;
        unsigned char* d8 = (u.pn >> 2) == 0 ? sa : sr;
        const float ke = -LOG2E * gsc;
#pragma unroll
        for (int ai = 0; ai < 2; ++ai)
#pragma unroll
            for (int m = 0; m < 4; ++m) { unsigned char* rowp = d8 + (unsigned)((row0 + ai * HALF + m * 16) * DM + col0);
                unsigned wd[4];
#pragma unroll
                for (int bj = 0; bj < 2; ++bj)
#pragma unroll
                    for (int n = 0; n < 2; ++n) { unsigned b[4];
#pragma unroll
                        for (int j = 0; j < 4; ++j) b[j] = (unsigned)(__builtin_amdgcn_rcpf(GATE_QI + __builtin_amdgcn_exp2f(acc[ai][bj][m][n][j] * ke + GATE_QL)));
                        wd[2 * bj + n] = (b[0] | (b[1] << 8)) | ((b[2] | (b[3] << 8)) << 16); }
                *(u32x4*)rowp = (u32x4){wd[0], wd[1], wd[2], wd[3]}; }
    }
};
struct EpiNull { static constexpr int BHSTEP_ROWS = 32; __host__ __device__ static __forceinline__ int browmap(int R) { return 64 * (R >> 5) + perm32(R & 31); }
    float* sink;
    __device__ __forceinline__ void operator()(const f32x4 (&acc)[2][2][4][2], const Unit& u, int wr, int wc, int fr, int fq, int wid, int lane) const {
        float s = 0.f;
#pragma unroll
        for (int ai = 0; ai < 2; ++ai)
#pragma unroll
            for (int bj = 0; bj < 2; ++bj)
#pragma unroll
                for (int m = 0; m < 4; ++m)
#pragma unroll
                    for (int n = 0; n < 2; ++n) s += acc[ai][bj][m][n][0] + acc[ai][bj][m][n][1] + acc[ai][bj][m][n][2] + acc[ai][bj][m][n][3];
        if (s == 123456.789f) sink[0] = s;
    } };
struct PermMap { static constexpr int BHSTEP_ROWS = 128; __host__ __device__ static __forceinline__ int browmap(int R) { return (R & ~31) + perm32(R & 31); } };
struct PlainMap { static constexpr int BHSTEP_ROWS = 128; __host__ __device__ static __forceinline__ int browmap(int R) { return R; } };

struct EpiBranch : PermMap {
    const unsigned char *sa, *sr; bf16_t* mixed;
#define GB(w, i) ((float)(((w) >> (8 * (i))) & 0xffu) + 0.5f)
    __device__ __forceinline__ void mid(f32x4 (&acc)[2][2][4][2], const Unit& u, int wr, int wc, int fr, int fq) const {
        int row0 = u.pm * BM + wr * 64 + fr; asm volatile("" : "+v"(row0));
        const int col0 = u.pn * BM + wc * 32 + 8 * fq;
        u32x2 ga[2][2], gg[2][2];
#define MID_LOAD(buf, grp) do { const unsigned off_ = (unsigned)((row0 + ((grp) >> 2) * HALF + ((grp) & 3) * 16) * DM + col0); \
            _Pragma("unroll") for (int bj = 0; bj < 2; ++bj) { ga[buf][bj] = *(const u32x2*)(sa + off_ + bj * HALF); gg[buf][bj] = *(const u32x2*)(sr + off_ + bj * HALF); } } while (0)
        MID_LOAD(0, 0);
#pragma unroll
        for (int grp = 0; grp < 8; ++grp) { const int ai = grp >> 2, m = grp & 3, cb = grp & 1;
            if (grp + 1 < 8) MID_LOAD(cb ^ 1, grp + 1);
            __builtin_amdgcn_sched_barrier(0);
#pragma unroll
            for (int bj = 0; bj < 2; ++bj) { const u32x2 a = ga[cb][bj], g = gg[cb][bj];
                f32x4& c0 = acc[ai][bj][m][0]; f32x4& c1 = acc[ai][bj][m][1];
                c0[0] *= GB(a.x, 0) * __builtin_amdgcn_rcpf(GB(g.x, 0)); c0[1] *= GB(a.x, 1) * __builtin_amdgcn_rcpf(GB(g.x, 1)); c0[2] *= GB(a.x, 2) * __builtin_amdgcn_rcpf(GB(g.x, 2)); c0[3] *= GB(a.x, 3) * __builtin_amdgcn_rcpf(GB(g.x, 3));
                c1[0] *= GB(a.y, 0) * __builtin_amdgcn_rcpf(GB(g.y, 0)); c1[1] *= GB(a.y, 1) * __builtin_amdgcn_rcpf(GB(g.y, 1)); c1[2] *= GB(a.y, 2) * __builtin_amdgcn_rcpf(GB(g.y, 2)); c1[3] *= GB(a.y, 3) * __builtin_amdgcn_rcpf(GB(g.y, 3)); }
            __builtin_amdgcn_sched_barrier(0); }
#undef MID_LOAD
    }
    __device__ __forceinline__ void operator()(const f32x4 (&acc)[2][2][4][2], const Unit& u, int wr, int wc, int fr, int fq, int wid, int lane) const {
        int row0 = u.pm * BM + wr * 64 + fr; asm volatile("" : "+v"(row0));
        const int col0 = u.pn * BM + wc * 32 + 8 * fq;
        u32x2 g[2][4][2];
#pragma unroll
        for (int ai = 0; ai < 2; ++ai)
#pragma unroll
            for (int m = 0; m < 4; ++m) { const unsigned off = (unsigned)((row0 + ai * HALF + m * 16) * DM + col0);
#pragma unroll
                for (int bj = 0; bj < 2; ++bj) g[ai][m][bj] = *(const u32x2*)(sr + off + bj * HALF); }
        __builtin_amdgcn_sched_barrier(0);
#pragma unroll
        for (int ai = 0; ai < 2; ++ai)
#pragma unroll
            for (int m = 0; m < 4; ++m) { const unsigned off = (unsigned)((row0 + ai * HALF + m * 16) * DM + col0);
#pragma unroll
                for (int bj = 0; bj < 2; ++bj) { const f32x4 a0 = acc[ai][bj][m][0] * GATE_QI, a1 = acc[ai][bj][m][1] * GATE_QI; const u32x2 gw = g[ai][m][bj];
                    u32x4 w; w.x = cvt_pk_bf16(a0[0] * GB(gw.x, 0), a0[1] * GB(gw.x, 1)); w.y = cvt_pk_bf16(a0[2] * GB(gw.x, 2), a0[3] * GB(gw.x, 3));
                    w.z = cvt_pk_bf16(a1[0] * GB(gw.y, 0), a1[1] * GB(gw.y, 1)); w.w = cvt_pk_bf16(a1[2] * GB(gw.y, 2), a1[3] * GB(gw.y, 3));
                    *(u32x4*)(mixed + off + bj * HALF) = w; } }
    }
#undef GB
};
struct EpiOut : PermMap {
    const float* x; bf16_t* h16;
    __device__ __forceinline__ void operator()(const f32x4 (&acc)[2][2][4][2], const Unit& u, int wr, int wc, int fr, int fq, int wid, int lane) const {
        int row0 = u.pm * BM + wr * 64 + fr; asm volatile("" : "+v"(row0));
        const int col0 = u.pn * BM + wc * 32 + 8 * fq;
#pragma unroll
        for (int ai = 0; ai < 2; ++ai) {
            f32x4 xv[4][2][2];
#pragma unroll
            for (int m = 0; m < 4; ++m) { const unsigned off = (unsigned)((row0 + ai * HALF + m * 16) * DM + col0);
#pragma unroll
                for (int bj = 0; bj < 2; ++bj) { xv[m][bj][0] = *(const f32x4*)(x + off + bj * HALF); xv[m][bj][1] = *(const f32x4*)(x + off + bj * HALF + 4); } }
            __builtin_amdgcn_sched_barrier(0);
#pragma unroll
            for (int m = 0; m < 4; ++m) { const unsigned off = (unsigned)((row0 + ai * HALF + m * 16) * DM + col0);
#pragma unroll
                for (int bj = 0; bj < 2; ++bj) { const f32x4 v0 = xv[m][bj][0] + acc[ai][bj][m][0], v1 = xv[m][bj][1] + acc[ai][bj][m][1];
                    u32x4 w; w.x = cvt_pk_bf16(v0[0], v0[1]); w.y = cvt_pk_bf16(v0[2], v0[3]); w.z = cvt_pk_bf16(v1[0], v1[1]); w.w = cvt_pk_bf16(v1[2], v1[3]);
                    *(u32x4*)(h16 + off + bj * HALF) = w; } }
            __builtin_amdgcn_sched_barrier(0);
        }
    }
};
struct EpiMoeUp : PermMap {
    unsigned char* hg; const LAS float* rsl;
    __device__ __forceinline__ void operator()(const f32x4 (&acc)[2][2][4][2], const Unit& u, int wr, int wc, int fr, int fq, int wid, int lane) const {
        int row0 = wr * 64 + fr; asm volatile("" : "+v"(row0));
        const int col0 = u.pn * 128 + wc * 32 + 8 * fq;
        unsigned char* base = hg + (size_t)u.pm * CAP * FFE;
        float scv[2][4];
#pragma unroll
        for (int ai = 0; ai < 2; ++ai)
#pragma unroll
            for (int m = 0; m < 4; ++m) scv[ai][m] = rsl[row0 + ai * HALF + m * 16];
#pragma unroll
        for (int ai = 0; ai < 2; ++ai)
#pragma unroll
            for (int m = 0; m < 4; ++m) { float r[8]; const float sc = scv[ai][m], sc2 = sc * sc, ke = -LOG2E * sc;
#pragma unroll
                for (int n = 0; n < 2; ++n)
#pragma unroll
                    for (int j = 0; j < 4; ++j) { const float ga = acc[ai][0][m][n][j]; r[4 * n + j] = (ga * acc[ai][1][m][n][j]) * (sc2 * __builtin_amdgcn_rcpf(1.0f + __builtin_amdgcn_exp2f(ga * ke))); }
                u32x2 w; w.x = pk4_fp8(r[0], r[1], r[2], r[3]); w.y = pk4_fp8(r[4], r[5], r[6], r[7]);
                *(u32x2*)(base + (unsigned)((row0 + ai * HALF + m * 16) * FFE + col0)) = w; }
    }
};
struct EpiMoeDown : WideMap {
    unsigned char* ye; const LAS float* vall;
    __device__ __forceinline__ void operator()(const f32x4 (&acc)[2][2][4][2], const Unit& u, int wr, int wc, int fr, int fq, int wid, int lane) const {
        int row0 = wr * 64 + fr; asm volatile("" : "+v"(row0));
        const int col0 = u.pn * BM + wc * 64 + 16 * fq;
        unsigned char* base = ye + (size_t)u.pm * CAP * DM;
        float vsv[2][4];
#pragma unroll
        for (int ai = 0; ai < 2; ++ai)
#pragma unroll
            for (int m = 0; m < 4; ++m) vsv[ai][m] = vall[u.aux * CAP + row0 + ai * HALF + m * 16];
#pragma unroll
        for (int ai = 0; ai < 2; ++ai)
#pragma unroll
            for (int m = 0; m < 4; ++m) { const int row = row0 + ai * HALF + m * 16; const float vs = vsv[ai][m];
                const f32x4 v0 = acc[ai][0][m][0] * vs, v1 = acc[ai][0][m][1] * vs, v2 = acc[ai][1][m][0] * vs, v3 = acc[ai][1][m][1] * vs;
                u32x4 w; w.x = pk4_fp8(v0[0], v0[1], v0[2], v0[3]); w.y = pk4_fp8(v1[0], v1[1], v1[2], v1[3]); w.z = pk4_fp8(v2[0], v2[1], v2[2], v2[3]); w.w = pk4_fp8(v3[0], v3[1], v3[2], v3[3]);
                *(u32x4*)(base + (unsigned)(row * DM + col0)) = w; }
    }
};
}

namespace att {
constexpr int KVBLK = 64, LD = DM;
constexpr int SHM_V = KVBLK * 128 * 2, SHM_K = KVBLK * 128 * 2;
constexpr int NBUF = 4, BUFB = SHM_V + SHM_K;
constexpr int TB_OFF = NBUF * BUFB;
constexpr int E_STRIDE = 132, E_BYTES = 128 * E_STRIDE * 4;
constexpr int LI_OFF = 2 * E_BYTES;
#define KSWZ(row, colB) ((row) * 256 + ((colB) ^ (((row) & 7) << 4)))
#define SBAR() __builtin_amdgcn_sched_barrier(0)
__device__ __forceinline__ int crow(int r, int hi) { return (r & 3) + 8 * (r >> 2) + 4 * hi; }
__device__ __forceinline__ int v_st(int k, int c) { const int kk = (k & ~0xC) | ((k & 4) << 1) | ((k & 8) >> 1); return ((kk >> 3) * 4 + (c >> 5)) * 512 + ((kk & 7) * 32 + (c & 31)) * 2; }
__device__ __forceinline__ int v_rd_base(int lane) { return ((lane & 3) << 3) | (((lane >> 2) & 3) << 6) | (((lane >> 4) & 1) << 5) | (((lane >> 5) & 1) << 8); }
constexpr int v_rd_off(int d0, int ks, int half) { return d0 * 512 + ks * 4096 + half * 2048; }
typedef short v4i16_t __attribute__((ext_vector_type(4)));
__device__ __forceinline__ s16x4 vtr(const LAS char* p) { return __builtin_bit_cast(s16x4, __builtin_amdgcn_ds_read_tr16_b64_v4i16((LAS v4i16_t*)p)); }
template <int OFF> __device__ __forceinline__ s16x4 tr_read(int vb) {
    s16x4 r; asm volatile("ds_read_b64_tr_b16 %0, %1 offset:%2" : "=&v"(r) : "v"(vb), "i"(OFF) : "memory"); return r;
}
template <int OFF> __device__ __forceinline__ bf16x8 lds_read128(int a) {
    bf16x8 r; asm volatile("ds_read_b128 %0, %1 offset:%2" : "=&v"(r) : "v"(a), "i"(OFF) : "memory"); return r;
}
template <int D0> __device__ __forceinline__ void pv_one(f32x16& od, int vb, bf16x8 pa0, bf16x8 pa1, bf16x8 pa2, bf16x8 pa3) {
    const s16x4 l0 = tr_read<v_rd_off(D0, 0, 0)>(vb), h0 = tr_read<v_rd_off(D0, 0, 1)>(vb), l1 = tr_read<v_rd_off(D0, 1, 0)>(vb), h1 = tr_read<v_rd_off(D0, 1, 1)>(vb);
    const s16x4 l2 = tr_read<v_rd_off(D0, 2, 0)>(vb), h2 = tr_read<v_rd_off(D0, 2, 1)>(vb), l3 = tr_read<v_rd_off(D0, 3, 0)>(vb), h3 = tr_read<v_rd_off(D0, 3, 1)>(vb);
    asm volatile("s_waitcnt lgkmcnt(0)" ::: "memory"); SBAR();
#define PK(L, H) (bf16x8){L[0], L[1], L[2], L[3], H[0], H[1], H[2], H[3]}
    od = __builtin_amdgcn_mfma_f32_32x32x16_bf16(pa0, PK(l0, h0), od, 0, 0, 0);
    od = __builtin_amdgcn_mfma_f32_32x32x16_bf16(pa1, PK(l1, h1), od, 0, 0, 0);
    od = __builtin_amdgcn_mfma_f32_32x32x16_bf16(pa2, PK(l2, h2), od, 0, 0, 0);
    od = __builtin_amdgcn_mfma_f32_32x32x16_bf16(pa3, PK(l3, h3), od, 0, 0, 0);
#undef PK
}
__device__ __forceinline__ void pv_d0(f32x16* o, int vb, bf16x8 pa0, bf16x8 pa1, bf16x8 pa2, bf16x8 pa3) {
    pv_one<0>(o[0], vb, pa0, pa1, pa2, pa3); pv_one<1>(o[1], vb, pa0, pa1, pa2, pa3); pv_one<2>(o[2], vb, pa0, pa1, pa2, pa3); pv_one<3>(o[3], vb, pa0, pa1, pa2, pa3);
}
template <int VAR = 0> __device__ __forceinline__ void qkt(f32x16& p0, f32x16& p1, const char* Ks, const bf16x8* qr, int r32, int hi, int mm, const float* Tb, int drel, const f32x16& cvec) {
    if constexpr (VAR == 3) { p0 = cvec; p1 = cvec; return; }
    const bool far = (drel >= 122 || drel <= -154);
    if (!far) {
        const float* tb = Tb + (drel + 256 - r32 + 4 * hi);
#pragma unroll
        for (int r = 0; r < 16; ++r) { const int o = (r & 3) + 8 * (r >> 2); p0[r] = tb[o]; p1[r] = tb[o + 32]; }
    }
    { const int cb = (mm * 64 + hi * 8) * 2;
      const bf16x8 b0 = *reinterpret_cast<const bf16x8*>(Ks + KSWZ(r32, cb));
      const bf16x8 b1 = *reinterpret_cast<const bf16x8*>(Ks + KSWZ(32 + r32, cb));
      if (far) { p0 = __builtin_amdgcn_mfma_f32_32x32x16_bf16(b0, qr[0], cvec, 0, 0, 0); p1 = __builtin_amdgcn_mfma_f32_32x32x16_bf16(b1, qr[0], cvec, 0, 0, 0); }
      else     { p0 = __builtin_amdgcn_mfma_f32_32x32x16_bf16(b0, qr[0], p0, 0, 0, 0);   p1 = __builtin_amdgcn_mfma_f32_32x32x16_bf16(b1, qr[0], p1, 0, 0, 0); } }
#pragma unroll
    for (int d0 = 1; d0 < 4; ++d0) { const int cb = (mm * 64 + d0 * 16 + hi * 8) * 2;
        const bf16x8 b0 = *reinterpret_cast<const bf16x8*>(Ks + KSWZ(r32, cb));
        const bf16x8 b1 = *reinterpret_cast<const bf16x8*>(Ks + KSWZ(32 + r32, cb));
        p0 = __builtin_amdgcn_mfma_f32_32x32x16_bf16(b0, qr[d0], p0, 0, 0, 0);
        p1 = __builtin_amdgcn_mfma_f32_32x32x16_bf16(b1, qr[d0], p1, 0, 0, 0); }
}
template <class F> __device__ __forceinline__ void qkt2(f32x16& p0, f32x16& p1, const char* Ks, const bf16x8* qr, int r32, int hi, int mm, const float* Tb, int drel, const f32x16& cvec, F&& gap) {
    const bool far = (drel >= 122 || drel <= -154);
    bf16x8 kf[8];
#pragma unroll
    for (int d0 = 0; d0 < 4; ++d0) { const int cb = (mm * 64 + d0 * 16 + hi * 8) * 2;
        kf[2 * d0] = *reinterpret_cast<const bf16x8*>(Ks + KSWZ(r32, cb)); kf[2 * d0 + 1] = *reinterpret_cast<const bf16x8*>(Ks + KSWZ(32 + r32, cb)); }
    SBAR();
    if (!far) {
        const float* tb = Tb + (drel + 256 - r32 + 4 * hi);
#pragma unroll
        for (int r = 0; r < 16; ++r) { const int o = (r & 3) + 8 * (r >> 2); p0[r] = tb[o]; p1[r] = tb[o + 32]; }
        p0 = __builtin_amdgcn_mfma_f32_32x32x16_bf16(kf[0], qr[0], p0, 0, 0, 0); p1 = __builtin_amdgcn_mfma_f32_32x32x16_bf16(kf[1], qr[0], p1, 0, 0, 0);
    } else { p0 = __builtin_amdgcn_mfma_f32_32x32x16_bf16(kf[0], qr[0], cvec, 0, 0, 0); p1 = __builtin_amdgcn_mfma_f32_32x32x16_bf16(kf[1], qr[0], cvec, 0, 0, 0); }
    gap(0); gap(1); SBAR();
#pragma unroll
    for (int d0 = 1; d0 < 4; ++d0) {
        p0 = __builtin_amdgcn_mfma_f32_32x32x16_bf16(kf[2 * d0], qr[d0], p0, 0, 0, 0); gap(2 * d0); SBAR();
        p1 = __builtin_amdgcn_mfma_f32_32x32x16_bf16(kf[2 * d0 + 1], qr[d0], p1, 0, 0, 0); gap(2 * d0 + 1); SBAR(); }
}
__device__ __forceinline__ void partialSM(f32x16& p0) {
#pragma unroll
    for (int r = 0; r < 16; ++r) p0[r] = __builtin_amdgcn_exp2f(p0[r]);
}
__device__ __forceinline__ void finishSM(f32x16& p0, f32x16& p1, float& l_reg, bf16x8& pa0, bf16x8& pa1, bf16x8& pa2, bf16x8& pa3) {
#pragma unroll
    for (int r = 0; r < 16; ++r) p1[r] = __builtin_amdgcn_exp2f(p1[r]);
    float ps = 0;
#pragma unroll
    for (int r = 0; r < 16; ++r) ps += p0[r];
#pragma unroll
    for (int r = 0; r < 16; ++r) ps += p1[r];
    { auto rr = __builtin_amdgcn_permlane32_swap(__float_as_uint(ps), __float_as_uint(ps), false, false);
      ps = __uint_as_float(rr[0]) + __uint_as_float(rr[1]); }
    l_reg += ps;
#define PK4(P, BASE, OUT) do { unsigned a0 = cvt_pk_bf16(P[BASE + 0], P[BASE + 1]), a1 = cvt_pk_bf16(P[BASE + 2], P[BASE + 3]);   \
    unsigned b0 = cvt_pk_bf16(P[BASE + 4], P[BASE + 5]), b1 = cvt_pk_bf16(P[BASE + 6], P[BASE + 7]);                              \
    auto r0 = __builtin_amdgcn_permlane32_swap(a0, b0, false, false); auto r1 = __builtin_amdgcn_permlane32_swap(a1, b1, false, false); \
    u32x4 w = {r0[0], r1[0], r0[1], r1[1]}; OUT = *reinterpret_cast<bf16x8*>(&w); } while (0)
    PK4(p0, 0, pa0); PK4(p0, 8, pa1); PK4(p1, 0, pa2); PK4(p1, 8, pa3);
#undef PK4
}

constexpr int E2_OFF = 2 * BUFB, E2_STRIDE = 136, E2_BYTES = 128 * E2_STRIDE * 2;
constexpr int LI2_OFF = E2_OFF + 2 * E2_BYTES, TB2_OFF = LI2_OFF + 2048, GS_OFF = TB2_OFF + 2048;
template <int NTL, int VAR = 0> __device__ __forceinline__ void attn_phase(int vcu, int G, const bf16_t* __restrict__ Qb, const bf16_t* __restrict__ Kb, const bf16_t* __restrict__ Vb, bf16_t* __restrict__ Ob,
                                          const float* __restrict__ TbG, const float* __restrict__ gsub, float lam, char* lds, const int wid) {
    const int lane = lane_id(), tid = wid * 64 + lane, r32 = lane & 31, hi = lane >> 5, rg = wid & 3, mm = wid >> 2;
    constexpr int NUNITS = BATCH * NH * 16;
    if (vcu >= NUNITS) return;
    char* V_lds = lds; char* K_lds = lds + SHM_V; float* Tb = (float*)(lds + TB2_OFF); float* GS = (float*)(lds + GS_OFF);
    unsigned offK[2], offV[2];
#pragma unroll
    for (int i = 0; i < 2; ++i) { const int pc = 2 * wid + i;
        { const int row = pc * 4 + (lane >> 4), c = (lane & 15) ^ (row & 7); offK[i] = (unsigned)(row * LD + c * 8) * 2u; }
        { const int sub = pc * 2 + (lane >> 5), kk = (sub >> 2) * 8 + ((lane & 31) >> 2), k = (kk & ~0xC) | ((kk & 4) << 1) | ((kk & 8) >> 1), col = (sub & 3) * 32 + (lane & 3) * 8; offV[i] = (unsigned)(k * LD + col) * 2u; } }
    LAS unsigned char* ldsl_ = (LAS unsigned char*)(unsigned char*)lds;
    const int vb0 = (int)(uintptr_t)V_lds + v_rd_base(lane);
    const LAS char* vbase = (const LAS char*)(LAS unsigned char*)(unsigned char*)V_lds + v_rd_base(lane);
#define DMA(Kh_, Vh_, t, boff) do { if constexpr (VAR == 5) break; const char* kt_ = (Kh_) + (size_t)(t) * (KVBLK * LD * 2); const char* vt_ = (Vh_) + (size_t)(t) * (KVBLK * LD * 2); \
        _Pragma("unroll") for (int i_ = 0; i_ < 2; ++i_) { \
            __builtin_amdgcn_global_load_lds((const unsigned*)(vt_ + offV[i_]), (LAS unsigned*)(ldsl_ + (boff) + (2 * wid + i_) * 1024), 16, 0, 0); \
            __builtin_amdgcn_global_load_lds((const unsigned*)(kt_ + offK[i_]), (LAS unsigned*)(ldsl_ + (boff) + SHM_V + (2 * wid + i_) * 1024), 16, 0, 0); } } while (0)
#define WBAR(N) do { asm volatile("s_waitcnt vmcnt(" #N ") lgkmcnt(0)" ::: "memory"); if constexpr (VAR != 7) __builtin_amdgcn_s_barrier(); asm volatile("" ::: "memory"); } while (0)
#define VRDSET(V, D0, boff) do { if constexpr (VAR == 4) break; _Pragma("unroll") for (int ks_ = 0; ks_ < 4; ++ks_) { V[2 * ks_] = vtr(vbase + (boff) + v_rd_off(D0, ks_, 0)); V[2 * ks_ + 1] = vtr(vbase + (boff) + v_rd_off(D0, ks_, 1)); } } while (0)
#define VFRAG(V, ks) (bf16x8){V[2 * (ks)][0], V[2 * (ks)][1], V[2 * (ks)][2], V[2 * (ks)][3], V[2 * (ks) + 1][0], V[2 * (ks) + 1][1], V[2 * (ks) + 1][2], V[2 * (ks) + 1][3]}
#define PIECE(P, B, q) do { if constexpr (VAR != 1) { P[(B) + 2 * (q)] = __builtin_amdgcn_exp2f(P[(B) + 2 * (q)]); P[(B) + 2 * (q) + 1] = __builtin_amdgcn_exp2f(P[(B) + 2 * (q) + 1]); } \
        ps += P[(B) + 2 * (q)]; ps += P[(B) + 2 * (q) + 1]; cq[q] = cvt_pk_bf16(P[(B) + 2 * (q)], P[(B) + 2 * (q) + 1]); } while (0)
#define PFIN(OUT) do { auto r0_ = __builtin_amdgcn_permlane32_swap(cq[0], cq[2], false, false); auto r1_ = __builtin_amdgcn_permlane32_swap(cq[1], cq[3], false, false); \
        u32x4 w_ = {r0_[0], r1_[0], r0_[1], r1_[1]}; OUT = *reinterpret_cast<bf16x8*>(&w_); } while (0)
#define PVBLOCK(D0, VC, VN, P, B, OUT, boff) do { \
        if ((D0) < 3) VRDSET(VN, (D0) + 1, boff); \
        if constexpr (VAR != 2) o[D0] = __builtin_amdgcn_mfma_f32_32x32x16_bf16(pa0, VFRAG(VC, 0), o[D0], 0, 0, 0); PIECE(P, B, 0); SBAR(); \
        if constexpr (VAR != 2) o[D0] = __builtin_amdgcn_mfma_f32_32x32x16_bf16(pa1, VFRAG(VC, 1), o[D0], 0, 0, 0); PIECE(P, B, 1); SBAR(); \
        if constexpr (VAR != 2) o[D0] = __builtin_amdgcn_mfma_f32_32x32x16_bf16(pa2, VFRAG(VC, 2), o[D0], 0, 0, 0); PIECE(P, B, 2); SBAR(); \
        if constexpr (VAR != 2) o[D0] = __builtin_amdgcn_mfma_f32_32x32x16_bf16(pa3, VFRAG(VC, 3), o[D0], 0, 0, 0); PIECE(P, B, 3); PFIN(OUT); SBAR(); } while (0)
#define LSUM() do { auto rr_ = __builtin_amdgcn_permlane32_swap(__float_as_uint(ps), __float_as_uint(ps), false, false); l_reg += __uint_as_float(rr_[0]) + __uint_as_float(rr_[1]); ps = 0.f; } while (0)
#define UNIT_PTRS(u_, b_, h_, q0_, Kh_, Vh_, Qw_) const int b_ = (u_) >> 7, h_ = ((u_) >> 4) & 7, q0_ = ((u_) & 15) * 128; \
        const char* Kh_ = (const char*)(Kb + (size_t)(b_ * SEQ) * LD + h_ * 128); const char* Vh_ = (const char*)(Vb + (size_t)(b_ * SEQ) * LD + h_ * 128); \
        const bf16_t* Qw_ = Qb + (size_t)(b_ * SEQ + q0_ + rg * 32 + r32) * LD + h_ * 128 + mm * 64 + hi * 8
    constexpr int NT = NTL;
    bf16x8 qr[4]; int htab = -1;
    { UNIT_PTRS(vcu, b0_, h0_, q00_, Kh0_, Vh0_, Qw0_);
      DMA(Kh0_, Vh0_, 0, 0); if (NT > 1) DMA(Kh0_, Vh0_, 1, BUFB);
#pragma unroll
      for (int d0 = 0; d0 < 4; ++d0) qr[d0] = *reinterpret_cast<const bf16x8*>(Qw0_ + d0 * 16);
      if (tid < 128) GS[tid] = gsub[tid]; }
    for (int u = vcu; u < NUNITS; u += G) {
        UNIT_PTRS(u, b, h, q0, Kh, Vh, Qw); (void)Qw;
        const int q0w = q0 + rg * 32;
        if (h != htab) { const int t2 = wid * 64 + lane_id(); Tb[t2] = TbG[h * 512 + t2]; htab = h; }
        const float Tl = TbG[h * 512 + 0];
        f32x16 o[4] = {}; float l_reg = 0.f, ps = 0.f;
        f32x16 pC0, pC1; bf16x8 pa0, pa1, pa2, pa3, pn0, pn1, pn2, pn3;
        s16x4 VA[8], VB[8]; unsigned cq[4];
        if constexpr (VAR == 4) {
#pragma unroll
            for (int i = 0; i < 8; ++i) { VA[i] = s16x4{}; VB[i] = s16x4{}; } }
        f32x16 cvec;
#pragma unroll
        for (int r = 0; r < 16; ++r) cvec[r] = Tl;
        WBAR(0);
        if (NT > 2) DMA(Kh, Vh, 2, 2 * BUFB);
        { const int l5 = lane_id(); qkt<VAR>(pC0, pC1, K_lds, qr, l5 & 31, l5 >> 5, mm, Tb, 0 - q0w, cvec); }
        PIECE(pC0, 0, 0); PIECE(pC0, 0, 1); PIECE(pC0, 0, 2); PIECE(pC0, 0, 3); PFIN(pa0);
        PIECE(pC0, 8, 0); PIECE(pC0, 8, 1); PIECE(pC0, 8, 2); PIECE(pC0, 8, 3); PFIN(pa1);
        PIECE(pC1, 0, 0); PIECE(pC1, 0, 1); PIECE(pC1, 0, 2); PIECE(pC1, 0, 3); PFIN(pa2);
        PIECE(pC1, 8, 0); PIECE(pC1, 8, 1); PIECE(pC1, 8, 2); PIECE(pC1, 8, 3); PFIN(pa3);
        LSUM();
        if (NT > 2) WBAR(4); else WBAR(0);
        for (int j = 1; j < NT; ++j) {
            const int bp = ((j - 1) & 3) * BUFB, bc = (j & 3) * BUFB;
            if (j + 2 < NT) DMA(Kh, Vh, j + 2, ((j + 2) & 3) * BUFB);
            if constexpr (VAR == 6) { if (j + 2 < NT) WBAR(4); else WBAR(0); continue; }
            SBAR(); VRDSET(VA, 0, bp);
            { const int drel = j * KVBLK - q0w; if (drel >= 122 && drel < 122 + KVBLK) {
                const float Tr = Tb[511];
#pragma unroll
                for (int r = 0; r < 16; ++r) cvec[r] = Tr; } }
            qkt<VAR>(pC0, pC1, K_lds + bc, qr, r32, hi, mm, Tb, j * KVBLK - q0w, cvec); SBAR();
            PVBLOCK(0, VA, VB, pC0, 0, pn0, bp);
            PVBLOCK(1, VB, VA, pC0, 8, pn1, bp);
            PVBLOCK(2, VA, VB, pC1, 0, pn2, bp);
            PVBLOCK(3, VB, VA, pC1, 8, pn3, bp);
            LSUM();
            pa0 = pn0; pa1 = pn1; pa2 = pn2; pa3 = pn3;
            if (j + 2 < NT) WBAR(4); else WBAR(0);
        }
        pv_d0(o, vb0 + ((NT - 1) & 3) * BUFB, pa0, pa1, pa2, pa3);
        float* li_l = (float*)(lds + LI2_OFF) + wid * 64;
        { const int l3 = lane_id(); if (l3 < 32) li_l[l3] = l_reg; }
        WBAR(0);
        const int un = u + G;
        if (un < NUNITS) {
            const int bn_ = un >> 7, hn_ = (un >> 4) & 7, q0n_ = (un & 15) * 128; const int l4 = lane_id();
            const char* Khn_ = (const char*)(Kb + (size_t)(bn_ * SEQ) * LD + hn_ * 128); const char* Vhn_ = (const char*)(Vb + (size_t)(bn_ * SEQ) * LD + hn_ * 128);
            const bf16_t* Qwn_ = Qb + (size_t)(bn_ * SEQ + q0n_ + rg * 32 + (l4 & 31)) * LD + hn_ * 128 + mm * 64 + (l4 >> 5) * 8;
            DMA(Khn_, Vhn_, 0, 0); if (NT > 1) DMA(Khn_, Vhn_, 1, BUFB);
#pragma unroll
            for (int d0 = 0; d0 < 4; ++d0) qr[d0] = *reinterpret_cast<const bf16x8*>(Qwn_ + d0 * 16);
        }
        const float fsc = mm ? lam : 1.0f;
        bf16_t* Em = (bf16_t*)(lds + E2_OFF + mm * E2_BYTES);
#pragma unroll
        for (int r = 0; r < 16; ++r) { const int orow = crow(r, hi); const float f = fsc * __builtin_amdgcn_rcpf(li_l[orow]);
#pragma unroll
            for (int d0 = 0; d0 < 4; ++d0) Em[(rg * 32 + orow) * E2_STRIDE + d0 * 32 + r32] = f2bf(o[d0][r] * f); }
        asm volatile("s_waitcnt lgkmcnt(0)" ::: "memory"); if constexpr (VAR != 7) __builtin_amdgcn_s_barrier(); asm volatile("" ::: "memory");
        {
            const int row = tid >> 2, qt = tid & 3;
            const bf16_t* e0 = (const bf16_t*)(lds + E2_OFF) + row * E2_STRIDE + qt * 32; const bf16_t* e1 = e0 + E2_BYTES / 2;
            float d[32]; float ss = 0.f;
#pragma unroll
            for (int c = 0; c < 4; ++c) { const u32x4 a = *(const u32x4*)(e0 + 8 * c), bq = *(const u32x4*)(e1 + 8 * c);
                d[8 * c + 0] = bf_lo(a.x) - bf_lo(bq.x); d[8 * c + 1] = bf_hi(a.x) - bf_hi(bq.x); d[8 * c + 2] = bf_lo(a.y) - bf_lo(bq.y); d[8 * c + 3] = bf_hi(a.y) - bf_hi(bq.y);
                d[8 * c + 4] = bf_lo(a.z) - bf_lo(bq.z); d[8 * c + 5] = bf_hi(a.z) - bf_hi(bq.z); d[8 * c + 6] = bf_lo(a.w) - bf_lo(bq.w); d[8 * c + 7] = bf_hi(a.w) - bf_hi(bq.w); }
#pragma unroll
            for (int c = 0; c < 32; ++c) ss += d[c] * d[c];
            ss += __shfl_xor(ss, 1); ss += __shfl_xor(ss, 2);
            const float rs = __builtin_amdgcn_rsqf(ss * (1.0f / 128.0f) + EPS) * 0.8f;
            bf16_t* op = Ob + (size_t)(b * SEQ + q0 + row) * LD + h * 128 + qt * 32;
            const float* gq = GS + qt * 32;
#pragma unroll
            for (int c = 0; c < 4; ++c) {
                u32x4 w; w.x = cvt_pk_bf16(d[8 * c + 0] * rs * gq[8 * c + 0], d[8 * c + 1] * rs * gq[8 * c + 1]); w.y = cvt_pk_bf16(d[8 * c + 2] * rs * gq[8 * c + 2], d[8 * c + 3] * rs * gq[8 * c + 3]);
                w.z = cvt_pk_bf16(d[8 * c + 4] * rs * gq[8 * c + 4], d[8 * c + 5] * rs * gq[8 * c + 5]); w.w = cvt_pk_bf16(d[8 * c + 6] * rs * gq[8 * c + 6], d[8 * c + 7] * rs * gq[8 * c + 7]);
                *(u32x4*)(op + 8 * c) = w; }
        }
    }
    asm volatile("s_waitcnt vmcnt(0) lgkmcnt(0)" ::: "memory"); __builtin_amdgcn_s_barrier(); asm volatile("" ::: "memory");
#undef UNIT_PTRS
#undef VRDSET
#undef VFRAG
#undef PIECE
#undef PFIN
#undef PVBLOCK
#undef LSUM
#undef DMA
#undef WBAR
}
constexpr int BUF2 = 65536;
template <int VAR = 0> __device__ __forceinline__ void attn_phase2(int vcu, int G, const bf16_t* __restrict__ Qb, const bf16_t* __restrict__ Kb, const bf16_t* __restrict__ Vb, bf16_t* __restrict__ Ob,
                                          const float* __restrict__ TbG, const float* __restrict__ gsub, float lam, char* lds, const int wid) {
    const int lane = lane_id(), tid = wid * 64 + lane, r32 = lane & 31, hi = lane >> 5, rg = wid & 3, mm = wid >> 2;
    constexpr int NUNITS = BATCH * NH * 16, NT2 = SEQ / 128;
    if (vcu >= NUNITS) return;
    float* Tb = (float*)(lds + TB2_OFF); float* GS = (float*)(lds + GS_OFF);
    unsigned offK[2], offV[2];
#pragma unroll
    for (int i = 0; i < 2; ++i) { const int pc = 2 * wid + i;
        { const int row = pc * 4 + (lane >> 4), c = (lane & 15) ^ (row & 7); offK[i] = (unsigned)(row * LD + c * 8) * 2u; }
        { const int sub = pc * 2 + (lane >> 5), kk = (sub >> 2) * 8 + ((lane & 31) >> 2), k = (kk & ~0xC) | ((kk & 4) << 1) | ((kk & 8) >> 1), col = (sub & 3) * 32 + (lane & 3) * 8; offV[i] = (unsigned)(k * LD + col) * 2u; } }
    LAS unsigned char* ldsl_ = (LAS unsigned char*)(unsigned char*)lds;
    const LAS char* vbase = (const LAS char*)(LAS unsigned char*)(unsigned char*)lds + v_rd_base(lane);
    const int vbi0 = (int)(unsigned)(unsigned long long)vbase, ldsi0 = (int)(unsigned)(unsigned long long)ldsl_;
#define DMA2(Kh_, Vh_, t, boff) do { _Pragma("unroll") for (int s_ = 0; s_ < 2; ++s_) { const char* kt_ = (Kh_) + (size_t)(2 * (t) + s_) * (KVBLK * LD * 2); const char* vt_ = (Vh_) + (size_t)(2 * (t) + s_) * (KVBLK * LD * 2); \
        _Pragma("unroll") for (int i_ = 0; i_ < 2; ++i_) { \
            __builtin_amdgcn_global_load_lds((const unsigned*)(vt_ + offV[i_]), (LAS unsigned*)(ldsl_ + (boff) + s_ * SHM_V + (2 * wid + i_) * 1024), 16, 0, 0); \
            __builtin_amdgcn_global_load_lds((const unsigned*)(kt_ + offK[i_]), (LAS unsigned*)(ldsl_ + (boff) + 2 * SHM_V + s_ * SHM_K + (2 * wid + i_) * 1024), 16, 0, 0); } } } while (0)
#define DMAP(Kh_, Vh_, t, boff, p) do { const int s_ = (p) >> 2, i_ = ((p) >> 1) & 1; \
        if ((p) & 1) { const char* kt_ = (Kh_) + (size_t)(2 * (t) + s_) * (KVBLK * LD * 2); __builtin_amdgcn_global_load_lds((const unsigned*)(kt_ + offK[i_]), (LAS unsigned*)(ldsl_ + (boff) + 2 * SHM_V + s_ * SHM_K + (2 * wid + i_) * 1024), 16, 0, 0); } \
        else { const char* vt_ = (Vh_) + (size_t)(2 * (t) + s_) * (KVBLK * LD * 2); __builtin_amdgcn_global_load_lds((const unsigned*)(vt_ + offV[i_]), (LAS unsigned*)(ldsl_ + (boff) + s_ * SHM_V + (2 * wid + i_) * 1024), 16, 0, 0); } } while (0)
#define WBAR0() do { asm volatile("s_waitcnt vmcnt(0) lgkmcnt(0)" ::: "memory"); __builtin_amdgcn_s_barrier(); asm volatile("" ::: "memory"); } while (0)
#define VREQ(f) do { if ((f) < 32) { FL[(f) & 3] = tr_read<((f) >> 4) * SHM_V + v_rd_off((f) & 3, ((f) >> 2) & 3, 0)>(vbi); FH[(f) & 3] = tr_read<((f) >> 4) * SHM_V + v_rd_off((f) & 3, ((f) >> 2) & 3, 1)>(vbi); } } while (0)
#define VWAIT(f) asm volatile("s_waitcnt lgkmcnt(%2)" : "+v"(FL[(f) & 3]), "+v"(FH[(f) & 3]) : "n"((f) <= 28 ? 6 : 2 * (31 - (f))))
#define VFRG(f) (bf16x8){FL[(f) & 3][0], FL[(f) & 3][1], FL[(f) & 3][2], FL[(f) & 3][3], FH[(f) & 3][0], FH[(f) & 3][1], FH[(f) & 3][2], FH[(f) & 3][3]}
#define PVM(f, X) do { VREQ((f) + 3); VWAIT(f); o[(f) & 3] = __builtin_amdgcn_mfma_f32_32x32x16_bf16(((f) < 16 ? paA : paB)[((f) >> 2) & 3], VFRG(f), o[(f) & 3], 0, 0, 0); X; SBAR(); } while (0)
#define PIECE(P, B, q) do { P[(B) + 2 * (q)] = __builtin_amdgcn_exp2f(P[(B) + 2 * (q)]); P[(B) + 2 * (q) + 1] = __builtin_amdgcn_exp2f(P[(B) + 2 * (q) + 1]); \
        ps += P[(B) + 2 * (q)]; ps += P[(B) + 2 * (q) + 1]; cq[q] = cvt_pk_bf16(P[(B) + 2 * (q)], P[(B) + 2 * (q) + 1]); } while (0)
#define PFIN(OUT) do { auto r0_ = __builtin_amdgcn_permlane32_swap(cq[0], cq[2], false, false); auto r1_ = __builtin_amdgcn_permlane32_swap(cq[1], cq[3], false, false); \
        u32x4 w_ = {r0_[0], r1_[0], r0_[1], r1_[1]}; OUT = *reinterpret_cast<bf16x8*>(&w_); } while (0)
#define PC(P0, P1, PA, i) do { if ((i) < 8) PIECE(P0, ((i) >> 2) * 8, (i) & 3); else PIECE(P1, (((i) >> 2) & 1) * 8, (i) & 3); if (((i) & 3) == 3) PFIN(PA[(i) >> 2]); } while (0)
#define LSUM() do { auto rr_ = __builtin_amdgcn_permlane32_swap(__float_as_uint(ps), __float_as_uint(ps), false, false); l_reg += __uint_as_float(rr_[0]) + __uint_as_float(rr_[1]); ps = 0.f; } while (0)
#define UNIT_PTRS(u_, b_, h_, q0_, Kh_, Vh_, Qw_) const int b_ = (u_) >> 7, h_ = ((u_) >> 4) & 7, q0_ = ((u_) & 15) * 128; \
        const char* Kh_ = (const char*)(Kb + (size_t)(b_ * SEQ) * LD + h_ * 128); const char* Vh_ = (const char*)(Vb + (size_t)(b_ * SEQ) * LD + h_ * 128); \
        const bf16_t* Qw_ = Qb + (size_t)(b_ * SEQ + q0_ + rg * 32 + r32) * LD + h_ * 128 + mm * 64 + hi * 8
    bf16x8 qr[4]; int htab = -1;
    { UNIT_PTRS(vcu, b0_, h0_, q00_, Kh0_, Vh0_, Qw0_);
      DMA2(Kh0_, Vh0_, 0, 0);
#pragma unroll
      for (int d0 = 0; d0 < 4; ++d0) qr[d0] = *reinterpret_cast<const bf16x8*>(Qw0_ + d0 * 16);
      if (tid < 128) GS[tid] = gsub[tid]; }
    for (int u = vcu; u < NUNITS; u += G) {
        UNIT_PTRS(u, b, h, q0, Kh, Vh, Qw); (void)Qw;
        const int q0w = q0 + rg * 32;
        if (h != htab) { const int t2 = wid * 64 + lane_id(); Tb[t2] = TbG[h * 512 + t2]; htab = h; }
        const float Tl = TbG[h * 512 + 0];
        f32x16 o[4] = {}; float l_reg = 0.f, ps = 0.f;
        f32x16 pA0, pA1, pB0, pB1; bf16x8 paA[4], paB[4];
        s16x4 FL[4], FH[4]; unsigned cq[4];
        float tfar = Tl;
        WBAR0();
        for (int j = 0; j < NT2; ++j) {
            const int base = (j & 1) * BUF2; const int vbi = vbi0 + base;
            const bool dnext = (j + 1 < NT2); const int nboff = ((j + 1) & 1) * BUF2;
            SBAR();
            const int drela = j * 128 - q0w, drelb = drela + 64;
            if (drela >= 122 && drela < 122 + KVBLK) tfar = Tb[511];
            { const int l5 = lane_id(); f32x16 cv;
#pragma unroll
              for (int r = 0; r < 16; ++r) cv[r] = tfar;
              qkt2(pA0, pA1, lds + base + 2 * SHM_V, qr, l5 & 31, l5 >> 5, mm, Tb, drela, cv, [&](int p) { if (dnext) DMAP(Kh, Vh, j + 1, nboff, p); }); } SBAR();
            if (drelb >= 122 && drelb < 122 + KVBLK) tfar = Tb[511];
            VREQ(0); VREQ(1); VREQ(2);
            {
                const bool farb = (drelb >= 122 || drelb <= -154);
#define KREQ(i) do { if ((i) < 8) kw[(i) & 3] = lds_read128<2 * SHM_V + SHM_K + 8192 * ((i) & 1)>(kab + (((((i) >> 1) << 5) | (hi << 4)) ^ kxs)); } while (0)
#define KWAIT(i) asm volatile("s_waitcnt lgkmcnt(%1)" : "+v"(kw[(i) & 3]) : "n"((i) <= 4 ? 3 : 7 - (i)))
#define QKB(i, ACC) do { KREQ((i) + 3); KWAIT(i); ACC = __builtin_amdgcn_mfma_f32_32x32x16_bf16(kw[(i) & 3], qr[(i) >> 1], ACC, 0, 0, 0); PC(pA0, pA1, paA, i); SBAR(); } while (0)
                const int kxs = (r32 & 7) << 4, kab = ldsi0 + base + r32 * 256 + mm * 128;
                bf16x8 kw[4];
                KREQ(0); KREQ(1); KREQ(2); SBAR();
                if (!farb) { const float* tb = Tb + (drelb + 256 - r32 + 4 * hi);
#pragma unroll
                    for (int r = 0; r < 16; ++r) { const int oo = (r & 3) + 8 * (r >> 2); pB0[r] = tb[oo]; pB1[r] = tb[oo + 32]; } }
                else {
#pragma unroll
                    for (int r = 0; r < 16; ++r) { pB0[r] = tfar; pB1[r] = tfar; } }
                QKB(0, pB0); QKB(1, pB1); QKB(2, pB0); QKB(3, pB1); QKB(4, pB0); QKB(5, pB1); QKB(6, pB0); QKB(7, pB1);
#undef QKB
#undef KWAIT
#undef KREQ
            }
            PVM(0, PC(pA0, pA1, paA, 8)); PVM(1, PC(pA0, pA1, paA, 9)); PVM(2, PC(pA0, pA1, paA, 10)); PVM(3, PC(pA0, pA1, paA, 11));
            PVM(4, PC(pA0, pA1, paA, 12)); PVM(5, PC(pA0, pA1, paA, 13)); PVM(6, PC(pA0, pA1, paA, 14)); PVM(7, PC(pA0, pA1, paA, 15));
            PVM(8, PC(pB0, pB1, paB, 0)); PVM(9, PC(pB0, pB1, paB, 1)); PVM(10, PC(pB0, pB1, paB, 2)); PVM(11, PC(pB0, pB1, paB, 3));
            PVM(12, PC(pB0, pB1, paB, 4)); PVM(13, PC(pB0, pB1, paB, 5)); PVM(14, PC(pB0, pB1, paB, 6)); PVM(15, PC(pB0, pB1, paB, 7));
            PVM(16, PC(pB0, pB1, paB, 8)); PVM(17, PC(pB0, pB1, paB, 9)); PVM(18, PC(pB0, pB1, paB, 10)); PVM(19, PC(pB0, pB1, paB, 11));
            PVM(20, PC(pB0, pB1, paB, 12)); PVM(21, PC(pB0, pB1, paB, 13)); PVM(22, PC(pB0, pB1, paB, 14)); PVM(23, PC(pB0, pB1, paB, 15));
            PVM(24, (void)0); PVM(25, (void)0); PVM(26, (void)0); PVM(27, (void)0); PVM(28, (void)0); PVM(29, (void)0); PVM(30, (void)0); PVM(31, (void)0);
            LSUM();
            WBAR0();
        }
        float* li_l = (float*)(lds + LI2_OFF) + wid * 64;
        { const int l3 = lane_id(); if (l3 < 32) li_l[l3] = l_reg; }
        const int un = u + G;
        if (un < NUNITS) {
            const int bn_ = un >> 7, hn_ = (un >> 4) & 7, q0n_ = (un & 15) * 128; const int l4 = lane_id();
            const char* Khn_ = (const char*)(Kb + (size_t)(bn_ * SEQ) * LD + hn_ * 128); const char* Vhn_ = (const char*)(Vb + (size_t)(bn_ * SEQ) * LD + hn_ * 128);
            const bf16_t* Qwn_ = Qb + (size_t)(bn_ * SEQ + q0n_ + rg * 32 + (l4 & 31)) * LD + hn_ * 128 + mm * 64 + (l4 >> 5) * 8;
            DMA2(Khn_, Vhn_, 0, 0);
#pragma unroll
            for (int d0 = 0; d0 < 4; ++d0) qr[d0] = *reinterpret_cast<const bf16x8*>(Qwn_ + d0 * 16);
        }
        const float fsc = mm ? lam : 1.0f;
        bf16_t* Em = (bf16_t*)(lds + E2_OFF + mm * E2_BYTES);
        asm volatile("s_waitcnt lgkmcnt(0)" ::: "memory");
#pragma unroll
        for (int r = 0; r < 16; ++r) { const int orow = crow(r, hi); const float f = fsc * __builtin_amdgcn_rcpf(li_l[orow]);
#pragma unroll
            for (int d0 = 0; d0 < 4; ++d0) Em[(rg * 32 + orow) * E2_STRIDE + d0 * 32 + r32] = f2bf(o[d0][r] * f); }
        asm volatile("s_waitcnt lgkmcnt(0)" ::: "memory"); __builtin_amdgcn_s_barrier(); asm volatile("" ::: "memory");
        {
            const int row = tid >> 2, qt = tid & 3;
            const bf16_t* e0 = (const bf16_t*)(lds + E2_OFF) + row * E2_STRIDE + qt * 32; const bf16_t* e1 = e0 + E2_BYTES / 2;
            float d[32]; float ss = 0.f;
#pragma unroll
            for (int c = 0; c < 4; ++c) { const u32x4 a = *(const u32x4*)(e0 + 8 * c), bq = *(const u32x4*)(e1 + 8 * c);
                d[8 * c + 0] = bf_lo(a.x) - bf_lo(bq.x); d[8 * c + 1] = bf_hi(a.x) - bf_hi(bq.x); d[8 * c + 2] = bf_lo(a.y) - bf_lo(bq.y); d[8 * c + 3] = bf_hi(a.y) - bf_hi(bq.y);
                d[8 * c + 4] = bf_lo(a.z) - bf_lo(bq.z); d[8 * c + 5] = bf_hi(a.z) - bf_hi(bq.z); d[8 * c + 6] = bf_lo(a.w) - bf_lo(bq.w); d[8 * c + 7] = bf_hi(a.w) - bf_hi(bq.w); }
#pragma unroll
            for (int c = 0; c < 32; ++c) ss += d[c] * d[c];
            ss += __shfl_xor(ss, 1); ss += __shfl_xor(ss, 2);
            const float rs = __builtin_amdgcn_rsqf(ss * (1.0f / 128.0f) + EPS) * 0.8f;
            bf16_t* op = Ob + (size_t)(b * SEQ + q0 + row) * LD + h * 128 + qt * 32;
            const float* gq = GS + qt * 32;
#pragma unroll
            for (int c = 0; c < 4; ++c) {
                u32x4 w; w.x = cvt_pk_bf16(d[8 * c + 0] * rs * gq[8 * c + 0], d[8 * c + 1] * rs * gq[8 * c + 1]); w.y = cvt_pk_bf16(d[8 * c + 2] * rs * gq[8 * c + 2], d[8 * c + 3] * rs * gq[8 * c + 3]);
                w.z = cvt_pk_bf16(d[8 * c + 4] * rs * gq[8 * c + 4], d[8 * c + 5] * rs * gq[8 * c + 5]); w.w = cvt_pk_bf16(d[8 * c + 6] * rs * gq[8 * c + 6], d[8 * c + 7] * rs * gq[8 * c + 7]);
                *(u32x4*)(op + 8 * c) = w; }
        }
    }
    asm volatile("s_waitcnt vmcnt(0) lgkmcnt(0)" ::: "memory"); __builtin_amdgcn_s_barrier(); asm volatile("" ::: "memory");
#undef UNIT_PTRS
#undef DMAP
#undef DMA2
#undef WBAR0
#undef VREQ
#undef VFRG
#undef PVM
#undef PIECE
#undef PFIN
#undef PC
#undef LSUM
}
}

namespace lru {
constexpr int CT = 128, NCH = SEQ / CT;
constexpr int LST = 68;
constexpr int XC_OFF = 0, AS_OFF = CT * 256, BS_OFF = AS_OFF + CT * LST * 4, HT_OFF = BS_OFF + CT * LST * 4, SEGP_OFF = HT_OFF + CT * LST * 4, SEGH_OFF = SEGP_OFF + 2048, CAR_OFF = SEGH_OFF + 2048, CW_OFF = CAR_OFF + 512;
static_assert(CW_OFF + 2560 <= MISC_OFF, "LRU LDS map");
__device__ __forceinline__ void lru_unit(int b, int n, int hh, const bf16_t* __restrict__ XL, const bf16_t* __restrict__ GY, bf16_t* __restrict__ LO, const bf16_t* __restrict__ WL,
                                         const float* __restrict__ conv_w, const float* __restrict__ conv_b, const float* __restrict__ rb, const float* __restrict__ ib, const float* __restrict__ lamp, char* lds, const int wid) {
    const int lane = lane_id(), tid = wid * 64 + lane, r32 = lane & 31, hi = lane >> 5;
    const int tp = wid & 1, ct = wid >> 1;
    char* XC = lds + XC_OFF; float* AS = (float*)(lds + AS_OFF); float* BS = (float*)(lds + BS_OFF); float* HT = (float*)(lds + HT_OFF);
    float* SEGP = (float*)(lds + SEGP_OFF); float* SEGH = (float*)(lds + SEGH_OFF); float* CAR = (float*)(lds + CAR_OFF);
    const int crow_ = tid >> 3, cg = tid & 7;
    const bf16_t* xbase = XL + (size_t)(b * SEQ) * DM + n * 128 + cg * 16;
    float* CW = (float*)(lds + CW_OFF);
    for (int i = tid; i < 640; i += 512) CW[i] = i < 512 ? conv_w[(i >> 7) * DM + n * 128 + (i & 127)] : conv_b[n * 128 + (i - 512)];
    for (int dir = 0; dir < 2; ++dir) {
        bf16x8 wf[8];
        { const bf16_t* wp = WL + (size_t)((((dir * 8 + n) * 2 + hh) * 4 + ct) * 32 + r32) * 128 + 8 * hi;
#pragma unroll
          for (int ks = 0; ks < 8; ++ks) wf[ks] = *reinterpret_cast<const bf16x8*>(wp + 16 * ks); }
        f32x4 nbr[2], nbi[2], kcv[2];
#pragma unroll
        for (int q2 = 0; q2 < 2; ++q2)
#pragma unroll
            for (int s2 = 0; s2 < 4; ++s2) { const int ch = dir * DM + n * 128 + hh * 64 + ct * 16 + 8 * q2 + 4 * hi + s2;
                nbr[q2][s2] = -rb[ch] * LOG2E; nbi[q2][s2] = -ib[ch] * LOG2E;
                const float L = lamp[ch]; kcv[q2][s2] = -8.0f * log1pf(__expf(-L)) * LOG2E; }
        __syncthreads();
        if (tid < 128) CAR[tid] = 0.f;
        u32x4 xin[2][4][2];
#define XLOAD(T1) do { const int t1_ = (T1); \
        if (t1_ >= 2 && t1_ <= SEQ - CT - 2) {                                    \
            _Pragma("unroll") for (int hf = 0; hf < 2; ++hf) _Pragma("unroll") for (int j = 0; j < 4; ++j) { const bf16_t* xp = xbase + (size_t)(t1_ + 64 * hf + crow_ + j - 2) * DM; xin[hf][j][0] = *(const u32x4*)xp; xin[hf][j][1] = *(const u32x4*)(xp + 8); } \
        } else { \
            _Pragma("unroll") for (int hf = 0; hf < 2; ++hf) _Pragma("unroll") for (int j = 0; j < 4; ++j) { const int t = t1_ + 64 * hf + crow_ + j - 2; const bool ok = (t >= 0 && t < SEQ); const bf16_t* xp = xbase + (size_t)(ok ? t : 0) * DM; \
                xin[hf][j][0] = ok ? *(const u32x4*)xp : (u32x4){0u, 0u, 0u, 0u}; xin[hf][j][1] = ok ? *(const u32x4*)(xp + 8) : (u32x4){0u, 0u, 0u, 0u}; } } } while (0)
        XLOAD(dir == 0 ? 0 : SEQ - CT);
        u32x4 hfr[2] = {{0u, 0u, 0u, 0u}, {0u, 0u, 0u, 0u}}, gyr[2] = {{0u, 0u, 0u, 0u}, {0u, 0u, 0u, 0u}}; size_t gio_prev = 0;
        for (int ci = 0; ci <= NCH; ++ci) {
            const int t0 = dir == 0 ? ci * CT : (NCH - 1 - ci) * CT;
            const size_t gio = (size_t)(b * SEQ + t0 + crow_) * DM + n * 128 + hh * 64 + cg * 8;
            if (ci < NCH) {
#pragma unroll
                for (int hf = 0; hf < 2; ++hf) {
                    f32x2 xc[8];
#pragma unroll
                    for (int p = 0; p < 8; ++p) xc[p] = *(const f32x2*)(CW + 512 + cg * 16 + 2 * p);
#pragma unroll
                    for (int j = 0; j < 4; ++j) { const u32x4 x0 = xin[hf][j][0], x1 = xin[hf][j][1]; const f32x2* cwj = (const f32x2*)(CW + j * 128 + cg * 16);
                        xc[0] += cwj[0] * (f32x2){bf_lo(x0.x), bf_hi(x0.x)}; xc[1] += cwj[1] * (f32x2){bf_lo(x0.y), bf_hi(x0.y)}; xc[2] += cwj[2] * (f32x2){bf_lo(x0.z), bf_hi(x0.z)}; xc[3] += cwj[3] * (f32x2){bf_lo(x0.w), bf_hi(x0.w)};
                        xc[4] += cwj[4] * (f32x2){bf_lo(x1.x), bf_hi(x1.x)}; xc[5] += cwj[5] * (f32x2){bf_lo(x1.y), bf_hi(x1.y)}; xc[6] += cwj[6] * (f32x2){bf_lo(x1.z), bf_hi(x1.z)}; xc[7] += cwj[7] * (f32x2){bf_lo(x1.w), bf_hi(x1.w)}; }
                    u32x4 w0, w1; w0.x = cvt_pk_bf16(xc[0].x, xc[0].y); w0.y = cvt_pk_bf16(xc[1].x, xc[1].y); w0.z = cvt_pk_bf16(xc[2].x, xc[2].y); w0.w = cvt_pk_bf16(xc[3].x, xc[3].y);
                    w1.x = cvt_pk_bf16(xc[4].x, xc[4].y); w1.y = cvt_pk_bf16(xc[5].x, xc[5].y); w1.z = cvt_pk_bf16(xc[6].x, xc[6].y); w1.w = cvt_pk_bf16(xc[7].x, xc[7].y);
                    *(u32x4*)(XC + KSWZ(64 * hf + crow_, cg * 32)) = w0; *(u32x4*)(XC + KSWZ(64 * hf + crow_, cg * 32 + 16)) = w1;
                }
                if (ci + 1 < NCH) XLOAD(dir == 0 ? (ci + 1) * CT : (NCH - 2 - ci) * CT);
            }
            __syncthreads();
            if (ci > 0) {
#pragma unroll
                for (int hf = 0; hf < 2; ++hf) {
                    const f32x4 h0 = *(const f32x4*)(HT + (64 * hf + crow_) * LST + cg * 8), h1 = *(const f32x4*)(HT + (64 * hf + crow_) * LST + cg * 8 + 4);
                    float hv[8] = {h0[0], h0[1], h0[2], h0[3], h1[0], h1[1], h1[2], h1[3]};
                    if (dir == 1) { const u32x4 f = hfr[hf], g = gyr[hf];
                        hv[0] = (hv[0] + bf_lo(f.x)) * bf_lo(g.x); hv[1] = (hv[1] + bf_hi(f.x)) * bf_hi(g.x); hv[2] = (hv[2] + bf_lo(f.y)) * bf_lo(g.y); hv[3] = (hv[3] + bf_hi(f.y)) * bf_hi(g.y);
                        hv[4] = (hv[4] + bf_lo(f.z)) * bf_lo(g.z); hv[5] = (hv[5] + bf_hi(f.z)) * bf_hi(g.z); hv[6] = (hv[6] + bf_lo(f.w)) * bf_lo(g.w); hv[7] = (hv[7] + bf_hi(f.w)) * bf_hi(g.w); }
                    u32x4 w; w.x = cvt_pk_bf16(hv[0], hv[1]); w.y = cvt_pk_bf16(hv[2], hv[3]); w.z = cvt_pk_bf16(hv[4], hv[5]); w.w = cvt_pk_bf16(hv[6], hv[7]);
                    *(u32x4*)(LO + gio_prev + (size_t)(64 * hf) * DM) = w; }
            }
            if (ci == NCH) break;
            if (dir == 1) {
#pragma unroll
                for (int hf = 0; hf < 2; ++hf) { hfr[hf] = *(const u32x4*)(LO + gio + (size_t)(64 * hf) * DM); gyr[hf] = *(const u32x4*)(GY + gio + (size_t)(64 * hf) * DM); } }
            gio_prev = gio;
#pragma unroll
            for (int k2 = 0; k2 < 2; ++k2) {
                const int tok = 64 * tp + 32 * k2 + r32;
                f32x16 acc = {};
                bf16x8 xb[4];
#pragma unroll
                for (int ks = 0; ks < 4; ++ks) xb[ks] = *reinterpret_cast<const bf16x8*>(XC + KSWZ(tok, (16 * ks + 8 * hi) * 2));
                __builtin_amdgcn_sched_barrier(0);
#pragma unroll
                for (int ks = 0; ks < 8; ++ks) { acc = __builtin_amdgcn_mfma_f32_32x32x16_bf16(wf[ks], xb[ks & 3], acc, 0, 0, 0);
                    if (ks + 4 < 8) xb[ks & 3] = *reinterpret_cast<const bf16x8*>(XC + KSWZ(tok, (16 * (ks + 4) + 8 * hi) * 2));
                    __builtin_amdgcn_sched_barrier(0); }
#pragma unroll
                for (int q2 = 0; q2 < 2; ++q2) { const int chl = ct * 16 + 8 * q2 + 4 * hi;
                    const f32x4 rpre = (f32x4){acc[8 * q2 + 0], acc[8 * q2 + 1], acc[8 * q2 + 2], acc[8 * q2 + 3]} * (-LOG2E) + nbr[q2];
                    const f32x4 ipre = (f32x4){acc[8 * q2 + 4], acc[8 * q2 + 5], acc[8 * q2 + 6], acc[8 * q2 + 7]} * (-LOG2E) + nbi[q2];
                    f32x4 rg, ig, a;
#pragma unroll
                    for (int s2 = 0; s2 < 4; ++s2) { rg[s2] = __builtin_amdgcn_rcpf(1.0f + __builtin_amdgcn_exp2f(rpre[s2])); ig[s2] = __builtin_amdgcn_rcpf(1.0f + __builtin_amdgcn_exp2f(ipre[s2])); }
                    const f32x4 la = rg * kcv[q2];
#pragma unroll
                    for (int s2 = 0; s2 < 4; ++s2) a[s2] = __builtin_amdgcn_exp2f(la[s2]);
                    const f32x4 om = 1.0f - a * a; f32x4 mult;
#pragma unroll
                    for (int s2 = 0; s2 < 4; ++s2) mult[s2] = __builtin_amdgcn_sqrtf(om[s2]);
                    const u32x2 xw = *(const u32x2*)(XC + KSWZ(tok, ((hh * 64 + chl) >> 3) * 16) + 8 * hi);
                    const f32x4 xv = {bf_lo(xw.x), bf_hi(xw.x), bf_lo(xw.y), bf_hi(xw.y)};
                    *(f32x4*)(AS + tok * LST + chl) = a; *(f32x4*)(BS + tok * LST + chl) = mult * ig * xv; }
            }
            __syncthreads();
            const int ch = lane, seg = wid;
            float av[16], bv[16];
            {
                float Pp = 1.f, Hh = 0.f;
#pragma unroll
                for (int p = 0; p < 16; ++p) { const int pos = seg * 16 + p, tl = dir ? CT - 1 - pos : pos; av[p] = AS[tl * LST + ch]; bv[p] = BS[tl * LST + ch]; Hh = av[p] * Hh + bv[p]; Pp *= av[p]; }
                SEGP[seg * 64 + ch] = Pp; SEGH[seg * 64 + ch] = Hh;
            }
            __syncthreads();
            {
                float c = CAR[(ci & 1) * 64 + ch];
                for (int s2 = 0; s2 < seg; ++s2) c = SEGP[s2 * 64 + ch] * c + SEGH[s2 * 64 + ch];
#pragma unroll
                for (int p = 0; p < 16; ++p) { const int pos = seg * 16 + p, tl = dir ? CT - 1 - pos : pos; c = av[p] * c + bv[p]; HT[tl * LST + ch] = c; }
                if (seg == 7) CAR[((ci + 1) & 1) * 64 + ch] = c;
            }
        }
#undef XLOAD
        asm volatile("s_waitcnt vmcnt(0)" ::: "memory");
        __syncthreads();
    }
}
}

__device__ __forceinline__ void transpose_item(const float* W, int N, bf16_t* WT, int ldt, int k0, int n0, size_t drow0, LAS float* scr, int lane) {
#pragma unroll
    for (int i = 0; i < 32; ++i) { const int kk = 2 * i + (lane >> 5); scr[kk * 33 + (lane & 31)] = W[(size_t)(k0 + kk) * N + n0 + (lane & 31)]; }
    LDS_WAIT(); asm volatile("" ::: "memory");
    const int c = lane & 7;
#pragma unroll
    for (int j = 0; j < 4; ++j) { const int nn = (lane >> 3) + 8 * j; const LAS float* s = scr + (8 * c) * 33 + nn;
        u32x4 o; o.x = cvt_pk_bf16(s[0 * 33], s[1 * 33]); o.y = cvt_pk_bf16(s[2 * 33], s[3 * 33]); o.z = cvt_pk_bf16(s[4 * 33], s[5 * 33]); o.w = cvt_pk_bf16(s[6 * 33], s[7 * 33]);
        *(GAS u32x4*)(WT + (drow0 + nn) * ldt + k0 + 8 * c) = o; }
    LDS_WAIT(); asm volatile("" ::: "memory");
}
__device__ __forceinline__ void transpose_item_fp8(const float* W, int N, unsigned char* WT, int ldt, int k0, int n0, size_t drow0, LAS float* scr, int lane) {
#pragma unroll
    for (int i = 0; i < 32; ++i) { const int kk = 2 * i + (lane >> 5); scr[kk * 33 + (lane & 31)] = W[(size_t)(k0 + kk) * N + n0 + (lane & 31)] * 64.0f; }
    LDS_WAIT(); asm volatile("" ::: "memory");
    const int c = lane & 7;
#pragma unroll
    for (int j = 0; j < 4; ++j) { const int nn = (lane >> 3) + 8 * j; const LAS float* s = scr + (8 * c) * 33 + nn;
        u32x2 o; o.x = pk4_fp8(s[0 * 33], s[1 * 33], s[2 * 33], s[3 * 33]); o.y = pk4_fp8(s[4 * 33], s[5 * 33], s[6 * 33], s[7 * 33]);
        *(GAS u32x2*)(WT + (drow0 + nn) * ldt + k0 + 8 * c) = o; }
    LDS_WAIT(); asm volatile("" ::: "memory");
}
__device__ __forceinline__ void transpose_mat(const float* W, int K, int N, bf16_t* WT, size_t drow_base, int item, LAS float* scr, int lane) {
    const int nblk = N / 32, kb = item / nblk, nb = item % nblk;
    transpose_item(W, N, WT, K, 64 * kb, 32 * nb, drow_base + 32 * nb, scr, lane);
}
__device__ __forceinline__ int rel_bucket(int rel) {
    const int ret = rel > 0 ? 16 : 0; const int nabs = rel < 0 ? -rel : rel;
    if (nabs < 8) return ret + nabs;
    int large = (31 - __clz(nabs * nabs)) + 2; large = large < 15 ? large : 15;
    return ret + large;
}

struct Params { const float* in[26]; float* out; unsigned char* ws; int ph_lo, ph_hi, probe, pad; };

__global__ void __launch_bounds__(512, 2) mk_fwd(Params P) {
    extern __shared__ __attribute__((aligned(16))) unsigned char lds[];
    LAS unsigned char* ldsl = (LAS unsigned char*)lds;
    volatile LAS unsigned* MISC = (volatile LAS unsigned*)(ldsl + MISC_OFF);
    const int wave = __builtin_amdgcn_readfirstlane((int)threadIdx.x >> 6);
    const int G = gridDim.x, bx = blockIdx.x;
    const int vcu = (G % 8 == 0) ? (bx % 8) * (G / 8) + bx / 8 : bx;
    unsigned char* ws = P.ws;
    if (threadIdx.x < 32) MISC[threadIdx.x] = 0u;
    __syncthreads();
    XcdBarrier bar; bar.bar = (unsigned*)(ws + WS_CTL) + CW_BAR; bar.x = 0; bar.st = nullptr;
    if (P.ph_hi - P.ph_lo > 1) bar = xcd_barrier_post((unsigned*)(ws + WS_CTL) + CW_BAR, MISC + 8);
    const int lo = P.ph_lo, hi = P.ph_hi;
#define IN(k) (lo <= (k) && (k) < hi)
#define PH_IDS() const int lane = lane_id(), tid = wave * 64 + lane; (void)tid; (void)lane
#define BOTH(k) (IN(k) && IN((k) + 1))
    const float* x = P.in[0];
    bf16_t* RA = (bf16_t*)(ws + WS_RA); bf16_t* QB = (bf16_t*)(ws + WS_Q); bf16_t* KB = (bf16_t*)(ws + WS_K); bf16_t* VB = (bf16_t*)(ws + WS_V);
    bf16_t* XL = (bf16_t*)(ws + WS_XL); bf16_t* GY = (bf16_t*)(ws + WS_GY); bf16_t* LO = (bf16_t*)(ws + WS_LO);
    unsigned char* SA = (unsigned char*)P.out; unsigned char* SR = (unsigned char*)P.out + (size_t)MTOK * DM;
    bf16_t* WIN = (bf16_t*)(ws + WS_WIN); bf16_t* WCAT = (bf16_t*)(ws + WS_WCAT); bf16_t* WOUT = (bf16_t*)(ws + WS_WOUT); bf16_t* WLRU = (bf16_t*)(ws + WS_WLRU);
    bf16_t* WGU = (bf16_t*)(ws + WS_WGU); bf16_t* WDN = (bf16_t*)(ws + WS_WDN); bf16_t* HG = (bf16_t*)(ws + WS_HG);
    unsigned char* XN8 = ws + WS_XN8; unsigned char* WIN8 = ws + WS_WIN8;
    float* TBG = (float*)(ws + WS_TAB); float* MISCG = (float*)(ws + WS_TAB + 16384);
    unsigned short* INV = (unsigned short*)(ws + WS_INV); bf16_t* YE = (bf16_t*)(ws + WS_YE);
    bf16_t* H16 = (bf16_t*)(ws + WS_H16);
    float* SELRS = (float*)(ws + WS_SELRS); float* RSV = (float*)(ws + WS_RS);
    float* AFF = (float*)(ws + WS_AFF); int* SELI = (int*)(ws + WS_SELI); float* SELV = (float*)(ws + WS_SELV);
    const int gw = vcu * 8 + wave, NGW = G * 8;

    if (IN(0)) { PH_IDS();
        LAS float* scr = (LAS float*)(ldsl + wave * 16384);
        constexpr int I_IN = (DM / 64) * (DIN / 32), I_SQ = (DM / 64) * (DM / 32);
        for (int it = gw; it < I_IN + 3 * I_SQ; it += NGW) {
            int r = it;
            if (r < I_IN) { const int nb = r % (DIN / 32); if (nb < 5120 / 32) transpose_mat(P.in[2], DM, DIN, WIN, 0, r, scr, lane);
                if (nb >= 5120 / 32) { const int kb = r / (DIN / 32); transpose_item_fp8(P.in[2], DIN, WIN8, DM, 64 * kb, 32 * nb, (size_t)(32 * nb - 5120), scr, lane); }
                continue; } r -= I_IN;
            if (r < I_SQ) { const int kb = r / (DM / 32), nb = r % (DM / 32); transpose_item(P.in[18], DM, WCAT, 2 * DM, 64 * kb, 32 * nb, (size_t)(32 * nb), scr, lane); continue; } r -= I_SQ;
            if (r < I_SQ) { const int kb = r / (DM / 32), nb = r % (DM / 32); transpose_item(P.in[19], DM, WCAT + DM, 2 * DM, 64 * kb, 32 * nb, (size_t)(32 * nb), scr, lane); continue; } r -= I_SQ;
            transpose_mat(P.in[20], DM, DM, WOUT, 0, r, scr, lane);
        }
        for (int e = gw * 64 + lane; e < 2 * 8 * 2 * 4 * 32 * 128; e += NGW * 64) {
            const int k = e & 127, rho = (e >> 7) & 31, ct = (e >> 12) & 3, hh = (e >> 14) & 1, n = (e >> 15) & 7, dir = e >> 18;
            const int type = (rho >> 3) & 1, s = rho & 3, hi_ = (rho >> 2) & 1, q2 = rho >> 4;
            const int dcol = hh * 64 + ct * 16 + 8 * q2 + 4 * hi_ + s;
            const float* src = type ? P.in[15] : P.in[13];
            WLRU[e] = f2bf(src[(size_t)((dir * 8 + n) * 128 + k) * 128 + dcol]);
        }
        if (vcu == 0) {
            float gqm = 0.f, gkm = 0.f;
            for (int i = 0; i < 64; ++i) { gqm = fmaxf(gqm, fabsf(P.in[3][i])); gkm = fmaxf(gkm, fabsf(P.in[4][i])); }
            for (int e = tid; e < NH * 512; e += 512) { const int h = e >> 9, idx = e & 511;
                float bm = -1e30f; for (int bk = 0; bk < 32; ++bk) bm = fmaxf(bm, P.in[10][bk * NH + h]);
                const float Mh = 8.0f * gqm * gkm + bm;
                TBG[e] = (P.in[10][rel_bucket(idx - 256) * NH + h] - Mh) * LOG2E; }
            if (tid == 0) { float s1 = 0.f, s2 = 0.f; for (int i = 0; i < 64; ++i) { s1 += P.in[5][i] * P.in[6][i]; s2 += P.in[7][i] * P.in[8][i]; }
                MISCG[0] = __expf(s1) - __expf(s2) + 0.2f; }
        }
        for (int m = gw; m < MTOK; m += NGW) {
            const GAS f32x4* xr = (const GAS f32x4*)(x + (size_t)m * DM) + lane; const f32x4* gr = (const f32x4*)P.in[1] + lane;
            f32x4 v[4]; float s = 0.f;
#pragma unroll
            for (int j = 0; j < 4; ++j) { v[j] = xr[64 * j]; s += (v[j].x * v[j].x + v[j].y * v[j].y) + (v[j].z * v[j].z + v[j].w * v[j].w); }
            const float rs = __builtin_amdgcn_rsqf(wave_sum(s) * (1.0f / DM) + EPS);
            GAS u32x2* o8 = (GAS u32x2*)(RA + (size_t)m * DM) + lane;
            GAS unsigned* o4 = (GAS unsigned*)(XN8 + (size_t)m * DM) + lane;
#pragma unroll
            for (int j = 0; j < 4; ++j) { const f32x4 g = gr[64 * j]; const f32x4 y = v[j] * rs * g; u32x2 w; w.x = cvt_pk_bf16(y.x, y.y); w.y = cvt_pk_bf16(y.z, y.w); o8[64 * j] = w; o4[64 * j] = pk4_fp8(y.x, y.y, y.z, y.w); }
        }
        if (BOTH(0)) xcd_barrier(bar, wave);
    }

    if (IN(1)) {
#ifdef MK_PROBE_P1
        if (P.probe) { pg8::DenseOrder S{(const char*)RA, (const char*)WIN, DM * 2, DM * 2, MTOK / 256, 20, G, bx}; pg8::EpiNull E{(float*)(ws + WS_CTL + 32768)};
            pg8::gemm_phase<pg8::EpiNull, pg8::DenseOrder, true, true>(ldsl, DM * 2, S, E, wave); } else
#endif
        {
        LAS float* gl = (LAS float*)(ldsl + X_SCR_OFF);
        { PH_IDS(); if (tid < 128) gl[tid] = tid < 64 ? P.in[3][tid] : P.in[4][tid - 64]; }
        __syncthreads();
        { pg8::DenseOrder S{(const char*)RA, (const char*)WIN, DM * 2, DM * 2, MTOK / 256, 20, G, bx};
          pg8::EpiProj E{QB, KB, VB, XL, GY, gl};
          pg8::gemm_phase<pg8::EpiProj, pg8::DenseOrder, true, true>(ldsl, DM * 2, S, E, wave); }
        { pg8::DenseOrder S{(const char*)XN8, (const char*)WIN8, DM, DM, MTOK / 256, 8, G, bx};
          pg8::EpiGate E; E.sa = SA; E.sr = SR; E.gsc = 0.015625f;
          pg8::gemm_phase<pg8::EpiGate, pg8::DenseOrder, true, true, true>(ldsl, DM, S, E, wave); }
        }
        if (BOTH(1)) xcd_barrier(bar, wave);
    }

    if (IN(2)) {
        for (int u = vcu; u < 256; u += G)
            lru::lru_unit(u >> 4, (u >> 1) & 7, u & 1, XL, GY, LO, WLRU, P.in[11], P.in[12], P.in[14], P.in[16], P.in[17], (char*)lds, wave);
        __syncthreads();
    }
    if (IN(3)) {
        const float lam = MISCG[0];
#ifdef MK_PROBE_ATTN
        if (P.probe) att::attn_phase<MK_PROBE_ATTN, MK_PROBE_VAR>(vcu, G, QB, KB, VB, RA, TBG, P.in[9], lam, (char*)lds, wave); else
#endif
        att::attn_phase2<0>(vcu, G, QB, KB, VB, RA, TBG, P.in[9], lam, (char*)lds, wave);
        if (BOTH(3)) xcd_barrier(bar, wave);
    }

    if (IN(4)) {
        pg8::BranchOrder S{(const char*)RA, (const char*)LO, (const char*)WCAT, G, bx};
        pg8::EpiBranch E; E.sa = SA; E.sr = SR; E.mixed = XL;
        pg8::gemm_phase<pg8::EpiBranch, pg8::BranchOrder, true, true>(ldsl, DM * 4, S, E, wave);
        if (BOTH(4)) xcd_barrier(bar, wave);
    }

    if (IN(5)) {
        pg8::DenseOrder S{(const char*)XL, (const char*)WOUT, DM * 2, DM * 2, MTOK / 256, DM / 256, G, bx};
        pg8::EpiOut E; E.x = x; E.h16 = H16;
        pg8::gemm_phase<pg8::EpiOut, pg8::DenseOrder, true, true>(ldsl, DM * 2, S, E, wave);
        if (BOTH(5)) xcd_barrier(bar, wave);
    }

    if (IN(6)) { PH_IDS();
        LAS float* WRT = (LAS float*)ldsl;
        LAS float* GL = (LAS float*)(ldsl + 65536);
        for (int i = tid; i < DM * NE; i += 512) { const int k = i >> 4, e = i & 15; WRT[(k >> 2) * 64 + e * 4 + (k & 3)] = P.in[22][i]; }
        for (int i = tid; i < DM; i += 512) GL[i] = P.in[21][i];
        __syncthreads();
        const int r = lane & 15, q = lane >> 4;
        for (int g16 = gw; g16 < MTOK / 16; g16 += NGW) {
            const int R0 = g16 * 16;
            const GAS u32x4* hrow = (const GAS u32x4*)(H16 + (size_t)(R0 + r) * DM + 8 * q);
            GAS u32x2* o8 = (GAS u32x2*)((unsigned char*)RA + (size_t)(R0 + r) * DM + 8 * q);
            f32x4 acc = {0.f, 0.f, 0.f, 0.f}; float ss = 0.f;
            u32x4 hwv[32];
#pragma unroll
            for (int j = 0; j < 32; ++j) hwv[j] = hrow[4 * j];
            __builtin_amdgcn_sched_barrier(0);
#pragma unroll
            for (int j = 0; j < 32; ++j) {
                const u32x4 hw = hwv[j]; const f32x4 g0 = *(const LAS f32x4*)(GL + 32 * j + 8 * q), g1 = *(const LAS f32x4*)(GL + 32 * j + 8 * q + 4);
                const f32x4 y0 = (f32x4){bf_lo(hw.x), bf_hi(hw.x), bf_lo(hw.y), bf_hi(hw.y)} * g0, y1 = (f32x4){bf_lo(hw.z), bf_hi(hw.z), bf_lo(hw.w), bf_hi(hw.w)} * g1;
                ss += ((y0.x * y0.x + y0.y * y0.y) + (y0.z * y0.z + y0.w * y0.w)) + ((y1.x * y1.x + y1.y * y1.y) + (y1.z * y1.z + y1.w * y1.w));
                u32x2 o; o.x = pk4_fp8(y0.x, y0.y, y0.z, y0.w); o.y = pk4_fp8(y1.x, y1.y, y1.z, y1.w); o8[4 * j] = o;
                const f32x4 w0 = *(const LAS f32x4*)(WRT + (8 * j + 2 * q) * 64 + r * 4), w1 = *(const LAS f32x4*)(WRT + (8 * j + 2 * q + 1) * 64 + r * 4);
                acc = __builtin_amdgcn_mfma_f32_16x16x4f32(y0.x, w0.x, acc, 0, 0, 0); acc = __builtin_amdgcn_mfma_f32_16x16x4f32(y0.y, w0.y, acc, 0, 0, 0);
                acc = __builtin_amdgcn_mfma_f32_16x16x4f32(y0.z, w0.z, acc, 0, 0, 0); acc = __builtin_amdgcn_mfma_f32_16x16x4f32(y0.w, w0.w, acc, 0, 0, 0);
                acc = __builtin_amdgcn_mfma_f32_16x16x4f32(y1.x, w1.x, acc, 0, 0, 0); acc = __builtin_amdgcn_mfma_f32_16x16x4f32(y1.y, w1.y, acc, 0, 0, 0);
                acc = __builtin_amdgcn_mfma_f32_16x16x4f32(y1.z, w1.z, acc, 0, 0, 0); acc = __builtin_amdgcn_mfma_f32_16x16x4f32(y1.w, w1.w, acc, 0, 0, 0);
            }
            ss += __shfl_xor(ss, 16); ss += __shfl_xor(ss, 32);
            const float rs = __builtin_amdgcn_rsqf(ss * (1.0f / DM) + EPS);
            if (q == 0) RSV[R0 + r] = rs;
            f32x4 pr;
#pragma unroll
            for (int reg = 0; reg < 4; ++reg) { const float lg = acc[reg] * __shfl(rs, 4 * q + reg);
                const float mx = row16_max(lg);
                const float ex = __expf(lg - mx); const float den = row16_sum(ex);
                pr[reg] = ex / den; }
            *(GAS f32x4*)(AFF + (size_t)((R0 >> 11) * NE + r) * SEQ + (R0 & (SEQ - 1)) + 4 * q) = pr;
        }
        if (BOTH(6)) xcd_barrier(bar, wave);
    }

    if (IN(7)) { PH_IDS();
        LAS u64* sk = (LAS u64*)ldsl;
        for (int p = vcu; p < BATCH * NE; p += G) {
            for (int t = tid; t < SEQ; t += 512) sk[t] = ((u64)__float_as_uint(AFF[(size_t)p * SEQ + t]) << 32) | (u64)(0xFFFFFFFFu - (unsigned)t);
            __syncthreads();
            for (int k = 2; k <= SEQ; k <<= 1)
                for (int j = k >> 1; j > 0; j >>= 1) {
#pragma unroll
                    for (int t2 = 0; t2 < 2; ++t2) { const int t = tid + 512 * t2; const int i = ((t & ~(j - 1)) << 1) | (t & (j - 1)), l = i | j;
                        const u64 a = sk[i], bq = sk[l]; const bool desc = ((i & k) == 0);
                        if ((a < bq) == desc) { sk[i] = bq; sk[l] = a; } }
                    __syncthreads();
                }
            if (tid < CAP) { const u64 kv = sk[tid]; const int tok = (int)(0xFFFFFFFFu - (unsigned)kv); SELI[p * CAP + tid] = tok; SELV[p * CAP + tid] = __uint_as_float((unsigned)(kv >> 32)); SELRS[p * CAP + tid] = RSV[(p >> 4) * SEQ + tok]; }
            for (int t = tid; t < SEQ; t += 512) { const unsigned tok = 0xFFFFFFFFu - (unsigned)sk[t]; INV[(size_t)((p >> 4) * SEQ + tok) * NE + (p & 15)] = (unsigned short)(t < CAP ? t + 1 : 0); }
            __syncthreads();
        }
        LAS float* scr = (LAS float*)(ldsl + 16384 + wave * 8704);
        constexpr int I_GU = (DM / 64) * (FFE / 32), I_DN = (FFE / 64) * (DM / 32);
        for (int it = gw; it < NE * (2 * I_GU + I_DN); it += NGW) {
            const int e = it / (2 * I_GU + I_DN); int r = it % (2 * I_GU + I_DN);
            if (r < 2 * I_GU) { const int up = r >= I_GU; if (up) r -= I_GU;
                const int nblk = FFE / 32, kb = r / nblk, nb = r % nblk, n0 = 32 * nb;
                const float* W = (up ? P.in[24] : P.in[23]) + (size_t)e * DM * FFE;
                const size_t drow0 = (size_t)e * 4096 + (size_t)(n0 >> 7) * 256 + (n0 & 127) + (up ? 128 : 0);
                transpose_item_fp8(W, FFE, (unsigned char*)WGU, DM, 64 * kb, n0, drow0, scr, lane);
            } else { r -= 2 * I_GU;
                const int nblk = DM / 32, kb = r / nblk, nb = r % nblk;
                transpose_item_fp8(P.in[25] + (size_t)e * FFE * DM, DM, (unsigned char*)WDN, FFE, 64 * kb, 32 * nb, (size_t)e * DM + 32 * nb, scr, lane); }
        }
        if (BOTH(7)) xcd_barrier(bar, wave);
    }

    const bool pvalid = (G == 256);
    const int pj = bx / 8, pe = 2 * (bx % 8) + (pj >> 4), pb = pj & 15, pair = pb * NE + pe;

    if (IN(8)) {
        pg8::MoeUpOrder S{(const char*)RA, (const char*)WGU, SELI, pb, pe, pair, pvalid};
        LAS float* rsl = (LAS float*)(ldsl + X_SCR_OFF);
        { PH_IDS(); if (tid < CAP) rsl[tid] = pvalid ? SELRS[pair * CAP + tid] * 0.015625f : 0.f; }
        __syncthreads();
        pg8::EpiMoeUp E; E.hg = (unsigned char*)HG; E.rsl = rsl;
        pg8::gemm_phase<pg8::EpiMoeUp, pg8::MoeUpOrder, true, true, true>(ldsl, DM, S, E, wave);
        if (BOTH(8)) xcd_barrier(bar, wave);
    }

    if (IN(9)) {
        pg8::MoeDownOrder S{(const char*)HG, (const char*)WDN, bx, pvalid};
        LAS float* vall = (LAS float*)(ldsl + X_SCR_OFF);
        { PH_IDS(); for (int t = tid; t < 4 * CAP; t += 512) { const int i = t >> 8, x_ = bx & 7, j_ = bx >> 3, q_ = i * 8 + (j_ >> 2), e_ = 2 * x_ + (q_ >> 4), b_ = q_ & 15;
            vall[t] = pvalid ? SELV[(b_ * NE + e_) * CAP + (t & 255)] : 0.f; } }
        __syncthreads();
        pg8::EpiMoeDown E; E.ye = (unsigned char*)YE; E.vall = vall;
        pg8::gemm_phase<pg8::EpiMoeDown, pg8::MoeDownOrder, true, true, true>(ldsl, FFE, S, E, wave);
        if (BOTH(9)) xcd_barrier(bar, wave);
    }

    if (IN(10)) { PH_IDS();
        unsigned iv_next = lane < NE ? (unsigned)INV[(size_t)gw * NE + lane] : 0u;
        for (int m = gw; m < MTOK; m += NGW) {
            GAS f32x4* orow = (GAS f32x4*)(P.out + (size_t)m * DM) + lane; const GAS u32x2* hrow = (const GAS u32x2*)(H16 + (size_t)m * DM) + lane;
            const unsigned iv = iv_next;
            if (m + NGW < MTOK) iv_next = lane < NE ? (unsigned)INV[(size_t)(m + NGW) * NE + lane] : 0u;
            f32x4 v[4], sacc[4];
#pragma unroll
            for (int j = 0; j < 4; ++j) { const u32x2 hw = hrow[64 * j]; v[j] = (f32x4){bf_lo(hw.x), bf_hi(hw.x), bf_lo(hw.y), bf_hi(hw.y)}; sacc[j] = (f32x4){0.f, 0.f, 0.f, 0.f}; }
            unsigned mask = (unsigned)(__ballot(iv != 0u) & 0xFFFFull);
            const int bb = m >> 11;
            while (mask) {
                unsigned a[4][4];
#pragma unroll
                for (int c = 0; c < 4; ++c) {
                    if (mask) { const int e0 = __builtin_ctz(mask); mask &= mask - 1;
                        const unsigned s0 = (unsigned)__builtin_amdgcn_readlane((int)iv, e0) - 1u;
                        const GAS unsigned* y0 = (const GAS unsigned*)((const unsigned char*)YE + (size_t)((bb * NE + e0) * CAP + s0) * DM) + lane;
#pragma unroll
                        for (int j = 0; j < 4; ++j) a[c][j] = y0[64 * j];
                    } else {
#pragma unroll
                        for (int j = 0; j < 4; ++j) a[c][j] = 0u;
                    }
                }
#pragma unroll
                for (int c = 0; c < 4; ++c)
#pragma unroll
                    for (int j = 0; j < 4; ++j) { const f32x2 lo = __builtin_amdgcn_cvt_pk_f32_fp8((int)a[c][j], false), hi = __builtin_amdgcn_cvt_pk_f32_fp8((int)a[c][j], true);
                        sacc[j].x += lo.x; sacc[j].y += lo.y; sacc[j].z += hi.x; sacc[j].w += hi.y; }
            }
#pragma unroll
            for (int j = 0; j < 4; ++j) v[j] += sacc[j] * 0.015625f;
#pragma unroll
            for (int j = 0; j < 4; ++j) orow[64 * j] = v[j];
        }
    }
#undef IN
#undef BOTH
}

extern "C" void kernel_launch(void* const* d_in, const int* in_sizes, int n_in, void* d_out, int out_size, void* d_ws, size_t ws_size, hipStream_t stream) {
    static int grid = 0;
    if (grid == 0) {
        if (n_in != 26 || in_sizes[0] != MTOK * DM || out_size != MTOK * DM || ws_size < WS_END) {
            fprintf(stderr, "kernel_launch: shape/workspace mismatch: n_in %d in0 %d out %d ws %zu (need %zu)\n", n_in, n_in > 0 ? in_sizes[0] : -1, out_size, ws_size, (size_t)WS_END); grid = -1; return; }
        int dev = 0, cus = 0;
        if (hipGetDevice(&dev) != hipSuccess || hipDeviceGetAttribute(&cus, hipDeviceAttributeMultiprocessorCount, dev) != hipSuccess) { grid = -1; return; }
        if (hipFuncSetAttribute((const void*)mk_fwd, hipFuncAttributeMaxDynamicSharedMemorySize, LDS_BYTES) != hipSuccess) { fprintf(stderr, "kernel_launch: hipFuncSetAttribute failed\n"); grid = -1; return; }
        int per_cu = 0;
        if (hipOccupancyMaxActiveBlocksPerMultiprocessor(&per_cu, (const void*)mk_fwd, 512, LDS_BYTES) != hipSuccess || per_cu < 1) fprintf(stderr, "kernel_launch: occupancy query says %d\n", per_cu);
        (void)hipGetLastError();
        grid = cus;
        if (grid != 256) fprintf(stderr, "kernel_launch: %d CUs; the MoE phases need 256\n", grid);
    }
    if (grid < 0) return;
    (void)hipMemsetAsync((char*)d_ws + WS_CTL, 0, CTL_ZERO_BYTES, stream);
    Params p{};
    for (int i = 0; i < 26; ++i) p.in[i] = (const float*)d_in[i];
    p.out = (float*)d_out; p.ws = (unsigned char*)d_ws;
#if MK_ONE_LAUNCH
    p.ph_lo = 0; p.ph_hi = NPHASE;
    hipLaunchKernelGGL(mk_fwd, dim3(grid), dim3(512), LDS_BYTES, stream, p);
#else
    for (int ph = 0; ph < NPHASE; ++ph) { p.ph_lo = ph; p.ph_hi = ph + 1; hipLaunchKernelGGL(mk_fwd, dim3(grid), dim3(512), LDS_BYTES, stream, p);
#ifdef MK_PROBE_ATTN
        if (ph == 2) { Params q = p; q.ph_lo = 3; q.ph_hi = 4; q.probe = 1; hipLaunchKernelGGL(mk_fwd, dim3(grid), dim3(512), LDS_BYTES, stream, q); }
#endif
#ifdef MK_PROBE_P1
        if (ph == 1) { Params q = p; q.probe = 1; hipLaunchKernelGGL(mk_fwd, dim3(grid), dim3(512), LDS_BYTES, stream, q); }
#endif
#ifdef MK_REP_PHASE
        if (ph == MK_REP_PHASE) hipLaunchKernelGGL(mk_fwd, dim3(grid), dim3(512), LDS_BYTES, stream, p);
#endif
    }
#endif
    const hipError_t le = hipPeekAtLastError();
    if (le != hipSuccess) fprintf(stderr, "kernel_launch: launch failed: %s\n", hipGetErrorName(le));
}
```

```cpp
#include <hip/hip_runtime.h>
#include <cstdio>
#include <cstdint>

#define GAS __attribute__((address_space(1)))
#define LAS __attribute__((address_space(3)))
typedef unsigned short bf16_t;
typedef short bf16x8 __attribute__((ext_vector_type(8)));
typedef short s16x4 __attribute__((ext_vector_type(4)));
typedef float f32x2 __attribute__((ext_vector_type(2)));
typedef float f32x4 __attribute__((ext_vector_type(4)));
typedef float f32x16 __attribute__((ext_vector_type(16)));
typedef unsigned u32x2 __attribute__((ext_vector_type(2)));
typedef unsigned u32x4 __attribute__((ext_vector_type(4)));
typedef unsigned long long u64;
typedef int i32x8 __attribute__((ext_vector_type(8)));
typedef int i32x4 __attribute__((ext_vector_type(4)));

#ifndef MK_ONE_LAUNCH
#define MK_ONE_LAUNCH 1
#endif

constexpr int BATCH = 16, SEQ = 2048, DM = 1024, MTOK = BATCH * SEQ, NH = 8, DIN = 7168, NE = 16, CAP = 256, FFE = 2048;
constexpr float EPS = 1e-6f;
constexpr float LOG2E = 1.4426950408889634f;
constexpr int NPHASE = 11;

constexpr size_t MiB = 1u << 20;
constexpr size_t WS_CTL = 0, CTL_ZERO_BYTES = 64 * 1024;
constexpr size_t WS_TAB = 1 * MiB;
constexpr size_t WS_WIN = 2 * MiB;
constexpr size_t WS_WCAT = 16 * MiB;
constexpr size_t WS_WOUT = 20 * MiB;
constexpr size_t WS_WLRU = 22 * MiB;
constexpr size_t WS_AFF = 23 * MiB;
constexpr size_t WS_SELI = 25 * MiB;
constexpr size_t WS_SELV = 25 * MiB + 256 * 1024;
constexpr size_t WS_SELRS = 25 * MiB + 512 * 1024;
constexpr size_t WS_RS = 25 * MiB + 768 * 1024;
constexpr size_t WS_RA = 26 * MiB;
constexpr size_t WS_Q = 90 * MiB, WS_K = 154 * MiB, WS_V = 218 * MiB;
constexpr size_t WS_WGU = 474 * MiB;
constexpr size_t WS_WDN = 218 * MiB;
constexpr size_t WS_XL = 282 * MiB;
constexpr size_t WS_GY = 346 * MiB;
constexpr size_t WS_LO = 410 * MiB;
constexpr size_t WS_HG = 282 * MiB;
constexpr size_t WS_YE = 90 * MiB;
constexpr size_t WS_XN8 = 474 * MiB;
constexpr size_t WS_WIN8 = 506 * MiB;
constexpr size_t WS_H16 = 410 * MiB;
constexpr size_t WS_INV = 540 * MiB;
constexpr size_t WS_END = 541 * MiB;
constexpr int CW_BAR = 1024;

constexpr int RING_BYTES = 131072;
constexpr int X_SCR_OFF = 131072;
constexpr int X_IDX_OFF = X_SCR_OFF + 8 * 2304;
constexpr int MISC_OFF = X_IDX_OFF + 2048;
constexpr int LDS_BYTES = 152576;

typedef __bf16 bf16x2_t __attribute__((ext_vector_type(2)));
__device__ __forceinline__ unsigned cvt_pk_bf16(float lo, float hi) { const f32x2 v = {lo, hi}; const bf16x2_t b = __builtin_convertvector(v, bf16x2_t); return __builtin_bit_cast(unsigned, b); }
__device__ __forceinline__ float bf_lo(unsigned w) { return __uint_as_float(w << 16); }
__device__ __forceinline__ float bf_hi(unsigned w) { return __uint_as_float(w & 0xffff0000u); }
__device__ __forceinline__ float bf1(bf16_t b) { return __uint_as_float(((unsigned)b) << 16); }
__device__ __forceinline__ bf16_t f2bf(float f) { return (bf16_t)(cvt_pk_bf16(f, 0.f) & 0xffffu); }
__device__ __forceinline__ unsigned pk4_fp8(float a, float b, float c, float d) { int w = 0; w = __builtin_amdgcn_cvt_pk_fp8_f32(a, b, w, false); w = __builtin_amdgcn_cvt_pk_fp8_f32(c, d, w, true); return (unsigned)w; }
__device__ __forceinline__ int lane_id() { int r; asm volatile("v_mbcnt_lo_u32_b32 %0, -1, 0\n\tv_mbcnt_hi_u32_b32 %0, -1, %0" : "=v"(r)); return r; }
__device__ __forceinline__ float wave_sum(float v) {
#pragma unroll
    for (int o = 1; o < 64; o <<= 1) v += __shfl_xor(v, o);
    return v;
}
constexpr float GATE_Q = 255.996f, GATE_QI = 1.0f / 255.996f, GATE_QL = -7.99997745f;
template <int CTRL> __device__ __forceinline__ float dppf(float x) { return __uint_as_float((unsigned)__builtin_amdgcn_mov_dpp((int)__float_as_uint(x), CTRL, 0xF, 0xF, true)); }
__device__ __forceinline__ float row16_max(float x) { x = fmaxf(x, dppf<0xB1>(x)); x = fmaxf(x, dppf<0x4E>(x)); x = fmaxf(x, dppf<0x141>(x)); x = fmaxf(x, dppf<0x140>(x)); return x; }
__device__ __forceinline__ float row16_sum(float x) { x += dppf<0xB1>(x); x += dppf<0x4E>(x); x += dppf<0x141>(x); x += dppf<0x140>(x); return x; }
__device__ __forceinline__ float sigmoidf_(float x) { return __builtin_amdgcn_rcpf(1.0f + __builtin_amdgcn_exp2f(-x * LOG2E)); }
__device__ __forceinline__ float gelu_tanh(float y) { const float u = 0.7978845608028654f * (y + 0.044715f * y * y * y); return y * __builtin_amdgcn_rcpf(1.0f + __builtin_amdgcn_exp2f(-2.0f * LOG2E * u)); }
#define LDS_WAIT() asm volatile("s_waitcnt lgkmcnt(0)" ::: "memory")
#define VM_WAIT() asm volatile("s_waitcnt vmcnt(0)" ::: "memory")

#define XB_TMO      128
#define XB_XCNT(j)  (256  + 64 * (j))
#define XB_XSUB(j)  (1280 + 64 * (j))
#define XB_XGEN(j)  (2304 + 64 * (j))
#define XB_TOP      3328
#define XB_TOPGEN   3392
#define XCD_BAR_WORDS 3456
#define XB_SPIN_CAP (1u << 18)
__device__ __forceinline__ unsigned xb_ld(unsigned* p)              { return __hip_atomic_load(p, __ATOMIC_RELAXED, __HIP_MEMORY_SCOPE_AGENT); }
__device__ __forceinline__ unsigned xb_add(unsigned* p, unsigned v) { return __hip_atomic_fetch_add(p, v, __ATOMIC_RELAXED, __HIP_MEMORY_SCOPE_AGENT); }
__device__ __forceinline__ unsigned xb_xcc_id() { return (unsigned)__builtin_amdgcn_s_getreg((3 << 11) | 20) & 0xFu; }
#define XB_SPIN(cond, bar) do { unsigned _sp = 0; while (cond) { __builtin_amdgcn_s_sleep(1); \
    if ((++_sp & 255u) == 0u) { if (xb_ld(&(bar)[XB_TMO])) break; if (_sp > XB_SPIN_CAP) { atomicAdd(&(bar)[XB_TMO], 1u); break; } } } } while (0)
struct XcdBarrier { unsigned* bar; unsigned x; volatile LAS unsigned* st; };
__device__ __forceinline__ XcdBarrier xcd_barrier_post(unsigned* bar, volatile LAS unsigned* st) {
    XcdBarrier b; b.bar = bar; b.x = xb_xcc_id(); b.st = st;
    if (threadIdx.x == 0) (void)xb_add(&bar[XB_XCNT(b.x)], 1u);
    return b;
}
__device__ __forceinline__ void xcd_barrier_complete(unsigned* bar, unsigned x, unsigned& nloc, unsigned& nx) {
    const unsigned G = gridDim.x * gridDim.y * gridDim.z;
    unsigned sum, cnt, mine, sp = 0u;
    for (;;) {
        sum = 0u; cnt = 0u; mine = 0u;
#pragma unroll
        for (unsigned j = 0; j < 16; ++j) { const unsigned c = xb_ld(&bar[XB_XCNT(j)]); sum += c; cnt += (c > 0u) ? 1u : 0u; mine = (j == x) ? c : mine; }
        if (sum == G) break;
        __builtin_amdgcn_s_sleep(1);
        if ((++sp & 255u) == 0u) { if (xb_ld(&bar[XB_TMO])) break; if (sp > XB_SPIN_CAP) { atomicAdd(&bar[XB_TMO], 1u); break; } }
    }
    nloc = mine > 0u ? mine : 1u; nx = cnt > 0u ? cnt : 1u;
}
__device__ __forceinline__ int lane_id();
__device__ __forceinline__ void xcd_barrier(const XcdBarrier& b, const int wave) {
    asm volatile("s_waitcnt vmcnt(0)" ::: "memory");
    __syncthreads();
    if (wave == 0 && lane_id() == 0) {
        unsigned* bar = b.bar;
        __builtin_amdgcn_s_waitcnt(0);
        unsigned nloc = b.st[0], nx = b.st[1];
        if (nloc == 0u) { xcd_barrier_complete(bar, b.x, nloc, nx); b.st[0] = nloc; b.st[1] = nx; }
        const unsigned old = xb_add(&bar[XB_XSUB(b.x)], 1u);
        const unsigned gen = old / nloc;
        if (old + 1u == (gen + 1u) * nloc) {
            __builtin_amdgcn_fence(__ATOMIC_RELEASE, "agent");
            asm volatile("s_waitcnt vmcnt(0)" ::: "memory");
            const unsigned og = xb_add(&bar[XB_TOP], 1u);
            const unsigned tg = og / nx;
            if (og + 1u == (tg + 1u) * nx) xb_add(&bar[XB_TOPGEN], 1u);
            else XB_SPIN(xb_ld(&bar[XB_TOPGEN]) == tg, bar);
            __builtin_amdgcn_fence(__ATOMIC_ACQUIRE, "agent");
            xb_add(&bar[XB_XGEN(b.x)], 1u);
            asm volatile("s_waitcnt vmcnt(0)" ::: "memory");
        } else {
            XB_SPIN(xb_ld(&bar[XB_XGEN(b.x)]) == gen, bar);
            __builtin_amdgcn_fence(__ATOMIC_ACQUIRE, "agent");
            asm volatile("s_waitcnt vmcnt(0)" ::: "memory");
        }
    }
    __syncthreads();
}

namespace pg8 {
constexpr int BM = 256, BK = 64, HALF = 128, HTB = HALF * BK * 2, STAGE_BYTES = 8 * HTB, NXCD = 8, WGM = 4;
__host__ __device__ __forceinline__ int lds_byte(int r, int c) { const int st = (r >> 4) * 2 + (c >> 5), rr = r & 15, cc = c & 31, ob = rr * 64 + cc * 2; return st * 1024 + (ob ^ (((ob >> 9) & 1) << 5)); }
__host__ __device__ __forceinline__ void stage_rc(int b, int& R, int& C) { const int st = b / 1024, sb = b % 1024, swz = sb ^ (((sb >> 9) & 1) << 5); R = (st >> 1) * 16 + swz / 64; C = (st & 1) * 32 + (swz % 64) / 2; }
__host__ __device__ __forceinline__ int perm32(int rho) { const int n = rho >> 4, i = rho & 15; return 8 * (i >> 2) + 4 * n + (i & 3); }

struct Unit { int pm, pn, aux; const char* A; const char* B; const char* A2; };
__device__ __forceinline__ const char* uni(const char* p) {
    const unsigned long long v = (unsigned long long)p; const unsigned lo = __builtin_amdgcn_readfirstlane((unsigned)v), hi = __builtin_amdgcn_readfirstlane((unsigned)(v >> 32));
    return (const char*)(((unsigned long long)hi << 32) | lo);
}

__device__ __forceinline__ bool tile_of(int L, int nM, int nN, int& pm, int& pn) {
    const int nwg = nM * nN; if (L >= nwg) return false;
    int wgid = L; { const int q = nwg / NXCD, r = nwg % NXCD, xcd = wgid % NXCD, off = wgid / NXCD; wgid = (xcd < r ? xcd * (q + 1) : r * (q + 1) + (xcd - r) * q) + off; }
    const int nig = WGM * nN, gid = wgid / nig, fm = gid * WGM, gsz = (nM - fm) < WGM ? (nM - fm) : WGM;
    pm = fm + ((wgid % nig) % gsz); pn = (wgid % nig) / gsz; return true;
}

template <class Epi, class Sched, bool ALIGN_EPI, bool SP2, bool FP8 = false, int SCALE_B = 0x7f7f7f7f>
__device__ __forceinline__ void gemm_phase(LAS unsigned char* lds, const int KB  , const Sched& S, const Epi& E, const int wid  ) {
    const int lane = lane_id(), tid = wid * 64 + lane, wr = wid >> 2, wc = wid & 3, fr = lane & 15, fq = lane >> 4;
    const int nt = KB / (BK * 2);
    unsigned voffA[2][2], voffB[2];
#pragma unroll
    for (int i = 0; i < 2; ++i) { int R, C; stage_rc(tid * 16 + i * 8192, R, C);
        voffB[i] = (unsigned)(Epi::browmap(R) * KB + C * 2);
#pragma unroll
        for (int h = 0; h < 2; ++h) voffA[h][i] = S.aoff(R + HALF * h, C); }
    const size_t kstep = (size_t)(BK * 2);
    const size_t hstepB = (size_t)Epi::BHSTEP_ROWS * KB;
    const unsigned ldsw = (unsigned)wid * 1024u;
    const int aoff = lds_byte(wr * 64 + fr, fq * 8), boff = lds_byte(wc * 32 + fr, fq * 8);
#define PG8_SA(b, h) (((b) * 2 + (h)) * HTB)
#define PG8_SB(b, h) ((4 + (b) * 2 + (h)) * HTB)
#define PG8_STAGE_A(bufoff, gbase, h) do { _Pragma("unroll") for (int _i = 0; _i < 2; ++_i) { unsigned vo_ = voffA[h][_i]; asm volatile("" : "+v"(vo_)); \
        __builtin_amdgcn_global_load_lds((const unsigned*)((const char*)(gbase) + vo_), (LAS unsigned*)(lds + (bufoff) + ldsw + _i * 8192), 16, 0, 0); } } while (0)
#define PG8_STAGE_B(bufoff, gbase) do { _Pragma("unroll") for (int _i = 0; _i < 2; ++_i) { unsigned vo_ = voffB[_i]; asm volatile("" : "+v"(vo_)); \
        __builtin_amdgcn_global_load_lds((const unsigned*)((const char*)(gbase) + vo_), (LAS unsigned*)(lds + (bufoff) + ldsw + _i * 8192), 16, 0, 0); } } while (0)
#define PG8_LD8(p) __builtin_shufflevector(*(const LAS i32x4*)(p), *(const LAS i32x4*)((p) + 1024), 0, 1, 2, 3, 4, 5, 6, 7)
#define PG8_LDA(dst, b, h) do { _Pragma("unroll") for (int m = 0; m < 4; ++m) { if constexpr (FP8) { dst##8[m] = PG8_LD8(lds + PG8_SA(b, h) + aoff + m * 2048); } else { _Pragma("unroll") for (int k = 0; k < 2; ++k) dst[m][k] = *(const LAS bf16x8*)(lds + PG8_SA(b, h) + aoff + m * 2048 + k * 1024); } } } while (0)
#define PG8_LDB(dst, b, h) do { _Pragma("unroll") for (int n = 0; n < 2; ++n) { if constexpr (FP8) { dst##8[n] = PG8_LD8(lds + PG8_SB(b, h) + boff + n * 2048); } else { _Pragma("unroll") for (int k = 0; k < 2; ++k) dst[n][k] = *(const LAS bf16x8*)(lds + PG8_SB(b, h) + boff + n * 2048 + k * 1024); } } } while (0)
#define PG8_MMA(ai, bj, At, Bt) do { if constexpr (FP8) __builtin_amdgcn_sched_barrier(0); __builtin_amdgcn_s_setprio(1); _Pragma("unroll") for (int m = 0; m < 4; ++m) _Pragma("unroll") for (int n = 0; n < 2; ++n) { \
        if constexpr (FP8) { acc[ai][bj][m][n] = __builtin_amdgcn_mfma_scale_f32_16x16x128_f8f6f4(Bt##8[n], At##8[m], acc[ai][bj][m][n], 0, 0, 0, SCALE_B, 0, 0x7f7f7f7f); } \
        else { _Pragma("unroll") for (int k = 0; k < 2; ++k) acc[ai][bj][m][n] = __builtin_amdgcn_mfma_f32_16x16x32_bf16(Bt[n][k], At[m][k], acc[ai][bj][m][n], 0, 0, 0); } } \
        __builtin_amdgcn_s_setprio(0); if constexpr (FP8) __builtin_amdgcn_sched_barrier(0); } while (0)
#define PG8_WAIT_V(n) asm volatile("s_waitcnt vmcnt(" #n ")" ::: "memory")
#define PG8_WAIT_L(n) asm volatile("s_waitcnt lgkmcnt(" #n ")" ::: "memory")
#define PG8_BAR __builtin_amdgcn_s_barrier()
#define PG8_SCHED __builtin_amdgcn_sched_barrier(0)
    Unit cur, nxt; int ui = 0;
    if (!S.next(0, cur)) return;
    f32x4 acc[2][2][4][2];
#pragma unroll
    for (int a = 0; a < 2; ++a)
#pragma unroll
        for (int b = 0; b < 2; ++b)
#pragma unroll
            for (int m = 0; m < 4; ++m)
#pragma unroll
                for (int n = 0; n < 2; ++n) acc[a][b][m][n] = (f32x4){0.f, 0.f, 0.f, 0.f};
    bf16x8 At[4][2], B0[2][2], B1[2][2]; i32x8 At8[4], B08[2], B18[2];
    const char* cA = uni(cur.A); const char* cB = uni(cur.B); const char* cA2 = uni(cur.A2);
    if constexpr (SP2) {
        PG8_STAGE_B(PG8_SB(0, 0), cB); PG8_STAGE_B(PG8_SB(0, 1), cB + hstepB); PG8_STAGE_A(PG8_SA(0, 0), cA, 0); PG8_STAGE_A(PG8_SA(0, 1), cA, 1);
        if (wr == 1) PG8_BAR;
        PG8_WAIT_V(2); PG8_BAR;
        PG8_STAGE_B(PG8_SB(1, 0), cB + kstep); PG8_STAGE_A(PG8_SA(1, 0), cA + kstep, 0); PG8_STAGE_B(PG8_SB(1, 1), cB + hstepB + kstep);
        PG8_WAIT_V(6); PG8_BAR;
    } else {
        PG8_STAGE_B(PG8_SB(0, 0), cB); PG8_STAGE_A(PG8_SA(0, 0), cA, 0); PG8_STAGE_B(PG8_SB(0, 1), cB + hstepB); PG8_STAGE_A(PG8_SA(0, 1), cA, 1);
        if (wr == 1) PG8_BAR;
        PG8_WAIT_V(4); PG8_BAR;
        PG8_STAGE_B(PG8_SB(1, 0), cB + kstep); PG8_STAGE_A(PG8_SA(1, 0), cA + kstep, 0); PG8_STAGE_B(PG8_SB(1, 1), cB + hstepB + kstep);
        PG8_WAIT_V(6); PG8_BAR;
    }
    for (;;) {
        const bool has_next = S.next(ui + 1, nxt);
        const char* nA = uni(has_next ? nxt.A : cA); const char* nB = uni(has_next ? nxt.B : cB);
#pragma nounroll
        for (int t = 0; t < nt; t += 2) {
            const bool last = (t == nt - 2);
            const char* a1 = ((Sched::TSW && t + 1 >= Sched::TSW) ? cA2 : cA) + (size_t)(t + 1) * kstep;
            const char* a2 = last ? nA : ((Sched::TSW && t + 2 >= Sched::TSW) ? cA2 : cA) + (size_t)(t + 2) * kstep; const char* b2 = last ? nB : cB + (size_t)(t + 2) * kstep;
            const char* a3 = a2 + kstep; const char* b3 = b2 + kstep;
            if constexpr (Sched::TSW != 0) { if (t == Sched::TSW) { const int l2 = lane_id(); E.mid(acc, cur, wr, wc, l2 & 15, l2 >> 4); } }
            if constexpr (SP2) {
            PG8_LDB(B0, 0, 0); PG8_LDB(B1, 0, 1); PG8_SCHED; PG8_LDA(At, 0, 0); PG8_STAGE_A(PG8_SA(1, 1), a1, 1);
            PG8_WAIT_V(8); PG8_WAIT_L(0); PG8_BAR; PG8_MMA(0, 0, At, B0); PG8_MMA(0, 1, At, B1); PG8_BAR; PG8_SCHED;
            PG8_LDA(At, 0, 1); PG8_STAGE_B(PG8_SB(0, 0), b2); PG8_STAGE_B(PG8_SB(0, 1), b2 + hstepB); PG8_STAGE_A(PG8_SA(0, 0), a2, 0);
            PG8_WAIT_V(8); PG8_WAIT_L(0); PG8_BAR; PG8_MMA(1, 0, At, B0); PG8_MMA(1, 1, At, B1); PG8_BAR; PG8_SCHED;
            PG8_LDB(B0, 1, 0); PG8_LDB(B1, 1, 1); PG8_SCHED; PG8_LDA(At, 1, 0); PG8_STAGE_A(PG8_SA(0, 1), a2, 1);
            PG8_WAIT_V(8); PG8_WAIT_L(0); PG8_BAR; PG8_MMA(0, 0, At, B0); PG8_MMA(0, 1, At, B1); PG8_BAR; PG8_SCHED;
            PG8_LDA(At, 1, 1); PG8_STAGE_B(PG8_SB(1, 0), b3); PG8_STAGE_B(PG8_SB(1, 1), b3 + hstepB); PG8_STAGE_A(PG8_SA(1, 0), a3, 0);
            PG8_WAIT_V(8); PG8_WAIT_L(0); PG8_BAR; PG8_MMA(1, 0, At, B0); PG8_MMA(1, 1, At, B1); PG8_BAR; PG8_SCHED;
            } else {
            PG8_LDB(B0, 0, 0); PG8_SCHED; PG8_LDA(At, 0, 0); PG8_STAGE_A(PG8_SA(1, 1), a1, 1);
            PG8_WAIT_L(8); PG8_BAR; PG8_WAIT_L(0); PG8_MMA(0, 0, At, B0); PG8_BAR; PG8_SCHED;
            PG8_LDB(B1, 0, 1); PG8_STAGE_B(PG8_SB(0, 0), b2);
            PG8_BAR; PG8_WAIT_L(0); PG8_MMA(0, 1, At, B1); PG8_BAR;
            PG8_LDA(At, 0, 1); PG8_STAGE_A(PG8_SA(0, 0), a2, 0);
            PG8_BAR; PG8_WAIT_L(0); PG8_MMA(1, 0, At, B0); PG8_BAR; PG8_SCHED;
            PG8_STAGE_B(PG8_SB(0, 1), b2 + hstepB);
            PG8_WAIT_V(6); PG8_BAR; PG8_MMA(1, 1, At, B1); PG8_BAR;
            PG8_LDB(B0, 1, 0); PG8_SCHED; PG8_LDA(At, 1, 0); PG8_STAGE_A(PG8_SA(0, 1), a2, 1);
            PG8_WAIT_L(8); PG8_BAR; PG8_WAIT_L(0); PG8_MMA(0, 0, At, B0); PG8_BAR; PG8_SCHED;
            PG8_LDB(B1, 1, 1); PG8_STAGE_B(PG8_SB(1, 0), b3);
            PG8_BAR; PG8_WAIT_L(0); PG8_MMA(0, 1, At, B1); PG8_BAR;
            PG8_LDA(At, 1, 1); PG8_STAGE_A(PG8_SA(1, 0), a3, 0);
            PG8_BAR; PG8_WAIT_L(0); PG8_MMA(1, 0, At, B0); PG8_BAR; PG8_SCHED;
            PG8_STAGE_B(PG8_SB(1, 1), b3 + hstepB);
            PG8_WAIT_V(6); PG8_BAR; PG8_MMA(1, 1, At, B1); PG8_BAR;
            }
        }
        if constexpr (ALIGN_EPI) { if (wr == 0) PG8_BAR; }
        { const int l2 = lane_id(); E(acc, cur, wr, wc, l2 & 15, l2 >> 4, wid, l2); }
        if (!has_next) break;
#pragma unroll
        for (int a = 0; a < 2; ++a)
#pragma unroll
            for (int b = 0; b < 2; ++b)
#pragma unroll
                for (int m = 0; m < 4; ++m)
#pragma unroll
                    for (int n = 0; n < 2; ++n) acc[a][b][m][n] = (f32x4){0.f, 0.f, 0.f, 0.f};
        cur = nxt; cA = nA; cB = nB; cA2 = uni(cur.A2); ++ui;
        if constexpr (ALIGN_EPI) { if (wr == 1) PG8_BAR; }
    }
    PG8_WAIT_V(0);
    if constexpr (!ALIGN_EPI) { if (wr == 0) PG8_BAR; }
    PG8_BAR;
#undef PG8_SA
#undef PG8_SB
#undef PG8_STAGE_A
#undef PG8_STAGE_B
#undef PG8_LDA
#undef PG8_LDB
#undef PG8_MMA
#undef PG8_LD8
#undef PG8_WAIT_V
#undef PG8_WAIT_L
#undef PG8_BAR
#undef PG8_SCHED
}

struct DenseOrder {
    static constexpr int TSW = 0;
    const char* A; const char* Bt; int arow, brow, nM, nN, G, c;
    __device__ __forceinline__ unsigned aoff(int row, int C) const { return (unsigned)(row * arow + C * 2); }
    __device__ __forceinline__ bool next(int i, Unit& u) const {
        int pm, pn; if (!tile_of(i * G + c, nM, nN, pm, pn)) return false;
        u.pm = pm; u.pn = pn; u.aux = 0; u.A = A + (size_t)pm * BM * arow; u.A2 = u.A; u.B = Bt + (size_t)pn * BM * brow; return true;
    }
};
struct BranchOrder {
    static constexpr int TSW = 16;
    const char* A0; const char* A1; const char* Bt; int G, c;
    __device__ __forceinline__ unsigned aoff(int row, int C) const { return (unsigned)(row * DM + C) * 2u; }
    __device__ __forceinline__ bool next(int i, Unit& u) const {
        int pm, pn; if (!tile_of(i * G + c, MTOK / BM, DM / BM, pm, pn)) return false;
        u.pm = pm; u.pn = pn; u.aux = 0; u.A = A0 + (size_t)pm * BM * DM * 2; u.A2 = A1 + (size_t)pm * BM * DM * 2 - TSW * 128; u.B = Bt + (size_t)pn * BM * (2 * DM) * 2; return true;
    }
};
struct MoeUpOrder {
    static constexpr int TSW = 0;
    const char* hn; const char* wgu; const int* idx; int b, e, pair; bool valid;
    __device__ __forceinline__ unsigned aoff(int row, int C) const { const int tok = valid ? idx[pair * CAP + row] : 0; return (unsigned)((b * SEQ + tok) * DM + C * 2); }
    __device__ __forceinline__ bool next(int i, Unit& u) const {
        if (!valid || i >= 16) return false;
        u.pm = pair; u.pn = i; u.aux = 0; u.A = hn; u.A2 = hn; u.B = wgu + (size_t)((e * 16 + i) * 256) * DM; return true;
    }
};
struct MoeDownOrder {
    static constexpr int TSW = 0;
    const char* hg; const char* wdn; int c; bool valid;
    __device__ __forceinline__ unsigned aoff(int row, int C) const { return (unsigned)(row * FFE + C * 2); }
    __device__ __forceinline__ bool next(int i, Unit& u) const {
        if (!valid || i >= 4) return false;
        const int x = c & 7, j = c >> 3, nt = j & 3, q = i * 8 + (j >> 2), e = 2 * x + (q >> 4), b = q & 15, pair = b * NE + e;
        u.pm = pair; u.pn = nt; u.aux = i; u.A = hg + (size_t)pair * CAP * FFE; u.A2 = u.A; u.B = wdn + (size_t)(e * DM + nt * BM) * FFE; return true;
    }
};

struct EpiProj {
    static constexpr int BHSTEP_ROWS = 32;
    __host__ __device__ static __forceinline__ int browmap(int R) { return 64 * (R >> 5) + perm32(R & 31); }
    bf16_t *q, *k, *v, *xl, *gy; const LAS float* gl;
    __device__ __forceinline__ void operator()(const f32x4 (&acc)[2][2][4][2], const Unit& u, int wr, int wc, int fr, int fq, int wid, int lane) const {
        const int type = u.pn >> 2;
        const int row0 = u.pm * BM + wr * 64 + fr, col0 = (u.pn & 3) * 256 + 64 * wc + 8 * fq;
        bf16_t* dst = type == 0 ? q : type == 1 ? k : type == 2 ? v : type == 3 ? xl : gy;
        if (type < 2) {
            const LAS float* g = gl + type * 64;
            f32x4 gv[2][2];
#pragma unroll
            for (int bj = 0; bj < 2; ++bj)
#pragma unroll
                for (int n = 0; n < 2; ++n) gv[bj][n] = *(const LAS f32x4*)(g + 32 * bj + 8 * fq + 4 * n);
#pragma unroll
            for (int ai = 0; ai < 2; ++ai)
#pragma unroll
                for (int m = 0; m < 4; ++m) {
                    float ss = 0.f;
#pragma unroll
                    for (int bj = 0; bj < 2; ++bj)
#pragma unroll
                        for (int n = 0; n < 2; ++n) { const f32x4 x = acc[ai][bj][m][n]; ss += (x[0] * x[0] + x[1] * x[1]) + (x[2] * x[2] + x[3] * x[3]); }
                    { auto r16 = __builtin_amdgcn_permlane16_swap(__float_as_uint(ss), __float_as_uint(ss), false, false); ss = __uint_as_float(r16[0]) + __uint_as_float(r16[1]);
                      auto r32 = __builtin_amdgcn_permlane32_swap(__float_as_uint(ss), __float_as_uint(ss), false, false); ss = __uint_as_float(r32[0]) + __uint_as_float(r32[1]); }
                    const float rs = __builtin_amdgcn_rsqf(ss * (1.0f / 64.0f) + EPS) * (type == 0 ? 0.125f * LOG2E : 1.0f);
                    bf16_t* rowp = dst + (size_t)(row0 + ai * HALF + m * 16) * DM + col0;
#pragma unroll
                    for (int bj = 0; bj < 2; ++bj) { const f32x4 v0 = acc[ai][bj][m][0] * rs * gv[bj][0], v1 = acc[ai][bj][m][1] * rs * gv[bj][1];
                        u32x4 w; w.x = cvt_pk_bf16(v0[0], v0[1]); w.y = cvt_pk_bf16(v0[2], v0[3]); w.z = cvt_pk_bf16(v1[0], v1[1]); w.w = cvt_pk_bf16(v1[2], v1[3]);
                        __builtin_nontemporal_store(w, (u32x4*)(rowp + 32 * bj)); }
                }
        } else {
#pragma unroll
            for (int ai = 0; ai < 2; ++ai)
#pragma unroll
                for (int m = 0; m < 4; ++m) { bf16_t* rowp = dst + (size_t)(row0 + ai * HALF + m * 16) * DM + col0;
#pragma unroll
                    for (int bj = 0; bj < 2; ++bj) { f32x4 v0 = acc[ai][bj][m][0], v1 = acc[ai][bj][m][1];
                        if (type == 4) {
#pragma unroll
                            for (int j = 0; j < 4; ++j) { v0[j] = gelu_tanh(v0[j]); v1[j] = gelu_tanh(v1[j]); }
                        }
                        u32x4 w; w.x = cvt_pk_bf16(v0[0], v0[1]); w.y = cvt_pk_bf16(v0[2], v0[3]); w.z = cvt_pk_bf16(v1[0], v1[1]); w.w = cvt_pk_bf16(v1[2], v1[3]);
                        __builtin_nontemporal_store(w, (u32x4*)(rowp + 32 * bj)); } }
        }
    }
};
struct WideMap { static constexpr int BHSTEP_ROWS = 8; __host__ __device__ static __forceinline__ int browmap(int R) { return 64 * (R >> 5) + 16 * ((R >> 2) & 3) + 4 * ((R >> 4) & 1) + (R & 3); } };
struct EpiGate : WideMap {
    unsigned char *sa, *sr; float gsc;
    __device__ __forceinline__ void operator()(const f32x4 (&acc)[2][2][4][2], const Unit& u, int wr, int wc, int fr, int fq, int wid, int lane) const {
        int row0 = u.pm * BM + wr * 64 + fr; asm volatile("" : "+v"(row0));
        const int col0 = (u.pn & 3) * 256 + 64 * wc + 16 * fq;
        unsigned char* d8 = (u.pn >> 2) == 0 ? sa : sr;
        const float ke = -LOG2E * gsc;
#pragma unroll
        for (int ai = 0; ai < 2; ++ai)
#pragma unroll
            for (int m = 0; m < 4; ++m) { unsigned char* rowp = d8 + (unsigned)((row0 + ai * HALF + m * 16) * DM + col0);
                unsigned wd[4];
#pragma unroll
                for (int bj = 0; bj < 2; ++bj)
#pragma unroll
                    for (int n = 0; n < 2; ++n) { unsigned b[4];
#pragma unroll
                        for (int j = 0; j < 4; ++j) b[j] = (unsigned)(__builtin_amdgcn_rcpf(GATE_QI + __builtin_amdgcn_exp2f(acc[ai][bj][m][n][j] * ke + GATE_QL)));
                        wd[2 * bj + n] = (b[0] | (b[1] << 8)) | ((b[2] | (b[3] << 8)) << 16); }
                __builtin_nontemporal_store((u32x4){wd[0], wd[1], wd[2], wd[3]}, (u32x4*)rowp); }
    }
};
struct EpiNull { static constexpr int BHSTEP_ROWS = 32; __host__ __device__ static __forceinline__ int browmap(int R) { return 64 * (R >> 5) + perm32(R & 31); }
    float* sink;
    __device__ __forceinline__ void operator()(const f32x4 (&acc)[2][2][4][2], const Unit& u, int wr, int wc, int fr, int fq, int wid, int lane) const {
        float s = 0.f;
#pragma unroll
        for (int ai = 0; ai < 2; ++ai)
#pragma unroll
            for (int bj = 0; bj < 2; ++bj)
#pragma unroll
                for (int m = 0; m < 4; ++m)
#pragma unroll
                    for (int n = 0; n < 2; ++n) s += acc[ai][bj][m][n][0] + acc[ai][bj][m][n][1] + acc[ai][bj][m][n][2] + acc[ai][bj][m][n][3];
        if (s == 123456.789f) sink[0] = s;
    } };
struct PermMap { static constexpr int BHSTEP_ROWS = 128; __host__ __device__ static __forceinline__ int browmap(int R) { return (R & ~31) + perm32(R & 31); } };
struct PlainMap { static constexpr int BHSTEP_ROWS = 128; __host__ __device__ static __forceinline__ int browmap(int R) { return R; } };

struct EpiBranch : PermMap {
    const unsigned char *sa, *sr; bf16_t* mixed;
#define GB(w, i) ((float)(((w) >> (8 * (i))) & 0xffu) + 0.5f)
    __device__ __forceinline__ void mid(f32x4 (&acc)[2][2][4][2], const Unit& u, int wr, int wc, int fr, int fq) const {
        int row0 = u.pm * BM + wr * 64 + fr; asm volatile("" : "+v"(row0));
        const int col0 = u.pn * BM + wc * 32 + 8 * fq;
        u32x2 ga[2][2], gg[2][2];
#define MID_LOAD(buf, grp) do { const unsigned off_ = (unsigned)((row0 + ((grp) >> 2) * HALF + ((grp) & 3) * 16) * DM + col0); \
            _Pragma("unroll") for (int bj = 0; bj < 2; ++bj) { ga[buf][bj] = *(const u32x2*)(sa + off_ + bj * HALF); gg[buf][bj] = *(const u32x2*)(sr + off_ + bj * HALF); } } while (0)
        MID_LOAD(0, 0);
#pragma unroll
        for (int grp = 0; grp < 8; ++grp) { const int ai = grp >> 2, m = grp & 3, cb = grp & 1;
            if (grp + 1 < 8) MID_LOAD(cb ^ 1, grp + 1);
            __builtin_amdgcn_sched_barrier(0);
#pragma unroll
            for (int bj = 0; bj < 2; ++bj) { const u32x2 a = ga[cb][bj], g = gg[cb][bj];
                f32x4& c0 = acc[ai][bj][m][0]; f32x4& c1 = acc[ai][bj][m][1];
                c0[0] *= GB(a.x, 0) * __builtin_amdgcn_rcpf(GB(g.x, 0)); c0[1] *= GB(a.x, 1) * __builtin_amdgcn_rcpf(GB(g.x, 1)); c0[2] *= GB(a.x, 2) * __builtin_amdgcn_rcpf(GB(g.x, 2)); c0[3] *= GB(a.x, 3) * __builtin_amdgcn_rcpf(GB(g.x, 3));
                c1[0] *= GB(a.y, 0) * __builtin_amdgcn_rcpf(GB(g.y, 0)); c1[1] *= GB(a.y, 1) * __builtin_amdgcn_rcpf(GB(g.y, 1)); c1[2] *= GB(a.y, 2) * __builtin_amdgcn_rcpf(GB(g.y, 2)); c1[3] *= GB(a.y, 3) * __builtin_amdgcn_rcpf(GB(g.y, 3)); }
            __builtin_amdgcn_sched_barrier(0); }
#undef MID_LOAD
    }
    __device__ __forceinline__ void operator()(const f32x4 (&acc)[2][2][4][2], const Unit& u, int wr, int wc, int fr, int fq, int wid, int lane) const {
        int row0 = u.pm * BM + wr * 64 + fr; asm volatile("" : "+v"(row0));
        const int col0 = u.pn * BM + wc * 32 + 8 * fq;
        u32x2 g[2][4][2];
#pragma unroll
        for (int ai = 0; ai < 2; ++ai)
#pragma unroll
            for (int m = 0; m < 4; ++m) { const unsigned off = (unsigned)((row0 + ai * HALF + m * 16) * DM + col0);
#pragma unroll
                for (int bj = 0; bj < 2; ++bj) g[ai][m][bj] = *(const u32x2*)(sr + off + bj * HALF); }
        __builtin_amdgcn_sched_barrier(0);
#pragma unroll
        for (int ai = 0; ai < 2; ++ai)
#pragma unroll
            for (int m = 0; m < 4; ++m) { const unsigned off = (unsigned)((row0 + ai * HALF + m * 16) * DM + col0);
#pragma unroll
                for (int bj = 0; bj < 2; ++bj) { const f32x4 a0 = acc[ai][bj][m][0] * GATE_QI, a1 = acc[ai][bj][m][1] * GATE_QI; const u32x2 gw = g[ai][m][bj];
                    u32x4 w; w.x = cvt_pk_bf16(a0[0] * GB(gw.x, 0), a0[1] * GB(gw.x, 1)); w.y = cvt_pk_bf16(a0[2] * GB(gw.x, 2), a0[3] * GB(gw.x, 3));
                    w.z = cvt_pk_bf16(a1[0] * GB(gw.y, 0), a1[1] * GB(gw.y, 1)); w.w = cvt_pk_bf16(a1[2] * GB(gw.y, 2), a1[3] * GB(gw.y, 3));
                    *(u32x4*)(mixed + off + bj * HALF) = w; } }
    }
#undef GB
};
struct EpiOut : PermMap {
    const float* x; bf16_t* h16;
    __device__ __forceinline__ void operator()(const f32x4 (&acc)[2][2][4][2], const Unit& u, int wr, int wc, int fr, int fq, int wid, int lane) const {
        int row0 = u.pm * BM + wr * 64 + fr; asm volatile("" : "+v"(row0));
        const int col0 = u.pn * BM + wc * 32 + 8 * fq;
#pragma unroll
        for (int ai = 0; ai < 2; ++ai) {
            f32x4 xv[4][2][2];
#pragma unroll
            for (int m = 0; m < 4; ++m) { const unsigned off = (unsigned)((row0 + ai * HALF + m * 16) * DM + col0);
#pragma unroll
                for (int bj = 0; bj < 2; ++bj) { xv[m][bj][0] = __builtin_nontemporal_load((const f32x4*)(x + off + bj * HALF)); xv[m][bj][1] = __builtin_nontemporal_load((const f32x4*)(x + off + bj * HALF + 4)); } }
            __builtin_amdgcn_sched_barrier(0);
#pragma unroll
            for (int m = 0; m < 4; ++m) { const unsigned off = (unsigned)((row0 + ai * HALF + m * 16) * DM + col0);
#pragma unroll
                for (int bj = 0; bj < 2; ++bj) { const f32x4 v0 = xv[m][bj][0] + acc[ai][bj][m][0], v1 = xv[m][bj][1] + acc[ai][bj][m][1];
                    u32x4 w; w.x = cvt_pk_bf16(v0[0], v0[1]); w.y = cvt_pk_bf16(v0[2], v0[3]); w.z = cvt_pk_bf16(v1[0], v1[1]); w.w = cvt_pk_bf16(v1[2], v1[3]);
                    *(u32x4*)(h16 + off + bj * HALF) = w; } }
            __builtin_amdgcn_sched_barrier(0);
        }
    }
};
struct EpiMoeUp : PermMap {
    unsigned char* hg; const LAS float* rsl;
    __device__ __forceinline__ void operator()(const f32x4 (&acc)[2][2][4][2], const Unit& u, int wr, int wc, int fr, int fq, int wid, int lane) const {
        int row0 = wr * 64 + fr; asm volatile("" : "+v"(row0));
        const int col0 = u.pn * 128 + wc * 32 + 8 * fq;
        unsigned char* base = hg + (size_t)u.pm * CAP * FFE;
        float scv[2][4];
#pragma unroll
        for (int ai = 0; ai < 2; ++ai)
#pragma unroll
            for (int m = 0; m < 4; ++m) scv[ai][m] = rsl[row0 + ai * HALF + m * 16];
#pragma unroll
        for (int ai = 0; ai < 2; ++ai)
#pragma unroll
            for (int m = 0; m < 4; ++m) { float r[8]; const float sc = scv[ai][m], sc2 = sc * sc, ke = -LOG2E * sc;
#pragma unroll
                for (int n = 0; n < 2; ++n)
#pragma unroll
                    for (int j = 0; j < 4; ++j) { const float ga = acc[ai][0][m][n][j]; r[4 * n + j] = (ga * acc[ai][1][m][n][j]) * (sc2 * __builtin_amdgcn_rcpf(1.0f + __builtin_amdgcn_exp2f(ga * ke))); }
                u32x2 w; w.x = pk4_fp8(r[0], r[1], r[2], r[3]); w.y = pk4_fp8(r[4], r[5], r[6], r[7]);
                *(u32x2*)(base + (unsigned)((row0 + ai * HALF + m * 16) * FFE + col0)) = w; }
    }
};
struct EpiMoeDown : WideMap {
    unsigned char* ye; const LAS float* vall;
    __device__ __forceinline__ void operator()(const f32x4 (&acc)[2][2][4][2], const Unit& u, int wr, int wc, int fr, int fq, int wid, int lane) const {
        int row0 = wr * 64 + fr; asm volatile("" : "+v"(row0));
        const int col0 = u.pn * BM + wc * 64 + 16 * fq;
        unsigned char* base = ye + (size_t)u.pm * CAP * DM;
        float vsv[2][4];
#pragma unroll
        for (int ai = 0; ai < 2; ++ai)
#pragma unroll
            for (int m = 0; m < 4; ++m) vsv[ai][m] = vall[u.aux * CAP + row0 + ai * HALF + m * 16];
#pragma unroll
        for (int ai = 0; ai < 2; ++ai)
#pragma unroll
            for (int m = 0; m < 4; ++m) { const int row = row0 + ai * HALF + m * 16; const float vs = vsv[ai][m];
                const f32x4 v0 = acc[ai][0][m][0] * vs, v1 = acc[ai][0][m][1] * vs, v2 = acc[ai][1][m][0] * vs, v3 = acc[ai][1][m][1] * vs;
                u32x4 w; w.x = pk4_fp8(v0[0], v0[1], v0[2], v0[3]); w.y = pk4_fp8(v1[0], v1[1], v1[2], v1[3]); w.z = pk4_fp8(v2[0], v2[1], v2[2], v2[3]); w.w = pk4_fp8(v3[0], v3[1], v3[2], v3[3]);
                *(u32x4*)(base + (unsigned)(row * DM + col0)) = w; }
    }
};
}

namespace att {
constexpr int KVBLK = 64, LD = DM;
constexpr int SHM_V = KVBLK * 128 * 2, SHM_K = KVBLK * 128 * 2;
constexpr int NBUF = 4, BUFB = SHM_V + SHM_K;
constexpr int TB_OFF = NBUF * BUFB;
constexpr int E_STRIDE = 132, E_BYTES = 128 * E_STRIDE * 4;
constexpr int LI_OFF = 2 * E_BYTES;
#define KSWZ(row, colB) ((row) * 256 + ((colB) ^ (((row) & 7) << 4)))
#define SBAR() __builtin_amdgcn_sched_barrier(0)
__device__ __forceinline__ int crow(int r, int hi) { return (r & 3) + 8 * (r >> 2) + 4 * hi; }
__device__ __forceinline__ int v_st(int k, int c) { const int kk = (k & ~0xC) | ((k & 4) << 1) | ((k & 8) >> 1); return ((kk >> 3) * 4 + (c >> 5)) * 512 + ((kk & 7) * 32 + (c & 31)) * 2; }
__device__ __forceinline__ int v_rd_base(int lane) { return ((lane & 3) << 3) | (((lane >> 2) & 3) << 6) | (((lane >> 4) & 1) << 5) | (((lane >> 5) & 1) << 8); }
constexpr int v_rd_off(int d0, int ks, int half) { return d0 * 512 + ks * 4096 + half * 2048; }
typedef short v4i16_t __attribute__((ext_vector_type(4)));
__device__ __forceinline__ s16x4 vtr(const LAS char* p) { return __builtin_bit_cast(s16x4, __builtin_amdgcn_ds_read_tr16_b64_v4i16((LAS v4i16_t*)p)); }
template <int OFF> __device__ __forceinline__ s16x4 tr_read(int vb) {
    s16x4 r; asm volatile("ds_read_b64_tr_b16 %0, %1 offset:%2" : "=&v"(r) : "v"(vb), "i"(OFF) : "memory"); return r;
}
template <int OFF> __device__ __forceinline__ bf16x8 lds_read128(int a) {
    bf16x8 r; asm volatile("ds_read_b128 %0, %1 offset:%2" : "=&v"(r) : "v"(a), "i"(OFF) : "memory"); return r;
}
template <int D0> __device__ __forceinline__ void pv_one(f32x16& od, int vb, bf16x8 pa0, bf16x8 pa1, bf16x8 pa2, bf16x8 pa3) {
    const s16x4 l0 = tr_read<v_rd_off(D0, 0, 0)>(vb), h0 = tr_read<v_rd_off(D0, 0, 1)>(vb), l1 = tr_read<v_rd_off(D0, 1, 0)>(vb), h1 = tr_read<v_rd_off(D0, 1, 1)>(vb);
    const s16x4 l2 = tr_read<v_rd_off(D0, 2, 0)>(vb), h2 = tr_read<v_rd_off(D0, 2, 1)>(vb), l3 = tr_read<v_rd_off(D0, 3, 0)>(vb), h3 = tr_read<v_rd_off(D0, 3, 1)>(vb);
    asm volatile("s_waitcnt lgkmcnt(0)" ::: "memory"); SBAR();
#define PK(L, H) (bf16x8){L[0], L[1], L[2], L[3], H[0], H[1], H[2], H[3]}
    od = __builtin_amdgcn_mfma_f32_32x32x16_bf16(pa0, PK(l0, h0), od, 0, 0, 0);
    od = __builtin_amdgcn_mfma_f32_32x32x16_bf16(pa1, PK(l1, h1), od, 0, 0, 0);
    od = __builtin_amdgcn_mfma_f32_32x32x16_bf16(pa2, PK(l2, h2), od, 0, 0, 0);
    od = __builtin_amdgcn_mfma_f32_32x32x16_bf16(pa3, PK(l3, h3), od, 0, 0, 0);
#undef PK
}
__device__ __forceinline__ void pv_d0(f32x16* o, int vb, bf16x8 pa0, bf16x8 pa1, bf16x8 pa2, bf16x8 pa3) {
    pv_one<0>(o[0], vb, pa0, pa1, pa2, pa3); pv_one<1>(o[1], vb, pa0, pa1, pa2, pa3); pv_one<2>(o[2], vb, pa0, pa1, pa2, pa3); pv_one<3>(o[3], vb, pa0, pa1, pa2, pa3);
}
template <int VAR = 0> __device__ __forceinline__ void qkt(f32x16& p0, f32x16& p1, const char* Ks, const bf16x8* qr, int r32, int hi, int mm, const float* Tb, int drel, const f32x16& cvec) {
    if constexpr (VAR == 3) { p0 = cvec; p1 = cvec; return; }
    const bool far = (drel >= 122 || drel <= -154);
    if (!far) {
        const float* tb = Tb + (drel + 256 - r32 + 4 * hi);
#pragma unroll
        for (int r = 0; r < 16; ++r) { const int o = (r & 3) + 8 * (r >> 2); p0[r] = tb[o]; p1[r] = tb[o + 32]; }
    }
    { const int cb = (mm * 64 + hi * 8) * 2;
      const bf16x8 b0 = *reinterpret_cast<const bf16x8*>(Ks + KSWZ(r32, cb));
      const bf16x8 b1 = *reinterpret_cast<const bf16x8*>(Ks + KSWZ(32 + r32, cb));
      if (far) { p0 = __builtin_amdgcn_mfma_f32_32x32x16_bf16(b0, qr[0], cvec, 0, 0, 0); p1 = __builtin_amdgcn_mfma_f32_32x32x16_bf16(b1, qr[0], cvec, 0, 0, 0); }
      else     { p0 = __builtin_amdgcn_mfma_f32_32x32x16_bf16(b0, qr[0], p0, 0, 0, 0);   p1 = __builtin_amdgcn_mfma_f32_32x32x16_bf16(b1, qr[0], p1, 0, 0, 0); } }
#pragma unroll
    for (int d0 = 1; d0 < 4; ++d0) { const int cb = (mm * 64 + d0 * 16 + hi * 8) * 2;
        const bf16x8 b0 = *reinterpret_cast<const bf16x8*>(Ks + KSWZ(r32, cb));
        const bf16x8 b1 = *reinterpret_cast<const bf16x8*>(Ks + KSWZ(32 + r32, cb));
        p0 = __builtin_amdgcn_mfma_f32_32x32x16_bf16(b0, qr[d0], p0, 0, 0, 0);
        p1 = __builtin_amdgcn_mfma_f32_32x32x16_bf16(b1, qr[d0], p1, 0, 0, 0); }
}
template <class F> __device__ __forceinline__ void qkt2(f32x16& p0, f32x16& p1, const char* Ks, const bf16x8* qr, int r32, int hi, int mm, const float* Tb, int drel, const f32x16& cvec, F&& gap) {
    const bool far = (drel >= 122 || drel <= -154);
    bf16x8 kf[8];
#pragma unroll
    for (int d0 = 0; d0 < 4; ++d0) { const int cb = (mm * 64 + d0 * 16 + hi * 8) * 2;
        kf[2 * d0] = *reinterpret_cast<const bf16x8*>(Ks + KSWZ(r32, cb)); kf[2 * d0 + 1] = *reinterpret_cast<const bf16x8*>(Ks + KSWZ(32 + r32, cb)); }
    SBAR();
    if (!far) {
        const float* tb = Tb + (drel + 256 - r32 + 4 * hi);
#pragma unroll
        for (int r = 0; r < 16; ++r) { const int o = (r & 3) + 8 * (r >> 2); p0[r] = tb[o]; p1[r] = tb[o + 32]; }
        p0 = __builtin_amdgcn_mfma_f32_32x32x16_bf16(kf[0], qr[0], p0, 0, 0, 0); p1 = __builtin_amdgcn_mfma_f32_32x32x16_bf16(kf[1], qr[0], p1, 0, 0, 0);
    } else { p0 = __builtin_amdgcn_mfma_f32_32x32x16_bf16(kf[0], qr[0], cvec, 0, 0, 0); p1 = __builtin_amdgcn_mfma_f32_32x32x16_bf16(kf[1], qr[0], cvec, 0, 0, 0); }
    gap(0); gap(1); SBAR();
#pragma unroll
    for (int d0 = 1; d0 < 4; ++d0) {
        p0 = __builtin_amdgcn_mfma_f32_32x32x16_bf16(kf[2 * d0], qr[d0], p0, 0, 0, 0); gap(2 * d0); SBAR();
        p1 = __builtin_amdgcn_mfma_f32_32x32x16_bf16(kf[2 * d0 + 1], qr[d0], p1, 0, 0, 0); gap(2 * d0 + 1); SBAR(); }
}
__device__ __forceinline__ void partialSM(f32x16& p0) {
#pragma unroll
    for (int r = 0; r < 16; ++r) p0[r] = __builtin_amdgcn_exp2f(p0[r]);
}
__device__ __forceinline__ void finishSM(f32x16& p0, f32x16& p1, float& l_reg, bf16x8& pa0, bf16x8& pa1, bf16x8& pa2, bf16x8& pa3) {
#pragma unroll
    for (int r = 0; r < 16; ++r) p1[r] = __builtin_amdgcn_exp2f(p1[r]);
    float ps = 0;
#pragma unroll
    for (int r = 0; r < 16; ++r) ps += p0[r];
#pragma unroll
    for (int r = 0; r < 16; ++r) ps += p1[r];
    { auto rr = __builtin_amdgcn_permlane32_swap(__float_as_uint(ps), __float_as_uint(ps), false, false);
      ps = __uint_as_float(rr[0]) + __uint_as_float(rr[1]); }
    l_reg += ps;
#define PK4(P, BASE, OUT) do { unsigned a0 = cvt_pk_bf16(P[BASE + 0], P[BASE + 1]), a1 = cvt_pk_bf16(P[BASE + 2], P[BASE + 3]);   \
    unsigned b0 = cvt_pk_bf16(P[BASE + 4], P[BASE + 5]), b1 = cvt_pk_bf16(P[BASE + 6], P[BASE + 7]);                              \
    auto r0 = __builtin_amdgcn_permlane32_swap(a0, b0, false, false); auto r1 = __builtin_amdgcn_permlane32_swap(a1, b1, false, false); \
    u32x4 w = {r0[0], r1[0], r0[1], r1[1]}; OUT = *reinterpret_cast<bf16x8*>(&w); } while (0)
    PK4(p0, 0, pa0); PK4(p0, 8, pa1); PK4(p1, 0, pa2); PK4(p1, 8, pa3);
#undef PK4
}

constexpr int E2_OFF = 2 * BUFB, E2_STRIDE = 136, E2_BYTES = 128 * E2_STRIDE * 2;
constexpr int LI2_OFF = E2_OFF + 2 * E2_BYTES, TB2_OFF = LI2_OFF + 2048, GS_OFF = TB2_OFF + 2048;
template <int NTL, int VAR = 0> __device__ __forceinline__ void attn_phase(int vcu, int G, const bf16_t* __restrict__ Qb, const bf16_t* __restrict__ Kb, const bf16_t* __restrict__ Vb, bf16_t* __restrict__ Ob,
                                          const float* __restrict__ TbG, const float* __restrict__ gsub, float lam, char* lds, const int wid) {
    const int lane = lane_id(), tid = wid * 64 + lane, r32 = lane & 31, hi = lane >> 5, rg = wid & 3, mm = wid >> 2;
    constexpr int NUNITS = BATCH * NH * 16;
    if (vcu >= NUNITS) return;
    char* V_lds = lds; char* K_lds = lds + SHM_V; float* Tb = (float*)(lds + TB2_OFF); float* GS = (float*)(lds + GS_OFF);
    unsigned offK[2], offV[2];
#pragma unroll
    for (int i = 0; i < 2; ++i) { const int pc = 2 * wid + i;
        { const int row = pc * 4 + (lane >> 4), c = (lane & 15) ^ (row & 7); offK[i] = (unsigned)(row * LD + c * 8) * 2u; }
        { const int sub = pc * 2 + (lane >> 5), kk = (sub >> 2) * 8 + ((lane & 31) >> 2), k = (kk & ~0xC) | ((kk & 4) << 1) | ((kk & 8) >> 1), col = (sub & 3) * 32 + (lane & 3) * 8; offV[i] = (unsigned)(k * LD + col) * 2u; } }
    LAS unsigned char* ldsl_ = (LAS unsigned char*)(unsigned char*)lds;
    const int vb0 = (int)(uintptr_t)V_lds + v_rd_base(lane);
    const LAS char* vbase = (const LAS char*)(LAS unsigned char*)(unsigned char*)V_lds + v_rd_base(lane);
#define DMA(Kh_, Vh_, t, boff) do { if constexpr (VAR == 5) break; const char* kt_ = (Kh_) + (size_t)(t) * (KVBLK * LD * 2); const char* vt_ = (Vh_) + (size_t)(t) * (KVBLK * LD * 2); \
        _Pragma("unroll") for (int i_ = 0; i_ < 2; ++i_) { \
            __builtin_amdgcn_global_load_lds((const unsigned*)(vt_ + offV[i_]), (LAS unsigned*)(ldsl_ + (boff) + (2 * wid + i_) * 1024), 16, 0, 0); \
            __builtin_amdgcn_global_load_lds((const unsigned*)(kt_ + offK[i_]), (LAS unsigned*)(ldsl_ + (boff) + SHM_V + (2 * wid + i_) * 1024), 16, 0, 0); } } while (0)
#define WBAR(N) do { asm volatile("s_waitcnt vmcnt(" #N ") lgkmcnt(0)" ::: "memory"); if constexpr (VAR != 7) __builtin_amdgcn_s_barrier(); asm volatile("" ::: "memory"); } while (0)
#define VRDSET(V, D0, boff) do { if constexpr (VAR == 4) break; _Pragma("unroll") for (int ks_ = 0; ks_ < 4; ++ks_) { V[2 * ks_] = vtr(vbase + (boff) + v_rd_off(D0, ks_, 0)); V[2 * ks_ + 1] = vtr(vbase + (boff) + v_rd_off(D0, ks_, 1)); } } while (0)
#define VFRAG(V, ks) (bf16x8){V[2 * (ks)][0], V[2 * (ks)][1], V[2 * (ks)][2], V[2 * (ks)][3], V[2 * (ks) + 1][0], V[2 * (ks) + 1][1], V[2 * (ks) + 1][2], V[2 * (ks) + 1][3]}
#define PIECE(P, B, q) do { if constexpr (VAR != 1) { P[(B) + 2 * (q)] = __builtin_amdgcn_exp2f(P[(B) + 2 * (q)]); P[(B) + 2 * (q) + 1] = __builtin_amdgcn_exp2f(P[(B) + 2 * (q) + 1]); } \
        ps += P[(B) + 2 * (q)]; ps += P[(B) + 2 * (q) + 1]; cq[q] = cvt_pk_bf16(P[(B) + 2 * (q)], P[(B) + 2 * (q) + 1]); } while (0)
#define PFIN(OUT) do { auto r0_ = __builtin_amdgcn_permlane32_swap(cq[0], cq[2], false, false); auto r1_ = __builtin_amdgcn_permlane32_swap(cq[1], cq[3], false, false); \
        u32x4 w_ = {r0_[0], r1_[0], r0_[1], r1_[1]}; OUT = *reinterpret_cast<bf16x8*>(&w_); } while (0)
#define PVBLOCK(D0, VC, VN, P, B, OUT, boff) do { \
        if ((D0) < 3) VRDSET(VN, (D0) + 1, boff); \
        if constexpr (VAR != 2) o[D0] = __builtin_amdgcn_mfma_f32_32x32x16_bf16(pa0, VFRAG(VC, 0), o[D0], 0, 0, 0); PIECE(P, B, 0); SBAR(); \
        if constexpr (VAR != 2) o[D0] = __builtin_amdgcn_mfma_f32_32x32x16_bf16(pa1, VFRAG(VC, 1), o[D0], 0, 0, 0); PIECE(P, B, 1); SBAR(); \
        if constexpr (VAR != 2) o[D0] = __builtin_amdgcn_mfma_f32_32x32x16_bf16(pa2, VFRAG(VC, 2), o[D0], 0, 0, 0); PIECE(P, B, 2); SBAR(); \
        if constexpr (VAR != 2) o[D0] = __builtin_amdgcn_mfma_f32_32x32x16_bf16(pa3, VFRAG(VC, 3), o[D0], 0, 0, 0); PIECE(P, B, 3); PFIN(OUT); SBAR(); } while (0)
#define LSUM() do { auto rr_ = __builtin_amdgcn_permlane32_swap(__float_as_uint(ps), __float_as_uint(ps), false, false); l_reg += __uint_as_float(rr_[0]) + __uint_as_float(rr_[1]); ps = 0.f; } while (0)
#define UNIT_PTRS(u_, b_, h_, q0_, Kh_, Vh_, Qw_) const int b_ = (u_) >> 7, h_ = ((u_) >> 4) & 7, q0_ = ((u_) & 15) * 128; \
        const char* Kh_ = (const char*)(Kb + (size_t)(b_ * SEQ) * LD + h_ * 128); const char* Vh_ = (const char*)(Vb + (size_t)(b_ * SEQ) * LD + h_ * 128); \
        const bf16_t* Qw_ = Qb + (size_t)(b_ * SEQ + q0_ + rg * 32 + r32) * LD + h_ * 128 + mm * 64 + hi * 8
    constexpr int NT = NTL;
    bf16x8 qr[4]; int htab = -1;
    { UNIT_PTRS(vcu, b0_, h0_, q00_, Kh0_, Vh0_, Qw0_);
      DMA(Kh0_, Vh0_, 0, 0); if (NT > 1) DMA(Kh0_, Vh0_, 1, BUFB);
#pragma unroll
      for (int d0 = 0; d0 < 4; ++d0) qr[d0] = *reinterpret_cast<const bf16x8*>(Qw0_ + d0 * 16);
      if (tid < 128) GS[tid] = gsub[tid]; }
    for (int u = vcu; u < NUNITS; u += G) {
        UNIT_PTRS(u, b, h, q0, Kh, Vh, Qw); (void)Qw;
        const int q0w = q0 + rg * 32;
        if (h != htab) { const int t2 = wid * 64 + lane_id(); Tb[t2] = TbG[h * 512 + t2]; htab = h; }
        const float Tl = TbG[h * 512 + 0];
        f32x16 o[4] = {}; float l_reg = 0.f, ps = 0.f;
        f32x16 pC0, pC1; bf16x8 pa0, pa1, pa2, pa3, pn0, pn1, pn2, pn3;
        s16x4 VA[8], VB[8]; unsigned cq[4];
        if constexpr (VAR == 4) {
#pragma unroll
            for (int i = 0; i < 8; ++i) { VA[i] = s16x4{}; VB[i] = s16x4{}; } }
        f32x16 cvec;
#pragma unroll
        for (int r = 0; r < 16; ++r) cvec[r] = Tl;
        WBAR(0);
        if (NT > 2) DMA(Kh, Vh, 2, 2 * BUFB);
        { const int l5 = lane_id(); qkt<VAR>(pC0, pC1, K_lds, qr, l5 & 31, l5 >> 5, mm, Tb, 0 - q0w, cvec); }
        PIECE(pC0, 0, 0); PIECE(pC0, 0, 1); PIECE(pC0, 0, 2); PIECE(pC0, 0, 3); PFIN(pa0);
        PIECE(pC0, 8, 0); PIECE(pC0, 8, 1); PIECE(pC0, 8, 2); PIECE(pC0, 8, 3); PFIN(pa1);
        PIECE(pC1, 0, 0); PIECE(pC1, 0, 1); PIECE(pC1, 0, 2); PIECE(pC1, 0, 3); PFIN(pa2);
        PIECE(pC1, 8, 0); PIECE(pC1, 8, 1); PIECE(pC1, 8, 2); PIECE(pC1, 8, 3); PFIN(pa3);
        LSUM();
        if (NT > 2) WBAR(4); else WBAR(0);
        for (int j = 1; j < NT; ++j) {
            const int bp = ((j - 1) & 3) * BUFB, bc = (j & 3) * BUFB;
            if (j + 2 < NT) DMA(Kh, Vh, j + 2, ((j + 2) & 3) * BUFB);
            if constexpr (VAR == 6) { if (j + 2 < NT) WBAR(4); else WBAR(0); continue; }
            SBAR(); VRDSET(VA, 0, bp);
            { const int drel = j * KVBLK - q0w; if (drel >= 122 && drel < 122 + KVBLK) {
                const float Tr = Tb[511];
#pragma unroll
                for (int r = 0; r < 16; ++r) cvec[r] = Tr; } }
            qkt<VAR>(pC0, pC1, K_lds + bc, qr, r32, hi, mm, Tb, j * KVBLK - q0w, cvec); SBAR();
            PVBLOCK(0, VA, VB, pC0, 0, pn0, bp);
            PVBLOCK(1, VB, VA, pC0, 8, pn1, bp);
            PVBLOCK(2, VA, VB, pC1, 0, pn2, bp);
            PVBLOCK(3, VB, VA, pC1, 8, pn3, bp);
            LSUM();
            pa0 = pn0; pa1 = pn1; pa2 = pn2; pa3 = pn3;
            if (j + 2 < NT) WBAR(4); else WBAR(0);
        }
        pv_d0(o, vb0 + ((NT - 1) & 3) * BUFB, pa0, pa1, pa2, pa3);
        float* li_l = (float*)(lds + LI2_OFF) + wid * 64;
        { const int l3 = lane_id(); if (l3 < 32) li_l[l3] = l_reg; }
        WBAR(0);
        const int un = u + G;
        if (un < NUNITS) {
            const int bn_ = un >> 7, hn_ = (un >> 4) & 7, q0n_ = (un & 15) * 128; const int l4 = lane_id();
            const char* Khn_ = (const char*)(Kb + (size_t)(bn_ * SEQ) * LD + hn_ * 128); const char* Vhn_ = (const char*)(Vb + (size_t)(bn_ * SEQ) * LD + hn_ * 128);
            const bf16_t* Qwn_ = Qb + (size_t)(bn_ * SEQ + q0n_ + rg * 32 + (l4 & 31)) * LD + hn_ * 128 + mm * 64 + (l4 >> 5) * 8;
            DMA(Khn_, Vhn_, 0, 0); if (NT > 1) DMA(Khn_, Vhn_, 1, BUFB);
#pragma unroll
            for (int d0 = 0; d0 < 4; ++d0) qr[d0] = *reinterpret_cast<const bf16x8*>(Qwn_ + d0 * 16);
        }
        const float fsc = mm ? lam : 1.0f;
        bf16_t* Em = (bf16_t*)(lds + E2_OFF + mm * E2_BYTES);
#pragma unroll
        for (int r = 0; r < 16; ++r) { const int orow = crow(r, hi); const float f = fsc * __builtin_amdgcn_rcpf(li_l[orow]);
#pragma unroll
            for (int d0 = 0; d0 < 4; ++d0) Em[(rg * 32 + orow) * E2_STRIDE + d0 * 32 + r32] = f2bf(o[d0][r] * f); }
        asm volatile("s_waitcnt lgkmcnt(0)" ::: "memory"); if constexpr (VAR != 7) __builtin_amdgcn_s_barrier(); asm volatile("" ::: "memory");
        {
            const int row = tid >> 2, qt = tid & 3;
            const bf16_t* e0 = (const bf16_t*)(lds + E2_OFF) + row * E2_STRIDE + qt * 32; const bf16_t* e1 = e0 + E2_BYTES / 2;
            float d[32]; float ss = 0.f;
#pragma unroll
            for (int c = 0; c < 4; ++c) { const u32x4 a = *(const u32x4*)(e0 + 8 * c), bq = *(const u32x4*)(e1 + 8 * c);
                d[8 * c + 0] = bf_lo(a.x) - bf_lo(bq.x); d[8 * c + 1] = bf_hi(a.x) - bf_hi(bq.x); d[8 * c + 2] = bf_lo(a.y) - bf_lo(bq.y); d[8 * c + 3] = bf_hi(a.y) - bf_hi(bq.y);
                d[8 * c + 4] = bf_lo(a.z) - bf_lo(bq.z); d[8 * c + 5] = bf_hi(a.z) - bf_hi(bq.z); d[8 * c + 6] = bf_lo(a.w) - bf_lo(bq.w); d[8 * c + 7] = bf_hi(a.w) - bf_hi(bq.w); }
#pragma unroll
            for (int c = 0; c < 32; ++c) ss += d[c] * d[c];
            ss += __shfl_xor(ss, 1); ss += __shfl_xor(ss, 2);
            const float rs = __builtin_amdgcn_rsqf(ss * (1.0f / 128.0f) + EPS) * 0.8f;
            bf16_t* op = Ob + (size_t)(b * SEQ + q0 + row) * LD + h * 128 + qt * 32;
            const float* gq = GS + qt * 32;
#pragma unroll
            for (int c = 0; c < 4; ++c) {
                u32x4 w; w.x = cvt_pk_bf16(d[8 * c + 0] * rs * gq[8 * c + 0], d[8 * c + 1] * rs * gq[8 * c + 1]); w.y = cvt_pk_bf16(d[8 * c + 2] * rs * gq[8 * c + 2], d[8 * c + 3] * rs * gq[8 * c + 3]);
                w.z = cvt_pk_bf16(d[8 * c + 4] * rs * gq[8 * c + 4], d[8 * c + 5] * rs * gq[8 * c + 5]); w.w = cvt_pk_bf16(d[8 * c + 6] * rs * gq[8 * c + 6], d[8 * c + 7] * rs * gq[8 * c + 7]);
                *(u32x4*)(op + 8 * c) = w; }
        }
    }
    asm volatile("s_waitcnt vmcnt(0) lgkmcnt(0)" ::: "memory"); __builtin_amdgcn_s_barrier(); asm volatile("" ::: "memory");
#undef UNIT_PTRS
#undef VRDSET
#undef VFRAG
#undef PIECE
#undef PFIN
#undef PVBLOCK
#undef LSUM
#undef DMA
#undef WBAR
}
constexpr int BUF2 = 65536;
template <int VAR = 0> __device__ __forceinline__ void attn_phase2(int vcu, int G, const bf16_t* __restrict__ Qb, const bf16_t* __restrict__ Kb, const bf16_t* __restrict__ Vb, bf16_t* __restrict__ Ob,
                                          const float* __restrict__ TbG, const float* __restrict__ gsub, float lam, char* lds, const int wid) {
    const int lane = lane_id(), tid = wid * 64 + lane, r32 = lane & 31, hi = lane >> 5, rg = wid & 3, mm = wid >> 2;
    constexpr int NUNITS = BATCH * NH * 16, NT2 = SEQ / 128;
    if (vcu >= NUNITS) return;
    float* Tb = (float*)(lds + TB2_OFF); float* GS = (float*)(lds + GS_OFF);
    unsigned offK[2], offV[2];
#pragma unroll
    for (int i = 0; i < 2; ++i) { const int pc = 2 * wid + i;
        { const int row = pc * 4 + (lane >> 4), c = (lane & 15) ^ (row & 7); offK[i] = (unsigned)(row * LD + c * 8) * 2u; }
        { const int sub = pc * 2 + (lane >> 5), kk = (sub >> 2) * 8 + ((lane & 31) >> 2), k = (kk & ~0xC) | ((kk & 4) << 1) | ((kk & 8) >> 1), col = (sub & 3) * 32 + (lane & 3) * 8; offV[i] = (unsigned)(k * LD + col) * 2u; } }
    LAS unsigned char* ldsl_ = (LAS unsigned char*)(unsigned char*)lds;
    const LAS char* vbase = (const LAS char*)(LAS unsigned char*)(unsigned char*)lds + v_rd_base(lane);
    const int vbi0 = (int)(unsigned)(unsigned long long)vbase, ldsi0 = (int)(unsigned)(unsigned long long)ldsl_;
#define DMA2(Kh_, Vh_, t, boff) do { _Pragma("unroll") for (int s_ = 0; s_ < 2; ++s_) { const char* kt_ = (Kh_) + (size_t)(2 * (t) + s_) * (KVBLK * LD * 2); const char* vt_ = (Vh_) + (size_t)(2 * (t) + s_) * (KVBLK * LD * 2); \
        _Pragma("unroll") for (int i_ = 0; i_ < 2; ++i_) { \
            __builtin_amdgcn_global_load_lds((const unsigned*)(vt_ + offV[i_]), (LAS unsigned*)(ldsl_ + (boff) + s_ * SHM_V + (2 * wid + i_) * 1024), 16, 0, 0); \
            __builtin_amdgcn_global_load_lds((const unsigned*)(kt_ + offK[i_]), (LAS unsigned*)(ldsl_ + (boff) + 2 * SHM_V + s_ * SHM_K + (2 * wid + i_) * 1024), 16, 0, 0); } } } while (0)
#define DMAP(Kh_, Vh_, t, boff, p) do { const int s_ = (p) >> 2, i_ = ((p) >> 1) & 1; \
        if ((p) & 1) { const char* kt_ = pg8::uni((Kh_) + (size_t)(2 * (t) + s_) * (KVBLK * LD * 2)); unsigned vo_ = offK[i_]; asm volatile("" : "+v"(vo_)); \
            __builtin_amdgcn_global_load_lds((const unsigned*)(kt_ + vo_), (LAS unsigned*)(ldsl_ + (boff) + 2 * SHM_V + s_ * SHM_K + (2 * wid + i_) * 1024), 16, 0, 0); } \
        else { const char* vt_ = pg8::uni((Vh_) + (size_t)(2 * (t) + s_) * (KVBLK * LD * 2)); unsigned vo_ = offV[i_]; asm volatile("" : "+v"(vo_)); \
            __builtin_amdgcn_global_load_lds((const unsigned*)(vt_ + vo_), (LAS unsigned*)(ldsl_ + (boff) + s_ * SHM_V + (2 * wid + i_) * 1024), 16, 0, 0); } } while (0)
#define WBAR0() do { asm volatile("s_waitcnt vmcnt(0) lgkmcnt(0)" ::: "memory"); __builtin_amdgcn_s_barrier(); asm volatile("" ::: "memory"); } while (0)
#define VREQ(f) do { if ((f) < 32) { FL[(f) & 3] = tr_read<((f) >> 4) * SHM_V + v_rd_off((f) & 3, ((f) >> 2) & 3, 0)>(vbi); FH[(f) & 3] = tr_read<((f) >> 4) * SHM_V + v_rd_off((f) & 3, ((f) >> 2) & 3, 1)>(vbi); } } while (0)
#define VWAIT(f) asm volatile("s_waitcnt lgkmcnt(%2)" : "+v"(FL[(f) & 3]), "+v"(FH[(f) & 3]) : "n"((f) <= 28 ? 6 : 2 * (31 - (f))))
#define VFRG(f) (bf16x8){FL[(f) & 3][0], FL[(f) & 3][1], FL[(f) & 3][2], FL[(f) & 3][3], FH[(f) & 3][0], FH[(f) & 3][1], FH[(f) & 3][2], FH[(f) & 3][3]}
#define PVM(f, X) do { VREQ((f) + 3); VWAIT(f); o[(f) & 3] = __builtin_amdgcn_mfma_f32_32x32x16_bf16(((f) < 16 ? paA : paB)[((f) >> 2) & 3], VFRG(f), o[(f) & 3], 0, 0, 0); X; SBAR(); } while (0)
#define PIECE(P, B, q) do { P[(B) + 2 * (q)] = __builtin_amdgcn_exp2f(P[(B) + 2 * (q)]); P[(B) + 2 * (q) + 1] = __builtin_amdgcn_exp2f(P[(B) + 2 * (q) + 1]); \
        ps += P[(B) + 2 * (q)]; ps += P[(B) + 2 * (q) + 1]; cq[q] = cvt_pk_bf16(P[(B) + 2 * (q)], P[(B) + 2 * (q) + 1]); } while (0)
#define PFIN(OUT) do { auto r0_ = __builtin_amdgcn_permlane32_swap(cq[0], cq[2], false, false); auto r1_ = __builtin_amdgcn_permlane32_swap(cq[1], cq[3], false, false); \
        u32x4 w_ = {r0_[0], r1_[0], r0_[1], r1_[1]}; OUT = *reinterpret_cast<bf16x8*>(&w_); } while (0)
#define PC(P0, P1, PA, i) do { if ((i) < 8) PIECE(P0, ((i) >> 2) * 8, (i) & 3); else PIECE(P1, (((i) >> 2) & 1) * 8, (i) & 3); if (((i) & 3) == 3) PFIN(PA[(i) >> 2]); } while (0)
#define LSUM() do { auto rr_ = __builtin_amdgcn_permlane32_swap(__float_as_uint(ps), __float_as_uint(ps), false, false); l_reg += __uint_as_float(rr_[0]) + __uint_as_float(rr_[1]); ps = 0.f; } while (0)
#define UNIT_PTRS(u_, b_, h_, q0_, Kh_, Vh_, Qw_) const int b_ = (u_) >> 7, h_ = ((u_) >> 4) & 7, q0_ = ((u_) & 15) * 128; \
        const char* Kh_ = (const char*)(Kb + (size_t)(b_ * SEQ) * LD + h_ * 128); const char* Vh_ = (const char*)(Vb + (size_t)(b_ * SEQ) * LD + h_ * 128); \
        const bf16_t* Qw_ = Qb + (size_t)(b_ * SEQ + q0_ + rg * 32 + r32) * LD + h_ * 128 + mm * 64 + hi * 8
    bf16x8 qr[4]; int htab = -1;
    { UNIT_PTRS(vcu, b0_, h0_, q00_, Kh0_, Vh0_, Qw0_);
      DMA2(Kh0_, Vh0_, 0, 0);
#pragma unroll
      for (int d0 = 0; d0 < 4; ++d0) qr[d0] = *reinterpret_cast<const bf16x8*>(Qw0_ + d0 * 16);
      if (tid < 128) GS[tid] = gsub[tid]; }
    for (int u = vcu; u < NUNITS; u += G) {
        UNIT_PTRS(u, b, h, q0, Kh, Vh, Qw); (void)Qw;
        const int q0w = q0 + rg * 32;
        if (h != htab) { const int t2 = wid * 64 + lane_id(); Tb[t2] = TbG[h * 512 + t2]; htab = h; }
        const float Tl = TbG[h * 512 + 0];
        f32x16 o[4] = {}; float l_reg = 0.f, ps = 0.f;
        f32x16 pA0, pA1, pB0, pB1; bf16x8 paA[4], paB[4];
        s16x4 FL[4], FH[4]; unsigned cq[4];
        float tfar = Tl;
        WBAR0();
        for (int j = 0; j < NT2; ++j) {
            const int base = (j & 1) * BUF2; const int vbi = vbi0 + base;
            const bool dnext = (j + 1 < NT2); const int nboff = ((j + 1) & 1) * BUF2;
            SBAR();
            const int drela = j * 128 - q0w, drelb = drela + 64;
            if (drela >= 122 && drela < 122 + KVBLK) tfar = Tb[511];
            { const int l5 = lane_id(); f32x16 cv;
#pragma unroll
              for (int r = 0; r < 16; ++r) cv[r] = tfar;
              qkt2(pA0, pA1, lds + base + 2 * SHM_V, qr, l5 & 31, l5 >> 5, mm, Tb, drela, cv, [&](int p) { if (dnext) DMAP(Kh, Vh, j + 1, nboff, p); }); } SBAR();
            if (drelb >= 122 && drelb < 122 + KVBLK) tfar = Tb[511];
            VREQ(0); VREQ(1); VREQ(2);
            {
                const bool farb = (drelb >= 122 || drelb <= -154);
#define KREQ(i) do { if ((i) < 8) kw[(i) & 3] = lds_read128<2 * SHM_V + SHM_K + 8192 * ((i) & 1)>(kab + (((((i) >> 1) << 5) | (hi << 4)) ^ kxs)); } while (0)
#define KWAIT(i) asm volatile("s_waitcnt lgkmcnt(%1)" : "+v"(kw[(i) & 3]) : "n"((i) <= 4 ? 3 : 7 - (i)))
#define QKB(i, ACC) do { KREQ((i) + 3); KWAIT(i); ACC = __builtin_amdgcn_mfma_f32_32x32x16_bf16(kw[(i) & 3], qr[(i) >> 1], ACC, 0, 0, 0); PC(pA0, pA1, paA, i); SBAR(); } while (0)
                const int kxs = (r32 & 7) << 4, kab = ldsi0 + base + r32 * 256 + mm * 128;
                bf16x8 kw[4];
                KREQ(0); KREQ(1); KREQ(2); SBAR();
                if (!farb) { const float* tb = Tb + (drelb + 256 - r32 + 4 * hi);
#pragma unroll
                    for (int r = 0; r < 16; ++r) { const int oo = (r & 3) + 8 * (r >> 2); pB0[r] = tb[oo]; pB1[r] = tb[oo + 32]; } }
                else {
#pragma unroll
                    for (int r = 0; r < 16; ++r) { pB0[r] = tfar; pB1[r] = tfar; } }
                QKB(0, pB0); QKB(1, pB1); QKB(2, pB0); QKB(3, pB1); QKB(4, pB0); QKB(5, pB1); QKB(6, pB0); QKB(7, pB1);
#undef QKB
#undef KWAIT
#undef KREQ
            }
            PVM(0, PC(pA0, pA1, paA, 8)); PVM(1, PC(pA0, pA1, paA, 9)); PVM(2, PC(pA0, pA1, paA, 10)); PVM(3, PC(pA0, pA1, paA, 11));
            PVM(4, PC(pA0, pA1, paA, 12)); PVM(5, PC(pA0, pA1, paA, 13)); PVM(6, PC(pA0, pA1, paA, 14)); PVM(7, PC(pA0, pA1, paA, 15));
            PVM(8, PC(pB0, pB1, paB, 0)); PVM(9, PC(pB0, pB1, paB, 1)); PVM(10, PC(pB0, pB1, paB, 2)); PVM(11, PC(pB0, pB1, paB, 3));
            PVM(12, PC(pB0, pB1, paB, 4)); PVM(13, PC(pB0, pB1, paB, 5)); PVM(14, PC(pB0, pB1, paB, 6)); PVM(15, PC(pB0, pB1, paB, 7));
            PVM(16, PC(pB0, pB1, paB, 8)); PVM(17, PC(pB0, pB1, paB, 9)); PVM(18, PC(pB0, pB1, paB, 10)); PVM(19, PC(pB0, pB1, paB, 11));
            PVM(20, PC(pB0, pB1, paB, 12)); PVM(21, PC(pB0, pB1, paB, 13)); PVM(22, PC(pB0, pB1, paB, 14)); PVM(23, PC(pB0, pB1, paB, 15));
            PVM(24, (void)0); PVM(25, (void)0); PVM(26, (void)0); PVM(27, (void)0); PVM(28, (void)0); PVM(29, (void)0); PVM(30, (void)0); PVM(31, (void)0);
            LSUM();
            WBAR0();
        }
        float* li_l = (float*)(lds + LI2_OFF) + wid * 64;
        { const int l3 = lane_id(); if (l3 < 32) li_l[l3] = l_reg; }
        const int un = u + G;
        if (un < NUNITS) {
            const int bn_ = un >> 7, hn_ = (un >> 4) & 7, q0n_ = (un & 15) * 128; const int l4 = lane_id();
            const char* Khn_ = (const char*)(Kb + (size_t)(bn_ * SEQ) * LD + hn_ * 128); const char* Vhn_ = (const char*)(Vb + (size_t)(bn_ * SEQ) * LD + hn_ * 128);
            const bf16_t* Qwn_ = Qb + (size_t)(bn_ * SEQ + q0n_ + rg * 32 + (l4 & 31)) * LD + hn_ * 128 + mm * 64 + (l4 >> 5) * 8;
            DMA2(Khn_, Vhn_, 0, 0);
#pragma unroll
            for (int d0 = 0; d0 < 4; ++d0) qr[d0] = *reinterpret_cast<const bf16x8*>(Qwn_ + d0 * 16);
        }
        const float fsc = mm ? lam : 1.0f;
        bf16_t* Em = (bf16_t*)(lds + E2_OFF + mm * E2_BYTES);
        asm volatile("s_waitcnt lgkmcnt(0)" ::: "memory");
#pragma unroll
        for (int r = 0; r < 16; ++r) { const int orow = crow(r, hi); const float f = fsc * __builtin_amdgcn_rcpf(li_l[orow]);
#pragma unroll
            for (int d0 = 0; d0 < 4; ++d0) Em[(rg * 32 + orow) * E2_STRIDE + d0 * 32 + r32] = f2bf(o[d0][r] * f); }
        asm volatile("s_waitcnt lgkmcnt(0)" ::: "memory"); __builtin_amdgcn_s_barrier(); asm volatile("" ::: "memory");
        {
            const int row = tid >> 2, qt = tid & 3;
            const bf16_t* e0 = (const bf16_t*)(lds + E2_OFF) + row * E2_STRIDE + qt * 32; const bf16_t* e1 = e0 + E2_BYTES / 2;
            float d[32]; float ss = 0.f;
#pragma unroll
            for (int c = 0; c < 4; ++c) { const u32x4 a = *(const u32x4*)(e0 + 8 * c), bq = *(const u32x4*)(e1 + 8 * c);
                d[8 * c + 0] = bf_lo(a.x) - bf_lo(bq.x); d[8 * c + 1] = bf_hi(a.x) - bf_hi(bq.x); d[8 * c + 2] = bf_lo(a.y) - bf_lo(bq.y); d[8 * c + 3] = bf_hi(a.y) - bf_hi(bq.y);
                d[8 * c + 4] = bf_lo(a.z) - bf_lo(bq.z); d[8 * c + 5] = bf_hi(a.z) - bf_hi(bq.z); d[8 * c + 6] = bf_lo(a.w) - bf_lo(bq.w); d[8 * c + 7] = bf_hi(a.w) - bf_hi(bq.w); }
#pragma unroll
            for (int c = 0; c < 32; ++c) ss += d[c] * d[c];
            ss += __shfl_xor(ss, 1); ss += __shfl_xor(ss, 2);
            const float rs = __builtin_amdgcn_rsqf(ss * (1.0f / 128.0f) + EPS) * 0.8f;
            bf16_t* op = Ob + (size_t)(b * SEQ + q0 + row) * LD + h * 128 + qt * 32;
            const float* gq = GS + qt * 32;
#pragma unroll
            for (int c = 0; c < 4; ++c) {
                u32x4 w; w.x = cvt_pk_bf16(d[8 * c + 0] * rs * gq[8 * c + 0], d[8 * c + 1] * rs * gq[8 * c + 1]); w.y = cvt_pk_bf16(d[8 * c + 2] * rs * gq[8 * c + 2], d[8 * c + 3] * rs * gq[8 * c + 3]);
                w.z = cvt_pk_bf16(d[8 * c + 4] * rs * gq[8 * c + 4], d[8 * c + 5] * rs * gq[8 * c + 5]); w.w = cvt_pk_bf16(d[8 * c + 6] * rs * gq[8 * c + 6], d[8 * c + 7] * rs * gq[8 * c + 7]);
                *(u32x4*)(op + 8 * c) = w; }
        }
    }
    asm volatile("s_waitcnt vmcnt(0) lgkmcnt(0)" ::: "memory"); __builtin_amdgcn_s_barrier(); asm volatile("" ::: "memory");
#undef UNIT_PTRS
#undef DMAP
#undef DMA2
#undef WBAR0
#undef VREQ
#undef VFRG
#undef PVM
#undef PIECE
#undef PFIN
#undef PC
#undef LSUM
}
}

namespace lru {
constexpr int CT = 128, NCH = SEQ / CT;
constexpr int LST = 68;
constexpr int XC_OFF = 0, AS_OFF = CT * 256, BS_OFF = AS_OFF + CT * LST * 4, HT_OFF = BS_OFF + CT * LST * 4, SEGP_OFF = HT_OFF + CT * LST * 4, SEGH_OFF = SEGP_OFF + 2048, CAR_OFF = SEGH_OFF + 2048, CW_OFF = CAR_OFF + 512;
static_assert(CW_OFF + 2560 <= MISC_OFF, "LRU LDS map");
__device__ __forceinline__ void lru_unit(int b, int n, int hh, const bf16_t* __restrict__ XL, const bf16_t* __restrict__ GY, bf16_t* __restrict__ LO, const bf16_t* __restrict__ WL,
                                         const float* __restrict__ conv_w, const float* __restrict__ conv_b, const float* __restrict__ rb, const float* __restrict__ ib, const float* __restrict__ lamp, char* lds, const int wid, const int d0 = 0, const int d1 = 2) {
    const int lane = lane_id(), tid = wid * 64 + lane, r32 = lane & 31, hi = lane >> 5;
    const int tp = wid & 1, ct = wid >> 1;
    char* XC = lds + XC_OFF; float* AS = (float*)(lds + AS_OFF); float* BS = (float*)(lds + BS_OFF); float* HT = (float*)(lds + HT_OFF);
    float* SEGP = (float*)(lds + SEGP_OFF); float* SEGH = (float*)(lds + SEGH_OFF); float* CAR = (float*)(lds + CAR_OFF);
    const int crow_ = tid >> 3, cg = tid & 7;
    const bf16_t* xbase = XL + (size_t)(b * SEQ) * DM + n * 128 + cg * 16;
    float* CW = (float*)(lds + CW_OFF);
    for (int i = tid; i < 640; i += 512) CW[i] = i < 512 ? conv_w[(i >> 7) * DM + n * 128 + (i & 127)] : conv_b[n * 128 + (i - 512)];
    for (int dir = d0; dir < d1; ++dir) {
        bf16x8 wf[8];
        { const bf16_t* wp = WL + (size_t)((((dir * 8 + n) * 2 + hh) * 4 + ct) * 32 + r32) * 128 + 8 * hi;
#pragma unroll
          for (int ks = 0; ks < 8; ++ks) wf[ks] = *reinterpret_cast<const bf16x8*>(wp + 16 * ks); }
        f32x4 nbr[2], nbi[2], kcv[2];
#pragma unroll
        for (int q2 = 0; q2 < 2; ++q2)
#pragma unroll
            for (int s2 = 0; s2 < 4; ++s2) { const int ch = dir * DM + n * 128 + hh * 64 + ct * 16 + 8 * q2 + 4 * hi + s2;
                nbr[q2][s2] = -rb[ch] * LOG2E; nbi[q2][s2] = -ib[ch] * LOG2E;
                const float L = lamp[ch]; kcv[q2][s2] = -8.0f * log1pf(__expf(-L)) * LOG2E; }
        __syncthreads();
        if (tid < 128) CAR[tid] = 0.f;
        u32x4 xin[2][4][2];
#define XLOAD(T1) do { const int t1_ = (T1); \
        if (t1_ >= 2 && t1_ <= SEQ - CT - 2) {                                    \
            _Pragma("unroll") for (int hf = 0; hf < 2; ++hf) _Pragma("unroll") for (int j = 0; j < 4; ++j) { const bf16_t* xp = xbase + (size_t)(t1_ + 64 * hf + crow_ + j - 2) * DM; xin[hf][j][0] = *(const u32x4*)xp; xin[hf][j][1] = *(const u32x4*)(xp + 8); } \
        } else { \
            _Pragma("unroll") for (int hf = 0; hf < 2; ++hf) _Pragma("unroll") for (int j = 0; j < 4; ++j) { const int t = t1_ + 64 * hf + crow_ + j - 2; const bool ok = (t >= 0 && t < SEQ); const bf16_t* xp = xbase + (size_t)(ok ? t : 0) * DM; \
                xin[hf][j][0] = ok ? *(const u32x4*)xp : (u32x4){0u, 0u, 0u, 0u}; xin[hf][j][1] = ok ? *(const u32x4*)(xp + 8) : (u32x4){0u, 0u, 0u, 0u}; } } } while (0)
        XLOAD(dir == 0 ? 0 : SEQ - CT);
        u32x4 hfr[2] = {{0u, 0u, 0u, 0u}, {0u, 0u, 0u, 0u}}, gyr[2] = {{0u, 0u, 0u, 0u}, {0u, 0u, 0u, 0u}}; size_t gio_prev = 0;
        for (int ci = 0; ci <= NCH; ++ci) {
            const int t0 = dir == 0 ? ci * CT : (NCH - 1 - ci) * CT;
            const size_t gio = (size_t)(b * SEQ + t0 + crow_) * DM + n * 128 + hh * 64 + cg * 8;
            if (ci < NCH) {
#pragma unroll
                for (int hf = 0; hf < 2; ++hf) {
                    f32x2 xc[8];
#pragma unroll
                    for (int p = 0; p < 8; ++p) xc[p] = *(const f32x2*)(CW + 512 + cg * 16 + 2 * p);
#pragma unroll
                    for (int j = 0; j < 4; ++j) { const u32x4 x0 = xin[hf][j][0], x1 = xin[hf][j][1]; const f32x2* cwj = (const f32x2*)(CW + j * 128 + cg * 16);
                        xc[0] += cwj[0] * (f32x2){bf_lo(x0.x), bf_hi(x0.x)}; xc[1] += cwj[1] * (f32x2){bf_lo(x0.y), bf_hi(x0.y)}; xc[2] += cwj[2] * (f32x2){bf_lo(x0.z), bf_hi(x0.z)}; xc[3] += cwj[3] * (f32x2){bf_lo(x0.w), bf_hi(x0.w)};
                        xc[4] += cwj[4] * (f32x2){bf_lo(x1.x), bf_hi(x1.x)}; xc[5] += cwj[5] * (f32x2){bf_lo(x1.y), bf_hi(x1.y)}; xc[6] += cwj[6] * (f32x2){bf_lo(x1.z), bf_hi(x1.z)}; xc[7] += cwj[7] * (f32x2){bf_lo(x1.w), bf_hi(x1.w)}; }
                    u32x4 w0, w1; w0.x = cvt_pk_bf16(xc[0].x, xc[0].y); w0.y = cvt_pk_bf16(xc[1].x, xc[1].y); w0.z = cvt_pk_bf16(xc[2].x, xc[2].y); w0.w = cvt_pk_bf16(xc[3].x, xc[3].y);
                    w1.x = cvt_pk_bf16(xc[4].x, xc[4].y); w1.y = cvt_pk_bf16(xc[5].x, xc[5].y); w1.z = cvt_pk_bf16(xc[6].x, xc[6].y); w1.w = cvt_pk_bf16(xc[7].x, xc[7].y);
                    *(u32x4*)(XC + KSWZ(64 * hf + crow_, cg * 32)) = w0; *(u32x4*)(XC + KSWZ(64 * hf + crow_, cg * 32 + 16)) = w1;
                }
                if (ci + 1 < NCH) XLOAD(dir == 0 ? (ci + 1) * CT : (NCH - 2 - ci) * CT);
            }
            __syncthreads();
            if (ci > 0) {
#pragma unroll
                for (int hf = 0; hf < 2; ++hf) {
                    const f32x4 h0 = *(const f32x4*)(HT + (64 * hf + crow_) * LST + cg * 8), h1 = *(const f32x4*)(HT + (64 * hf + crow_) * LST + cg * 8 + 4);
                    float hv[8] = {h0[0], h0[1], h0[2], h0[3], h1[0], h1[1], h1[2], h1[3]};
                    if (dir == 1) { const u32x4 f = hfr[hf], g = gyr[hf];
                        hv[0] = (hv[0] + bf_lo(f.x)) * bf_lo(g.x); hv[1] = (hv[1] + bf_hi(f.x)) * bf_hi(g.x); hv[2] = (hv[2] + bf_lo(f.y)) * bf_lo(g.y); hv[3] = (hv[3] + bf_hi(f.y)) * bf_hi(g.y);
                        hv[4] = (hv[4] + bf_lo(f.z)) * bf_lo(g.z); hv[5] = (hv[5] + bf_hi(f.z)) * bf_hi(g.z); hv[6] = (hv[6] + bf_lo(f.w)) * bf_lo(g.w); hv[7] = (hv[7] + bf_hi(f.w)) * bf_hi(g.w); }
                    u32x4 w; w.x = cvt_pk_bf16(hv[0], hv[1]); w.y = cvt_pk_bf16(hv[2], hv[3]); w.z = cvt_pk_bf16(hv[4], hv[5]); w.w = cvt_pk_bf16(hv[6], hv[7]);
                    __builtin_nontemporal_store(w, (u32x4*)(LO + gio_prev + (size_t)(64 * hf) * DM)); }
            }
            if (ci == NCH) break;
            if (dir == 1) {
#pragma unroll
                for (int hf = 0; hf < 2; ++hf) { hfr[hf] = *(const u32x4*)(LO + gio + (size_t)(64 * hf) * DM); gyr[hf] = *(const u32x4*)(GY + gio + (size_t)(64 * hf) * DM); } }
            gio_prev = gio;
#pragma unroll
            for (int k2 = 0; k2 < 2; ++k2) {
                const int tok = 64 * tp + 32 * k2 + r32;
                f32x16 acc = {};
                bf16x8 xb[4];
#pragma unroll
                for (int ks = 0; ks < 4; ++ks) xb[ks] = *reinterpret_cast<const bf16x8*>(XC + KSWZ(tok, (16 * ks + 8 * hi) * 2));
                __builtin_amdgcn_sched_barrier(0);
#pragma unroll
                for (int ks = 0; ks < 8; ++ks) { acc = __builtin_amdgcn_mfma_f32_32x32x16_bf16(wf[ks], xb[ks & 3], acc, 0, 0, 0);
                    if (ks + 4 < 8) xb[ks & 3] = *reinterpret_cast<const bf16x8*>(XC + KSWZ(tok, (16 * (ks + 4) + 8 * hi) * 2));
                    __builtin_amdgcn_sched_barrier(0); }
#pragma unroll
                for (int q2 = 0; q2 < 2; ++q2) { const int chl = ct * 16 + 8 * q2 + 4 * hi;
                    const f32x4 rpre = (f32x4){acc[8 * q2 + 0], acc[8 * q2 + 1], acc[8 * q2 + 2], acc[8 * q2 + 3]} * (-LOG2E) + nbr[q2];
                    const f32x4 ipre = (f32x4){acc[8 * q2 + 4], acc[8 * q2 + 5], acc[8 * q2 + 6], acc[8 * q2 + 7]} * (-LOG2E) + nbi[q2];
                    f32x4 rg, ig, a;
#pragma unroll
                    for (int s2 = 0; s2 < 4; ++s2) { rg[s2] = __builtin_amdgcn_rcpf(1.0f + __builtin_amdgcn_exp2f(rpre[s2])); ig[s2] = __builtin_amdgcn_rcpf(1.0f + __builtin_amdgcn_exp2f(ipre[s2])); }
                    const f32x4 la = rg * kcv[q2];
#pragma unroll
                    for (int s2 = 0; s2 < 4; ++s2) a[s2] = __builtin_amdgcn_exp2f(la[s2]);
                    const f32x4 om = 1.0f - a * a; f32x4 mult;
#pragma unroll
                    for (int s2 = 0; s2 < 4; ++s2) mult[s2] = __builtin_amdgcn_sqrtf(om[s2]);
                    const u32x2 xw = *(const u32x2*)(XC + KSWZ(tok, ((hh * 64 + chl) >> 3) * 16) + 8 * hi);
                    const f32x4 xv = {bf_lo(xw.x), bf_hi(xw.x), bf_lo(xw.y), bf_hi(xw.y)};
                    *(f32x4*)(AS + tok * LST + chl) = a; *(f32x4*)(BS + tok * LST + chl) = mult * ig * xv; }
            }
            __syncthreads();
            const int ch = lane, seg = wid;
            float av[16], bv[16];
            {
                float Pp = 1.f, Hh = 0.f;
#pragma unroll
                for (int p = 0; p < 16; ++p) { const int pos = seg * 16 + p, tl = dir ? CT - 1 - pos : pos; av[p] = AS[tl * LST + ch]; bv[p] = BS[tl * LST + ch]; Hh = av[p] * Hh + bv[p]; Pp *= av[p]; }
                SEGP[seg * 64 + ch] = Pp; SEGH[seg * 64 + ch] = Hh;
            }
            __syncthreads();
            {
                float c = CAR[(ci & 1) * 64 + ch];
                for (int s2 = 0; s2 < seg; ++s2) c = SEGP[s2 * 64 + ch] * c + SEGH[s2 * 64 + ch];
#pragma unroll
                for (int p = 0; p < 16; ++p) { const int pos = seg * 16 + p, tl = dir ? CT - 1 - pos : pos; c = av[p] * c + bv[p]; HT[tl * LST + ch] = c; }
                if (seg == 7) CAR[((ci + 1) & 1) * 64 + ch] = c;
            }
        }
#undef XLOAD
        asm volatile("s_waitcnt vmcnt(0)" ::: "memory");
        __syncthreads();
    }
}
}

__device__ __forceinline__ void transpose_item(const float* W, int N, bf16_t* WT, int ldt, int k0, int n0, size_t drow0, LAS float* scr, int lane) {
#pragma unroll
    for (int i = 0; i < 32; ++i) { const int kk = 2 * i + (lane >> 5); scr[kk * 33 + (lane & 31)] = __builtin_nontemporal_load(&W[(size_t)(k0 + kk) * N + n0 + (lane & 31)]); }
    LDS_WAIT(); asm volatile("" ::: "memory");
    const int c = lane & 7;
#pragma unroll
    for (int j = 0; j < 4; ++j) { const int nn = (lane >> 3) + 8 * j; const LAS float* s = scr + (8 * c) * 33 + nn;
        u32x4 o; o.x = cvt_pk_bf16(s[0 * 33], s[1 * 33]); o.y = cvt_pk_bf16(s[2 * 33], s[3 * 33]); o.z = cvt_pk_bf16(s[4 * 33], s[5 * 33]); o.w = cvt_pk_bf16(s[6 * 33], s[7 * 33]);
        *(GAS u32x4*)(WT + (drow0 + nn) * ldt + k0 + 8 * c) = o; }
    LDS_WAIT(); asm volatile("" ::: "memory");
}
__device__ __forceinline__ void transpose_item_fp8(const float* W, int N, unsigned char* WT, int ldt, int k0, int n0, size_t drow0, LAS float* scr, int lane) {
#pragma unroll
    for (int i = 0; i < 32; ++i) { const int kk = 2 * i + (lane >> 5); scr[kk * 33 + (lane & 31)] = __builtin_nontemporal_load(&W[(size_t)(k0 + kk) * N + n0 + (lane & 31)]) * 64.0f; }
    LDS_WAIT(); asm volatile("" ::: "memory");
    const int c = lane & 7;
#pragma unroll
    for (int j = 0; j < 4; ++j) { const int nn = (lane >> 3) + 8 * j; const LAS float* s = scr + (8 * c) * 33 + nn;
        u32x2 o; o.x = pk4_fp8(s[0 * 33], s[1 * 33], s[2 * 33], s[3 * 33]); o.y = pk4_fp8(s[4 * 33], s[5 * 33], s[6 * 33], s[7 * 33]);
        *(GAS u32x2*)(WT + (drow0 + nn) * ldt + k0 + 8 * c) = o; }
    LDS_WAIT(); asm volatile("" ::: "memory");
}
__device__ __forceinline__ void convert_gate_up(const float* wg, const float* wu, unsigned char* WGU8, LAS unsigned char* ldsl, int gw, int NGW, int wave) {
    const int lane = lane_id();
    LAS float* scr = (LAS float*)(ldsl + 16384 + wave * 8704);
    constexpr int I_GU = (DM / 64) * (FFE / 32);
    for (int it = gw; it < NE * 2 * I_GU; it += NGW) {
        const int e = it / (2 * I_GU); int r = it % (2 * I_GU); const int up = r >= I_GU; if (up) r -= I_GU;
        const int nblk = FFE / 32, kb = r / nblk, nb = r % nblk, n0 = 32 * nb;
        const float* W = (up ? wu : wg) + (size_t)e * DM * FFE;
        const size_t drow0 = (size_t)e * 4096 + (size_t)(n0 >> 7) * 256 + (n0 & 127) + (up ? 128 : 0);
        transpose_item_fp8(W, FFE, WGU8, DM, 64 * kb, n0, drow0, scr, lane);
    }
}
__device__ __forceinline__ void transpose_mat(const float* W, int K, int N, bf16_t* WT, size_t drow_base, int item, LAS float* scr, int lane) {
    const int nblk = N / 32, kb = item / nblk, nb = item % nblk;
    transpose_item(W, N, WT, K, 64 * kb, 32 * nb, drow_base + 32 * nb, scr, lane);
}
__device__ __forceinline__ int rel_bucket(int rel) {
    const int ret = rel > 0 ? 16 : 0; const int nabs = rel < 0 ? -rel : rel;
    if (nabs < 8) return ret + nabs;
    int large = (31 - __clz(nabs * nabs)) + 2; large = large < 15 ? large : 15;
    return ret + large;
}

struct Params { const float* in[26]; float* out; unsigned char* ws; int ph_lo, ph_hi, probe, pad; };

__global__ void __launch_bounds__(512, 2) mk_fwd(Params P) {
    extern __shared__ __attribute__((aligned(16))) unsigned char lds[];
    LAS unsigned char* ldsl = (LAS unsigned char*)lds;
    volatile LAS unsigned* MISC = (volatile LAS unsigned*)(ldsl + MISC_OFF);
    const int wave = __builtin_amdgcn_readfirstlane((int)threadIdx.x >> 6);
    const int G = gridDim.x, bx = blockIdx.x;
    const int vcu = (G % 8 == 0) ? (bx % 8) * (G / 8) + bx / 8 : bx;
    unsigned char* ws = P.ws;
    if (threadIdx.x < 32) MISC[threadIdx.x] = 0u;
    __syncthreads();
    XcdBarrier bar; bar.bar = (unsigned*)(ws + WS_CTL) + CW_BAR; bar.x = 0; bar.st = nullptr;
    if (P.ph_hi - P.ph_lo > 1) bar = xcd_barrier_post((unsigned*)(ws + WS_CTL) + CW_BAR, MISC + 8);
    const int lo = P.ph_lo, hi = P.ph_hi;
#define IN(k) (lo <= (k) && (k) < hi)
#define PH_IDS() const int lane = lane_id(), tid = wave * 64 + lane; (void)tid; (void)lane
#define BOTH(k) (IN(k) && IN((k) + 1))
    const float* x = P.in[0];
    bf16_t* RA = (bf16_t*)(ws + WS_RA); bf16_t* QB = (bf16_t*)(ws + WS_Q); bf16_t* KB = (bf16_t*)(ws + WS_K); bf16_t* VB = (bf16_t*)(ws + WS_V);
    bf16_t* XL = (bf16_t*)(ws + WS_XL); bf16_t* GY = (bf16_t*)(ws + WS_GY); bf16_t* LO = (bf16_t*)(ws + WS_LO);
    unsigned char* SA = (unsigned char*)P.out; unsigned char* SR = (unsigned char*)P.out + (size_t)MTOK * DM;
    bf16_t* WIN = (bf16_t*)(ws + WS_WIN); bf16_t* WCAT = (bf16_t*)(ws + WS_WCAT); bf16_t* WOUT = (bf16_t*)(ws + WS_WOUT); bf16_t* WLRU = (bf16_t*)(ws + WS_WLRU);
    bf16_t* WGU = (bf16_t*)(ws + WS_WGU); bf16_t* WDN = (bf16_t*)(ws + WS_WDN); bf16_t* HG = (bf16_t*)(ws + WS_HG);
    unsigned char* XN8 = ws + WS_XN8; unsigned char* WIN8 = ws + WS_WIN8;
    float* TBG = (float*)(ws + WS_TAB); float* MISCG = (float*)(ws + WS_TAB + 16384);
    unsigned short* INV = (unsigned short*)(ws + WS_INV); bf16_t* YE = (bf16_t*)(ws + WS_YE);
    bf16_t* H16 = (bf16_t*)(ws + WS_H16);
    float* SELRS = (float*)(ws + WS_SELRS); float* RSV = (float*)(ws + WS_RS);
    float* AFF = (float*)(ws + WS_AFF); int* SELI = (int*)(ws + WS_SELI); float* SELV = (float*)(ws + WS_SELV);
    const int gw = vcu * 8 + wave, NGW = G * 8;

    if (IN(0)) { PH_IDS();
        LAS float* scr = (LAS float*)(ldsl + wave * 16384);
        constexpr int I_IN = (DM / 64) * (DIN / 32), I_SQ = (DM / 64) * (DM / 32);
        for (int it = gw; it < I_IN + 3 * I_SQ; it += NGW) {
            int r = it;
            if (r < I_IN) { const int nb = r % (DIN / 32); if (nb < 5120 / 32) transpose_mat(P.in[2], DM, DIN, WIN, 0, r, scr, lane);
                if (nb >= 5120 / 32) { const int kb = r / (DIN / 32); transpose_item_fp8(P.in[2], DIN, WIN8, DM, 64 * kb, 32 * nb, (size_t)(32 * nb - 5120), scr, lane); }
                continue; } r -= I_IN;
            if (r < I_SQ) { const int kb = r / (DM / 32), nb = r % (DM / 32); transpose_item(P.in[18], DM, WCAT, 2 * DM, 64 * kb, 32 * nb, (size_t)(32 * nb), scr, lane); continue; } r -= I_SQ;
            if (r < I_SQ) { const int kb = r / (DM / 32), nb = r % (DM / 32); transpose_item(P.in[19], DM, WCAT + DM, 2 * DM, 64 * kb, 32 * nb, (size_t)(32 * nb), scr, lane); continue; } r -= I_SQ;
            transpose_mat(P.in[20], DM, DM, WOUT, 0, r, scr, lane);
        }
        for (int e = gw * 64 + lane; e < 2 * 8 * 2 * 4 * 32 * 128; e += NGW * 64) {
            const int k = e & 127, rho = (e >> 7) & 31, ct = (e >> 12) & 3, hh = (e >> 14) & 1, n = (e >> 15) & 7, dir = e >> 18;
            const int type = (rho >> 3) & 1, s = rho & 3, hi_ = (rho >> 2) & 1, q2 = rho >> 4;
            const int dcol = hh * 64 + ct * 16 + 8 * q2 + 4 * hi_ + s;
            const float* src = type ? P.in[15] : P.in[13];
            WLRU[e] = f2bf(src[(size_t)((dir * 8 + n) * 128 + k) * 128 + dcol]);
        }
        if (vcu == 0) {
            float gqm = 0.f, gkm = 0.f;
            for (int i = 0; i < 64; ++i) { gqm = fmaxf(gqm, fabsf(P.in[3][i])); gkm = fmaxf(gkm, fabsf(P.in[4][i])); }
            for (int e = tid; e < NH * 512; e += 512) { const int h = e >> 9, idx = e & 511;
                float bm = -1e30f; for (int bk = 0; bk < 32; ++bk) bm = fmaxf(bm, P.in[10][bk * NH + h]);
                const float Mh = 8.0f * gqm * gkm + bm;
                TBG[e] = (P.in[10][rel_bucket(idx - 256) * NH + h] - Mh) * LOG2E; }
            if (tid == 0) { float s1 = 0.f, s2 = 0.f; for (int i = 0; i < 64; ++i) { s1 += P.in[5][i] * P.in[6][i]; s2 += P.in[7][i] * P.in[8][i]; }
                MISCG[0] = __expf(s1) - __expf(s2) + 0.2f; }
        }
        for (int m = gw; m < MTOK; m += NGW) {
            const GAS f32x4* xr = (const GAS f32x4*)(x + (size_t)m * DM) + lane; const f32x4* gr = (const f32x4*)P.in[1] + lane;
            f32x4 v[4]; float s = 0.f;
#pragma unroll
            for (int j = 0; j < 4; ++j) { v[j] = __builtin_nontemporal_load(&xr[64 * j]); s += (v[j].x * v[j].x + v[j].y * v[j].y) + (v[j].z * v[j].z + v[j].w * v[j].w); }
            const float rs = __builtin_amdgcn_rsqf(wave_sum(s) * (1.0f / DM) + EPS);
            GAS u32x2* o8 = (GAS u32x2*)(RA + (size_t)m * DM) + lane;
            GAS unsigned* o4 = (GAS unsigned*)(XN8 + (size_t)m * DM) + lane;
#pragma unroll
            for (int j = 0; j < 4; ++j) { const f32x4 g = gr[64 * j]; const f32x4 y = v[j] * rs * g; u32x2 w; w.x = cvt_pk_bf16(y.x, y.y); w.y = cvt_pk_bf16(y.z, y.w); o8[64 * j] = w; o4[64 * j] = pk4_fp8(y.x, y.y, y.z, y.w); }
        }
        if (BOTH(0)) xcd_barrier(bar, wave);
    }

    if (IN(1)) {
#ifdef MK_PROBE_P1
        if (P.probe) { pg8::DenseOrder S{(const char*)RA, (const char*)WIN, DM * 2, DM * 2, MTOK / 256, 20, G, bx}; pg8::EpiNull E{(float*)(ws + WS_CTL + 32768)};
            pg8::gemm_phase<pg8::EpiNull, pg8::DenseOrder, true, true>(ldsl, DM * 2, S, E, wave); } else
#endif
        {
        LAS float* gl = (LAS float*)(ldsl + X_SCR_OFF);
        { PH_IDS(); if (tid < 128) gl[tid] = tid < 64 ? P.in[3][tid] : P.in[4][tid - 64]; }
        __syncthreads();
        { pg8::DenseOrder S{(const char*)RA, (const char*)WIN, DM * 2, DM * 2, MTOK / 256, 20, G, bx};
          pg8::EpiProj E{QB, KB, VB, XL, GY, gl};
          pg8::gemm_phase<pg8::EpiProj, pg8::DenseOrder, true, true>(ldsl, DM * 2, S, E, wave); }
        { pg8::DenseOrder S{(const char*)XN8, (const char*)WIN8, DM, DM, MTOK / 256, 8, G, bx};
          pg8::EpiGate E; E.sa = SA; E.sr = SR; E.gsc = 0.015625f;
          pg8::gemm_phase<pg8::EpiGate, pg8::DenseOrder, true, true, true>(ldsl, DM, S, E, wave); }
        }
        if (BOTH(1)) xcd_barrier(bar, wave);
    }

    if (IN(2)) {
        const int cgrp = (vcu & 1) ? 2 : 0;
        if (cgrp == 0) { convert_gate_up(P.in[23], P.in[24], (unsigned char*)WGU, ldsl, gw, NGW, wave); __syncthreads(); }
        if (vcu < 256) lru::lru_unit(vcu >> 4, (vcu >> 1) & 7, vcu & 1, XL, GY, LO, WLRU, P.in[11], P.in[12], P.in[14], P.in[16], P.in[17], (char*)lds, wave, 0, 1);
        __syncthreads();
        if (cgrp == 1) { convert_gate_up(P.in[23], P.in[24], (unsigned char*)WGU, ldsl, gw, NGW, wave); __syncthreads(); }
        if (vcu < 256) lru::lru_unit(vcu >> 4, (vcu >> 1) & 7, vcu & 1, XL, GY, LO, WLRU, P.in[11], P.in[12], P.in[14], P.in[16], P.in[17], (char*)lds, wave, 1, 2);
        __syncthreads();
        if (cgrp == 2) { convert_gate_up(P.in[23], P.in[24], (unsigned char*)WGU, ldsl, gw, NGW, wave); __syncthreads(); }
    }
    if (IN(3)) {
        const float lam = MISCG[0];
#ifdef MK_PROBE_ATTN
        if (P.probe) att::attn_phase<MK_PROBE_ATTN, MK_PROBE_VAR>(vcu, G, QB, KB, VB, RA, TBG, P.in[9], lam, (char*)lds, wave); else
#endif
        att::attn_phase2<0>(vcu, G, QB, KB, VB, RA, TBG, P.in[9], lam, (char*)lds, wave);
        if (BOTH(3)) xcd_barrier(bar, wave);
    }

    if (IN(4)) {
        pg8::BranchOrder S{(const char*)RA, (const char*)LO, (const char*)WCAT, G, bx};
        pg8::EpiBranch E; E.sa = SA; E.sr = SR; E.mixed = XL;
        pg8::gemm_phase<pg8::EpiBranch, pg8::BranchOrder, true, true>(ldsl, DM * 4, S, E, wave);
        if (BOTH(4)) xcd_barrier(bar, wave);
    }

    if (IN(5)) {
        pg8::DenseOrder S{(const char*)XL, (const char*)WOUT, DM * 2, DM * 2, MTOK / 256, DM / 256, G, bx};
        pg8::EpiOut E; E.x = x; E.h16 = H16;
        pg8::gemm_phase<pg8::EpiOut, pg8::DenseOrder, true, true>(ldsl, DM * 2, S, E, wave);
        if (BOTH(5)) xcd_barrier(bar, wave);
    }

    if (IN(6)) { PH_IDS();
        LAS float* WRT = (LAS float*)ldsl;
        LAS float* GL = (LAS float*)(ldsl + 65536);
        for (int i = tid; i < DM * NE; i += 512) { const int k = i >> 4, e = i & 15; WRT[(k >> 2) * 64 + e * 4 + (k & 3)] = P.in[22][i]; }
        for (int i = tid; i < DM; i += 512) GL[i] = P.in[21][i];
        __syncthreads();
        const int r = lane & 15, q = lane >> 4;
        for (int g16 = gw; g16 < MTOK / 16; g16 += NGW) {
            const int R0 = g16 * 16;
            const GAS u32x4* hrow = (const GAS u32x4*)(H16 + (size_t)(R0 + r) * DM + 8 * q);
            GAS u32x2* o8 = (GAS u32x2*)((unsigned char*)RA + (size_t)(R0 + r) * DM + 8 * q);
            f32x4 acc = {0.f, 0.f, 0.f, 0.f}; float ss = 0.f;
            u32x4 hwv[32];
#pragma unroll
            for (int j = 0; j < 32; ++j) hwv[j] = hrow[4 * j];
            __builtin_amdgcn_sched_barrier(0);
#pragma unroll
            for (int j = 0; j < 32; ++j) {
                const u32x4 hw = hwv[j]; const f32x4 g0 = *(const LAS f32x4*)(GL + 32 * j + 8 * q), g1 = *(const LAS f32x4*)(GL + 32 * j + 8 * q + 4);
                const f32x4 y0 = (f32x4){bf_lo(hw.x), bf_hi(hw.x), bf_lo(hw.y), bf_hi(hw.y)} * g0, y1 = (f32x4){bf_lo(hw.z), bf_hi(hw.z), bf_lo(hw.w), bf_hi(hw.w)} * g1;
                ss += ((y0.x * y0.x + y0.y * y0.y) + (y0.z * y0.z + y0.w * y0.w)) + ((y1.x * y1.x + y1.y * y1.y) + (y1.z * y1.z + y1.w * y1.w));
                u32x2 o; o.x = pk4_fp8(y0.x, y0.y, y0.z, y0.w); o.y = pk4_fp8(y1.x, y1.y, y1.z, y1.w); o8[4 * j] = o;
                const f32x4 w0 = *(const LAS f32x4*)(WRT + (8 * j + 2 * q) * 64 + r * 4), w1 = *(const LAS f32x4*)(WRT + (8 * j + 2 * q + 1) * 64 + r * 4);
                acc = __builtin_amdgcn_mfma_f32_16x16x4f32(y0.x, w0.x, acc, 0, 0, 0); acc = __builtin_amdgcn_mfma_f32_16x16x4f32(y0.y, w0.y, acc, 0, 0, 0);
                acc = __builtin_amdgcn_mfma_f32_16x16x4f32(y0.z, w0.z, acc, 0, 0, 0); acc = __builtin_amdgcn_mfma_f32_16x16x4f32(y0.w, w0.w, acc, 0, 0, 0);
                acc = __builtin_amdgcn_mfma_f32_16x16x4f32(y1.x, w1.x, acc, 0, 0, 0); acc = __builtin_amdgcn_mfma_f32_16x16x4f32(y1.y, w1.y, acc, 0, 0, 0);
                acc = __builtin_amdgcn_mfma_f32_16x16x4f32(y1.z, w1.z, acc, 0, 0, 0); acc = __builtin_amdgcn_mfma_f32_16x16x4f32(y1.w, w1.w, acc, 0, 0, 0);
            }
            ss += __shfl_xor(ss, 16); ss += __shfl_xor(ss, 32);
            const float rs = __builtin_amdgcn_rsqf(ss * (1.0f / DM) + EPS);
            if (q == 0) RSV[R0 + r] = rs;
            f32x4 pr;
#pragma unroll
            for (int reg = 0; reg < 4; ++reg) { const float lg = acc[reg] * __shfl(rs, 4 * q + reg);
                const float mx = row16_max(lg);
                const float ex = __expf(lg - mx); const float den = row16_sum(ex);
                pr[reg] = ex / den; }
            *(GAS f32x4*)(AFF + (size_t)((R0 >> 11) * NE + r) * SEQ + (R0 & (SEQ - 1)) + 4 * q) = pr;
        }
        if (BOTH(6)) xcd_barrier(bar, wave);
    }

    if (IN(7)) { PH_IDS();
        LAS u64* sk = (LAS u64*)ldsl;
        for (int pass = 0; pass < 2; ++pass) {
        int ln = lane; asm volatile("" : "+v"(ln));
        if ((pass == 0) == ((vcu & 1) == 0)) {
        for (int p = vcu; p < BATCH * NE; p += G) {
            for (int t = tid; t < SEQ; t += 512) sk[t] = ((u64)__float_as_uint(AFF[(size_t)p * SEQ + t]) << 32) | (u64)(0xFFFFFFFFu - (unsigned)t);
            __syncthreads();
            for (int k = 2; k <= SEQ; k <<= 1)
                for (int j = k >> 1; j > 0; j >>= 1) {
#pragma unroll
                    for (int t2 = 0; t2 < 2; ++t2) { const int t = tid + 512 * t2; const int i = ((t & ~(j - 1)) << 1) | (t & (j - 1)), l = i | j;
                        const u64 a = sk[i], bq = sk[l]; const bool desc = ((i & k) == 0);
                        if ((a < bq) == desc) { sk[i] = bq; sk[l] = a; } }
                    __syncthreads();
                }
            if (tid < CAP) { const u64 kv = sk[tid]; const int tok = (int)(0xFFFFFFFFu - (unsigned)kv); SELI[p * CAP + tid] = tok; SELV[p * CAP + tid] = __uint_as_float((unsigned)(kv >> 32)); SELRS[p * CAP + tid] = RSV[(p >> 4) * SEQ + tok]; }
            for (int t = tid; t < SEQ; t += 512) { const unsigned tok = 0xFFFFFFFFu - (unsigned)sk[t]; INV[(size_t)((p >> 4) * SEQ + tok) * NE + (p & 15)] = (unsigned short)(t < CAP ? t + 1 : 0); }
            __syncthreads();
        }
        } else {
        LAS float* scr = (LAS float*)(ldsl + 16384 + wave * 8704);
        constexpr int I_DN = (FFE / 64) * (DM / 32);
        for (int it = gw; it < NE * I_DN; it += NGW) {
            const int e = it / I_DN, r = it % I_DN;
            const int nblk = DM / 32, kb = r / nblk, nb = r % nblk;
            transpose_item_fp8(P.in[25] + (size_t)e * FFE * DM, DM, (unsigned char*)WDN, FFE, 64 * kb, 32 * nb, (size_t)e * DM + 32 * nb, scr, ln);
        }
        }
        __syncthreads();
        }
        if (BOTH(7)) xcd_barrier(bar, wave);
    }

    const bool pvalid = (G == 256);
    const int pj = bx / 8, pe = 2 * (bx % 8) + (pj >> 4), pb = pj & 15, pair = pb * NE + pe;

    if (IN(8)) {
        pg8::MoeUpOrder S{(const char*)RA, (const char*)WGU, SELI, pb, pe, pair, pvalid};
        LAS float* rsl = (LAS float*)(ldsl + X_SCR_OFF);
        { PH_IDS(); if (tid < CAP) rsl[tid] = pvalid ? SELRS[pair * CAP + tid] * 0.015625f : 0.f; }
        __syncthreads();
        pg8::EpiMoeUp E; E.hg = (unsigned char*)HG; E.rsl = rsl;
        pg8::gemm_phase<pg8::EpiMoeUp, pg8::MoeUpOrder, true, true, true>(ldsl, DM, S, E, wave);
        if (BOTH(8)) xcd_barrier(bar, wave);
    }

    if (IN(9)) {
        pg8::MoeDownOrder S{(const char*)HG, (const char*)WDN, bx, pvalid};
        LAS float* vall = (LAS float*)(ldsl + X_SCR_OFF);
        { PH_IDS(); for (int t = tid; t < 4 * CAP; t += 512) { const int i = t >> 8, x_ = bx & 7, j_ = bx >> 3, q_ = i * 8 + (j_ >> 2), e_ = 2 * x_ + (q_ >> 4), b_ = q_ & 15;
            vall[t] = pvalid ? SELV[(b_ * NE + e_) * CAP + (t & 255)] : 0.f; } }
        __syncthreads();
        pg8::EpiMoeDown E; E.ye = (unsigned char*)YE; E.vall = vall;
        pg8::gemm_phase<pg8::EpiMoeDown, pg8::MoeDownOrder, true, true, true>(ldsl, FFE, S, E, wave);
        if (BOTH(9)) xcd_barrier(bar, wave);
    }

    if (IN(10)) { PH_IDS();
        unsigned iv_next = lane < NE ? (unsigned)INV[(size_t)gw * NE + lane] : 0u;
        for (int m = gw; m < MTOK; m += NGW) {
            GAS f32x4* orow = (GAS f32x4*)(P.out + (size_t)m * DM) + lane; const GAS u32x2* hrow = (const GAS u32x2*)(H16 + (size_t)m * DM) + lane;
            const unsigned iv = iv_next;
            if (m + NGW < MTOK) iv_next = lane < NE ? (unsigned)INV[(size_t)(m + NGW) * NE + lane] : 0u;
            f32x4 v[4], sacc[4];
#pragma unroll
            for (int j = 0; j < 4; ++j) { const u32x2 hw = hrow[64 * j]; v[j] = (f32x4){bf_lo(hw.x), bf_hi(hw.x), bf_lo(hw.y), bf_hi(hw.y)}; sacc[j] = (f32x4){0.f, 0.f, 0.f, 0.f}; }
            unsigned mask = (unsigned)(__ballot(iv != 0u) & 0xFFFFull);
            const int bb = m >> 11;
            while (mask) {
                unsigned a[4][4];
#pragma unroll
                for (int c = 0; c < 4; ++c) {
                    if (mask) { const int e0 = __builtin_ctz(mask); mask &= mask - 1;
                        const unsigned s0 = (unsigned)__builtin_amdgcn_readlane((int)iv, e0) - 1u;
                        const GAS unsigned* y0 = (const GAS unsigned*)((const unsigned char*)YE + (size_t)((bb * NE + e0) * CAP + s0) * DM) + lane;
#pragma unroll
                        for (int j = 0; j < 4; ++j) a[c][j] = y0[64 * j];
                    } else {
#pragma unroll
                        for (int j = 0; j < 4; ++j) a[c][j] = 0u;
                    }
                }
#pragma unroll
                for (int c = 0; c < 4; ++c)
#pragma unroll
                    for (int j = 0; j < 4; ++j) { const f32x2 lo = __builtin_amdgcn_cvt_pk_f32_fp8((int)a[c][j], false), hi = __builtin_amdgcn_cvt_pk_f32_fp8((int)a[c][j], true);
                        sacc[j].x += lo.x; sacc[j].y += lo.y; sacc[j].z += hi.x; sacc[j].w += hi.y; }
            }
#pragma unroll
            for (int j = 0; j < 4; ++j) v[j] += sacc[j] * 0.015625f;
#pragma unroll
            for (int j = 0; j < 4; ++j) __builtin_nontemporal_store(v[j], &orow[64 * j]);
        }
    }
#undef IN
#undef BOTH
}

extern "C" void kernel_launch(void* const* d_in, const int* in_sizes, int n_in, void* d_out, int out_size, void* d_ws, size_t ws_size, hipStream_t stream) {
    static int grid = 0;
    if (grid == 0) {
        if (n_in != 26 || in_sizes[0] != MTOK * DM || out_size != MTOK * DM || ws_size < WS_END) {
            fprintf(stderr, "kernel_launch: shape/workspace mismatch: n_in %d in0 %d out %d ws %zu (need %zu)\n", n_in, n_in > 0 ? in_sizes[0] : -1, out_size, ws_size, (size_t)WS_END); grid = -1; return; }
        int dev = 0, cus = 0;
        if (hipGetDevice(&dev) != hipSuccess || hipDeviceGetAttribute(&cus, hipDeviceAttributeMultiprocessorCount, dev) != hipSuccess) { grid = -1; return; }
        if (hipFuncSetAttribute((const void*)mk_fwd, hipFuncAttributeMaxDynamicSharedMemorySize, LDS_BYTES) != hipSuccess) { fprintf(stderr, "kernel_launch: hipFuncSetAttribute failed\n"); grid = -1; return; }
        int per_cu = 0;
        if (hipOccupancyMaxActiveBlocksPerMultiprocessor(&per_cu, (const void*)mk_fwd, 512, LDS_BYTES) != hipSuccess || per_cu < 1) fprintf(stderr, "kernel_launch: occupancy query says %d\n", per_cu);
        (void)hipGetLastError();
        grid = cus;
        if (grid != 256) fprintf(stderr, "kernel_launch: %d CUs; the MoE phases need 256\n", grid);
    }
    if (grid < 0) return;
    (void)hipMemsetAsync((char*)d_ws + WS_CTL, 0, CTL_ZERO_BYTES, stream);
    Params p{};
    for (int i = 0; i < 26; ++i) p.in[i] = (const float*)d_in[i];
    p.out = (float*)d_out; p.ws = (unsigned char*)d_ws;
#if MK_ONE_LAUNCH
    p.ph_lo = 0; p.ph_hi = NPHASE;
    hipLaunchKernelGGL(mk_fwd, dim3(grid), dim3(512), LDS_BYTES, stream, p);
#else
    for (int ph = 0; ph < NPHASE; ++ph) { p.ph_lo = ph; p.ph_hi = ph + 1; hipLaunchKernelGGL(mk_fwd, dim3(grid), dim3(512), LDS_BYTES, stream, p);
#ifdef MK_PROBE_ATTN
        if (ph == 2) { Params q = p; q.ph_lo = 3; q.ph_hi = 4; q.probe = 1; hipLaunchKernelGGL(mk_fwd, dim3(grid), dim3(512), LDS_BYTES, stream, q); }
#endif
#ifdef MK_PROBE_P1
        if (ph == 1) { Params q = p; q.probe = 1; hipLaunchKernelGGL(mk_fwd, dim3(grid), dim3(512), LDS_BYTES, stream, q); }
#endif
#ifdef MK_REP_PHASE
        if (ph == MK_REP_PHASE) hipLaunchKernelGGL(mk_fwd, dim3(grid), dim3(512), LDS_BYTES, stream, p);
#endif
    }
#endif
    const hipError_t le = hipPeekAtLastError();
    if (le != hipSuccess) fprintf(stderr, "kernel_launch: launch failed: %s\n", hipGetErrorName(le));
}
```
